# Optimizing an MI355X kernel written in HIP

```python
import jax, jax.numpy as jnp
from jax import lax
import numpy as np

D_MODEL = 1024
BATCH = 8
SEQ = 8192
DEPTH = 1

MIX_WIDTH = D_MODEL
ATT_WIDTH = MIX_WIDTH // 2
ATT_HEAD_DIM = 64
ATT_HEADS = ATT_WIDTH // ATT_HEAD_DIM
KV_LATENT = 128
IDX_HEADS = 8
IDX_DIM = 64
TOPK_MAX = 256
Q_BLOCK = 128
HG_WIDTH = MIX_WIDTH - ATT_WIDTH
HG_HEADS = 8
HG_VAL_DIM = HG_WIDTH // HG_HEADS
HG_KEY_DIM = HG_VAL_DIM
HG_CHUNK = 32
PEER_HEADS = 8
PEER_N_KEYS = 128
PEER_N_EXPERTS = PEER_N_KEYS * PEER_N_KEYS
PEER_KEY_DIM = 256
PEER_TOPK = 16
PEER_BLOCK = 128
EPS = 1e-5
ALPHA = (2.0 * DEPTH) ** 0.25
BETA = (8.0 * DEPTH) ** -0.25

ATT_Q = ATT_HEADS * ATT_HEAD_DIM
HG_QK = HG_HEADS * HG_KEY_DIM
HG_V = HG_HEADS * HG_VAL_DIM
IN_SPLITS = (ATT_Q, KV_LATENT, IDX_HEADS * IDX_DIM, IDX_DIM, IDX_HEADS, HG_QK, HG_QK, HG_V, HG_V)
D_IN = ATT_Q + KV_LATENT + IDX_HEADS * IDX_DIM + IDX_DIM + IDX_HEADS + 2 * HG_QK + 2 * HG_V

kernel_name = 'hymba_dsa_hgrn2_peer_deepnorm'


def _layer_norm(x, g, b):
    xf = x.astype(jnp.float32)
    mu = jnp.mean(xf, axis=-1, keepdims=True)
    var = jnp.mean(jnp.square(xf - mu), axis=-1, keepdims=True)
    return ((xf - mu) * lax.rsqrt(var + EPS) * g + b).astype(x.dtype)


def _rms_norm(x, g):
    xf = x.astype(jnp.float32)
    return (xf * lax.rsqrt(jnp.mean(xf * xf, axis=-1, keepdims=True) + EPS) * g).astype(x.dtype)


def _split_columns(proj):
    points = [int(p) for p in np.cumsum(IN_SPLITS)[:-1]]
    return jnp.split(proj, points, axis=-1)


def _dsa_attention(q, c_kv, q_idx, k_idx, w_idx, w_uk, w_uv):
    B, L = q.shape[:2]
    top_k = min(TOPK_MAX, L // 4)
    nb = L // Q_BLOCK
    q_lat = jnp.einsum('blhd,hcd->blhc', q, w_uk) * (ATT_HEAD_DIM ** -0.5)
    key_pos = jnp.arange(L)

    def to_blocks(a):
        return jnp.moveaxis(a.reshape(B, nb, Q_BLOCK, *a.shape[2:]), 1, 0)

    def one_block(args):
        ql, qi, wi, qpos = args
        logits = jax.nn.relu(jnp.einsum('bqhd,bsd->bqhs', qi, k_idx))
        score = jnp.einsum('bqhs,bqh->bqs', logits, wi).astype(jnp.float32)
        causal = key_pos[None, :] <= qpos[:, None]
        score = jnp.where(causal[None], score, -jnp.inf)
        _, sel = lax.top_k(score, top_k)
        c_sel = jax.vmap(lambda c, i: c[i])(c_kv, sel)
        att = jnp.einsum('bqhc,bqkc->bqhk', ql, c_sel).astype(jnp.float32)
        valid = (sel <= qpos[None, :, None])[:, :, None, :]
        p = jax.nn.softmax(jnp.where(valid, att, -jnp.inf), axis=-1).astype(c_sel.dtype)
        return jnp.einsum('bqhk,bqkc->bqhc', p, c_sel)

    o_lat = lax.map(one_block, (to_blocks(q_lat), to_blocks(q_idx), to_blocks(w_idx),
                                jnp.arange(L).reshape(nb, Q_BLOCK)))
    o_lat = jnp.moveaxis(o_lat, 0, 1).reshape(B, L, ATT_HEADS, KV_LATENT)
    o = jnp.einsum('blhc,hcd->blhd', o_lat, w_uv)
    return o.reshape(B, L, ATT_Q)


def _hgrn2(q, f_logit, i, gate, lower_bound, g_norm):
    B, L = q.shape[:2]
    nc = L // HG_CHUNK
    f32 = jnp.float32
    lb = lower_bound.astype(f32)
    f = lb + (1.0 - lb) * jax.nn.sigmoid(f_logit.astype(f32))
    log_f = jnp.log(f)
    k = 1.0 - f
    qf = jax.nn.silu(q.astype(f32))

    def chunks(a, d):
        return a.reshape(B, nc, HG_CHUNK, HG_HEADS, d)

    qc, kc, gc = chunks(qf, HG_KEY_DIM), chunks(k, HG_KEY_DIM), chunks(log_f, HG_KEY_DIM)
    vc = chunks(i.astype(f32), HG_VAL_DIM)
    b = jnp.cumsum(gc, axis=2)
    b_last = b[:, :, -1:]
    q_t = qc * jnp.exp(b)
    k_t = kc * jnp.exp(-b)
    mask = jnp.tril(jnp.ones((HG_CHUNK, HG_CHUNK), dtype=bool))
    a = jnp.where(mask, jnp.einsum('bnthd,bnshd->bnhts', q_t, k_t), 0.0)
    o_intra = jnp.einsum('bnhts,bnshe->bnthe', a, vc)
    ds = jnp.einsum('bnshd,bnshe->bnhde', kc * jnp.exp(b_last - b), vc)
    decay = jnp.exp(b_last[:, :, 0])

    def step(s, inp):
        d, dsn = inp
        return d[..., None] * s + dsn, s

    s0 = jnp.zeros((B, HG_HEADS, HG_KEY_DIM, HG_VAL_DIM), f32)
    _, s_prev = lax.scan(step, s0, (jnp.moveaxis(decay, 1, 0), jnp.moveaxis(ds, 1, 0)))
    s_prev = jnp.moveaxis(s_prev, 0, 1)
    o_inter = jnp.einsum('bnthd,bnhde->bnthe', q_t, s_prev)
    o = (o_intra + o_inter).reshape(B, L, HG_HEADS, HG_VAL_DIM)
    o = _rms_norm(o, g_norm) * jax.nn.silu(gate.astype(f32).reshape(B, L, HG_HEADS, HG_VAL_DIM))
    return o.reshape(B, L, HG_V).astype(i.dtype)


def _peer(x, w_q, sub_keys, u, v):
    B, L, D = x.shape
    xt = x.reshape(-1, PEER_BLOCK, D)
    K = PEER_TOPK

    def one_block(xb):
        q = (xb @ w_q).reshape(PEER_BLOCK, PEER_HEADS, 2, PEER_KEY_DIM // 2)
        s = jnp.einsum('thpd,hpkd->thpk', q, sub_keys).astype(jnp.float32)
        s_top, i_top = lax.top_k(s, K)
        cand = s_top[:, :, 0, :, None] + s_top[:, :, 1, None, :]
        cand_idx = i_top[:, :, 0, :, None] * PEER_N_KEYS + i_top[:, :, 1, None, :]
        best, pos = lax.top_k(cand.reshape(PEER_BLOCK, PEER_HEADS, K * K), K)
        experts = jnp.take_along_axis(cand_idx.reshape(PEER_BLOCK, PEER_HEADS, K * K), pos, axis=-1)
        g = jax.nn.softmax(best, axis=-1).astype(xb.dtype)
        h = jax.nn.gelu(jnp.einsum('td,thkd->thk', xb, u[experts]))
        return jnp.einsum('thk,thkd->td', g * h, v[experts])

    return lax.map(one_block, xt).reshape(B, L, D)


def setup_inputs(seed: int = 0) -> dict:
    key = jax.random.key(seed)
    ks = jax.random.split(key, 16)
    f32 = jnp.float32

    def normal(k, shape, scale):
        return jax.random.normal(k, shape, f32) * scale

    hg_i_start = int(np.cumsum(IN_SPLITS)[6])
    col_scale = jnp.ones((D_IN,), f32).at[hg_i_start:hg_i_start + HG_V].set(BETA)
    return {
        'x': normal(ks[0], (BATCH, SEQ, D_MODEL), 1.0),
        'w_in': normal(ks[1], (DEPTH, D_MODEL, D_IN), D_MODEL ** -0.5) * col_scale,
        'kv_norm_g': 1.0 + normal(ks[2], (DEPTH, KV_LATENT), 0.02),
        'w_uk': normal(ks[3], (DEPTH, ATT_HEADS, KV_LATENT, ATT_HEAD_DIM), ATT_HEAD_DIM ** -0.5),
        'w_uv': normal(ks[4], (DEPTH, ATT_HEADS, KV_LATENT, ATT_HEAD_DIM), BETA * KV_LATENT ** -0.5),
        'hg_lb_logits': normal(ks[5], (DEPTH + 1, HG_QK), 0.5),
        'hg_norm_g': 1.0 + normal(ks[6], (DEPTH, HG_VAL_DIM), 0.02),
        'w_out': normal(ks[7], (DEPTH, MIX_WIDTH, D_MODEL), BETA * MIX_WIDTH ** -0.5),
        'ln1_g': 1.0 + normal(ks[8], (DEPTH, D_MODEL), 0.02),
        'ln1_b': normal(ks[9], (DEPTH, D_MODEL), 0.02),
        'peer_w_q': normal(ks[10], (DEPTH, D_MODEL, PEER_HEADS * PEER_KEY_DIM), D_MODEL ** -0.5),
        'peer_sub_keys': normal(ks[11], (DEPTH, PEER_HEADS, 2, PEER_N_KEYS, PEER_KEY_DIM // 2), (PEER_KEY_DIM // 2) ** -0.5),
        'peer_u': normal(ks[12], (DEPTH, PEER_N_EXPERTS, D_MODEL), BETA * D_MODEL ** -0.5),
        'peer_v': normal(ks[13], (DEPTH, PEER_N_EXPERTS, D_MODEL), BETA),
        'ln2_g': 1.0 + normal(ks[14], (DEPTH, D_MODEL), 0.02),
        'ln2_b': normal(ks[15], (DEPTH, D_MODEL), 0.02),
    }


def reference(x, w_in, kv_norm_g, w_uk, w_uv, hg_lb_logits, hg_norm_g, w_out, ln1_g, ln1_b,
              peer_w_q, peer_sub_keys, peer_u, peer_v, ln2_g, ln2_b):
    B, L, _ = x.shape
    lower_bounds = jnp.cumsum(jax.nn.softmax(hg_lb_logits.astype(jnp.float32), axis=0), axis=0)
    for layer in range(DEPTH):
        proj = x @ w_in[layer]
        q_att, c_kv, q_idx, k_idx, w_idx, hg_q, hg_f, hg_i, hg_gate = _split_columns(proj)
        att_out = _dsa_attention(
            q_att.reshape(B, L, ATT_HEADS, ATT_HEAD_DIM),
            _rms_norm(c_kv, kv_norm_g[layer]),
            q_idx.reshape(B, L, IDX_HEADS, IDX_DIM),
            k_idx, w_idx, w_uk[layer], w_uv[layer])
        hg_out = _hgrn2(hg_q, hg_f, hg_i, hg_gate, lower_bounds[layer], hg_norm_g[layer])
        mix = jnp.concatenate([att_out, hg_out], axis=-1) @ w_out[layer]
        h = _layer_norm(ALPHA * x + mix, ln1_g[layer], ln1_b[layer])
        ffn = _peer(h, peer_w_q[layer], peer_sub_keys[layer], peer_u[layer], peer_v[layer])
        x = _layer_norm(ALPHA * h + ffn, ln2_g[layer], ln2_b[layer])
    return x
```

```cpp
#include <hip/hip_runtime.h>
#include <hip/hip_cooperative_groups.h>
#include <cstdio>
#include <cstdint>
namespace cg = cooperative_groups;

#define LAS __attribute__((address_space(3)))
typedef unsigned short u16;
typedef short s16x8 __attribute__((ext_vector_type(8)));
typedef short s16x4 __attribute__((ext_vector_type(4)));
typedef float f32x4v __attribute__((ext_vector_type(4)));
typedef float f32x16v __attribute__((ext_vector_type(16)));
typedef unsigned u32x4v __attribute__((ext_vector_type(4)));
typedef unsigned u32x2v __attribute__((ext_vector_type(2)));
typedef __bf16 bf16x2v __attribute__((ext_vector_type(2)));

constexpr int NB = 8, SEQ = 8192, DM = 1024, MTOK = NB * SEQ;
constexpr int DIN = 3272;
constexpr int N1 = 3840;
constexpr int K3 = 1536;
constexpr int NPQ = 2048;
constexpr float EPS = 1e-5f;
constexpr float ALPHA = 1.189207115002721f;
constexpr int TOPK = 256;

constexpr size_t MiB = 1u << 20;
constexpr size_t WS_CTL = 0, WS_LB = 4096, WS_USC = 65536, WS_VSC = 131072;
constexpr size_t WS_W1T = 1 * MiB, WS_W3T = 9 * MiB, WS_W5T = 12 * MiB, WS_SKB = 16 * MiB, WS_UB = 17 * MiB, WS_VB = 49 * MiB;
constexpr size_t WS_XB = 96 * MiB, WS_MIX = 96 * MiB;
constexpr size_t WS_H8 = WS_MIX + 96 * MiB, WS_HS = WS_MIX + 160 * MiB;
constexpr size_t WS_W1Q = 36 * MiB, WS_W1S = 272 * 1024, WS_XS = 40 * MiB;
constexpr size_t WS_W3M = 44 * MiB, WS_W3S = 288 * 1024, WS_MIXS = 41 * MiB;
constexpr int MIXB = 2048;
constexpr size_t WS_W5Q = 34 * MiB, WS_W5S = 256 * 1024;
constexpr size_t WS_R2 = 288 * MiB;
constexpr size_t WS_QLAT = WS_R2, WS_QIDX = WS_R2 + 128 * MiB, WS_CKV = WS_R2 + 192 * MiB, WS_KIDX = WS_R2 + 208 * MiB, WS_WIDX = WS_R2 + 216 * MiB, WS_SSQ = WS_R2 + 218 * MiB;
constexpr size_t WS_HQ = WS_R2 + 224 * MiB, WS_HLF = WS_R2 + 288 * MiB, WS_HV = WS_R2 + 416 * MiB, WS_HG = WS_R2 + 480 * MiB;
constexpr size_t WS_Y1 = WS_R2, WS_HB = WS_R2 + 256 * MiB, WS_PQ = WS_R2;
constexpr size_t WS_YB = WS_R2 + 384 * MiB;
constexpr size_t WS_END = WS_R2 + 544 * MiB;

#ifndef MK_REPEAT
#define MK_REPEAT 0
#endif
#ifndef MK_NOSORT
#define MK_NOSORT 0
#endif
constexpr int LDS_BYTES = 160 * 1024;
constexpr int NTHREADS = 512;

typedef float f32x2v __attribute__((ext_vector_type(2)));
__device__ __forceinline__ unsigned cvtpk(float lo, float hi) { const f32x2v v = {lo, hi}; const bf16x2v b = __builtin_convertvector(v, bf16x2v); return __builtin_bit_cast(unsigned, b); }
__device__ __forceinline__ float bf_lo(unsigned w) { return __builtin_bit_cast(float, w << 16); }
__device__ __forceinline__ float bf_hi(unsigned w) { return __builtin_bit_cast(float, w & 0xffff0000u); }
__device__ __forceinline__ float bf1(u16 w) { return __builtin_bit_cast(float, (unsigned)w << 16); }
__device__ __forceinline__ float fast_exp(float x) { return __builtin_amdgcn_exp2f(x * 1.4426950408889634f); }
__device__ __forceinline__ float sigmoidf_(float x) { return __builtin_amdgcn_rcpf(1.f + fast_exp(-x)); }
__device__ __forceinline__ float siluf_(float x) { return x * sigmoidf_(x); }
typedef int i32x4v __attribute__((ext_vector_type(4)));
__device__ __forceinline__ unsigned pack_i8(float a, float b, float c, float d) {
    const int ia = (int)__builtin_rintf(a), ib = (int)__builtin_rintf(b), ic = (int)__builtin_rintf(c), id = (int)__builtin_rintf(d);
    return ((unsigned)ia & 0xffu) | (((unsigned)ib & 0xffu) << 8) | (((unsigned)ic & 0xffu) << 16) | ((unsigned)id << 24);
}
__device__ __forceinline__ float dot2bf(unsigned a, unsigned b, float acc) { return __builtin_amdgcn_fdot2_f32_bf16(__builtin_bit_cast(bf16x2v, a), __builtin_bit_cast(bf16x2v, b), acc, false); }
__device__ __forceinline__ float dpp_xor1(float v) { return __builtin_bit_cast(float, __builtin_amdgcn_update_dpp(0, __builtin_bit_cast(int, v), 0xB1, 0xf, 0xf, true)); }
__device__ __forceinline__ float dpp_xor2(float v) { return __builtin_bit_cast(float, __builtin_amdgcn_update_dpp(0, __builtin_bit_cast(int, v), 0x4E, 0xf, 0xf, true)); }
__device__ __forceinline__ int dppi_xor1(int v) { return __builtin_amdgcn_update_dpp(0, v, 0xB1, 0xf, 0xf, true); }
__device__ __forceinline__ int dppi_xor2(int v) { return __builtin_amdgcn_update_dpp(0, v, 0x4E, 0xf, 0xf, true); }
__device__ __forceinline__ int dppi_xor4(int v) { return __builtin_amdgcn_update_dpp(0, __builtin_amdgcn_update_dpp(0, v, 0x141, 0xf, 0xf, true), 0x1B, 0xf, 0xf, true); }
__device__ __forceinline__ float dpp_xor4(float v) { const int t = __builtin_amdgcn_update_dpp(0, __builtin_bit_cast(int, v), 0x141, 0xf, 0xf, true); return __builtin_bit_cast(float, __builtin_amdgcn_update_dpp(0, t, 0x1B, 0xf, 0xf, true)); }
__device__ __forceinline__ float dpp_rowmirror(float v) { return __builtin_bit_cast(float, __builtin_amdgcn_update_dpp(0, __builtin_bit_cast(int, v), 0x140, 0xf, 0xf, true)); }
__device__ __forceinline__ float wave_max_f(float v) { v = fmaxf(v, dpp_xor1(v)); v = fmaxf(v, dpp_xor2(v)); v = fmaxf(v, dpp_xor4(v)); v = fmaxf(v, dpp_rowmirror(v)); v = fmaxf(v, __shfl_xor(v, 16)); return fmaxf(v, __shfl_xor(v, 32)); }
__device__ __forceinline__ float wave_sum_f(float v) { v += dpp_xor1(v); v += dpp_xor2(v); v += dpp_xor4(v); v += dpp_rowmirror(v); v += __shfl_xor(v, 16); return v + __shfl_xor(v, 32); }
#define LDS_FENCE() asm volatile("s_waitcnt lgkmcnt(0)" ::: "memory")

namespace pg8 {
#define PG8_LAS __attribute__((address_space(3)))
typedef unsigned short bf16_t;
typedef short bf16x8 __attribute__((ext_vector_type(8)));
typedef float f32x4 __attribute__((ext_vector_type(4)));
typedef unsigned u32x4 __attribute__((ext_vector_type(4)));
constexpr int BM = 256, BK = 64, HALF = 128, HTB = HALF * BK * 2  , STAGE_BYTES = 8 * HTB, NXCD = 8, WGM = 8;

__host__ __device__ __forceinline__ int lds_byte(int r, int c) { const int st = (r >> 4) * 2 + (c >> 5), rr = r & 15, cc = c & 31, ob = rr * 64 + cc * 2; return st * 1024 + (ob ^ (((ob >> 9) & 1) << 5)); }
__host__ __device__ __forceinline__ void stage_rc(int b, int& R, int& C) { const int st = b / 1024, sb = b % 1024, swz = sb ^ (((sb >> 9) & 1) << 5); R = (st >> 1) * 16 + swz / 64; C = (st & 1) * 32 + (swz % 64) / 2; }
__host__ __device__ __forceinline__ int perm32(int rho) { const int n = rho >> 4, i = rho & 15; return 8 * (i >> 2) + 4 * n + (i & 3); }

typedef int pg8_i32x4 __attribute__((ext_vector_type(4)));
struct Unit { int pm, pn; };
struct Gemm { const bf16_t* A; const bf16_t* Bt; int M, N, K; };

struct StaticOrder {
    int nM, nN, nwg, G, c;
    __host__ __device__ void init(int M, int N, int G_, int c_) { nM = M / BM; nN = N / BM; nwg = nM * nN; G = G_; c = c_; }
    __host__ __device__ bool next(int i, Unit& u) const {
        const long L = (long)i * G + c; if (L >= nwg) return false;
        int wgid = (int)L; { const int q = nwg / NXCD, r = nwg % NXCD, xcd = wgid % NXCD, off = wgid / NXCD; wgid = (xcd < r ? xcd * (q + 1) : r * (q + 1) + (xcd - r) * q) + off; }
        const int nig = WGM * nN, gid = wgid / nig, fm = gid * WGM, gsz = (nM - fm) < WGM ? (nM - fm) : WGM;
        u.pm = fm + ((wgid % nig) % gsz); u.pn = (wgid % nig) / gsz; return true;
    }
    __device__ __forceinline__ void a_ready(const Unit&) const {}
    __device__ __forceinline__ void done(const Unit&) const {}
};

__device__ __forceinline__ unsigned cvt_pk_bf16(float lo, float hi) { return cvtpk(lo, hi); }
typedef float f32x2 __attribute__((ext_vector_type(2)));

__device__ __forceinline__ u32x4 pack8(const f32x4& v0, const f32x4& v1) { u32x4 w; w.x = cvt_pk_bf16(v0[0], v0[1]); w.y = cvt_pk_bf16(v0[2], v0[3]); w.z = cvt_pk_bf16(v1[0], v1[1]); w.w = cvt_pk_bf16(v1[2], v1[3]); return w; }

struct EpiPlain {
    static constexpr bool PERM = true, AFTER_DRAIN = false;
    bf16_t* O; int ldc;
    __device__ __forceinline__ void operator()(const f32x4 (&acc)[2][2][4][2], const Unit& u, int wr, int wc, int fr, int fq) const {
        const int row0 = u.pm * BM + wr * 64 + fr, col0 = u.pn * BM + wc * 32 + 8 * fq;
#pragma unroll
        for (int ai = 0; ai < 2; ++ai)
#pragma unroll
            for (int m = 0; m < 4; ++m) { bf16_t* rowp = O + (size_t)(row0 + ai * HALF + m * 16) * ldc + col0;
#pragma unroll
                for (int bj = 0; bj < 2; ++bj) *(u32x4*)(rowp + bj * HALF) = pack8(acc[ai][bj][m][0], acc[ai][bj][m][1]); }
    }
};

struct EpiPQ {
    static constexpr bool PERM = true, AFTER_DRAIN = false;
    bf16_t* O; int ldc; const float* rs; const float* cs;
    __device__ __forceinline__ void operator()(const f32x4 (&acc)[2][2][4][2], const Unit& u, int wr, int wc, int fr, int fq) const {
        const int row0 = u.pm * BM + wr * 64 + fr, col0 = u.pn * BM + wc * 32 + 8 * fq;
        f32x4 c0[2], c1[2];
#pragma unroll
        for (int bj = 0; bj < 2; ++bj) { c0[bj] = *(const f32x4*)(cs + col0 + bj * HALF); c1[bj] = *(const f32x4*)(cs + col0 + bj * HALF + 4); }
#pragma unroll
        for (int ai = 0; ai < 2; ++ai)
#pragma unroll
            for (int m = 0; m < 4; ++m) { const int row = row0 + ai * HALF + m * 16; const float sr = rs[row]; bf16_t* rowp = O + (size_t)row * ldc + col0;
#pragma unroll
                for (int bj = 0; bj < 2; ++bj) {
                    const f32x4 v0 = __builtin_convertvector(__builtin_bit_cast(pg8_i32x4, acc[ai][bj][m][0]), f32x4) * sr * c0[bj], v1 = __builtin_convertvector(__builtin_bit_cast(pg8_i32x4, acc[ai][bj][m][1]), f32x4) * sr * c1[bj];
                    *(u32x4*)(rowp + bj * HALF) = pack8(v0, v1); } }
    }
};

struct EpiY1 {
    static constexpr bool PERM = true, AFTER_DRAIN = false;
    const float* X; bf16_t* Y; float alpha; const float* rs; const float* cs;
    __device__ __forceinline__ void to_float(f32x4 (&acc)[2][2][4][2], const Unit& u, int wr, int wc, int fr, int fq) const {
        const int row0 = u.pm * BM + wr * 64 + fr;
#pragma unroll
        for (int ai = 0; ai < 2; ++ai)
#pragma unroll
            for (int m = 0; m < 4; ++m) { const float sr = rs[row0 + ai * HALF + m * 16];
#pragma unroll
                for (int bj = 0; bj < 2; ++bj)
#pragma unroll
                    for (int n = 0; n < 2; ++n) acc[ai][bj][m][n] = __builtin_convertvector(__builtin_bit_cast(pg8_i32x4, acc[ai][bj][m][n]), f32x4) * sr; }
    }
    __device__ __forceinline__ void operator()(const f32x4 (&acc)[2][2][4][2], const Unit& u, int wr, int wc, int fr, int fq) const {
        const int row0 = u.pm * BM + wr * 64 + fr, col0 = u.pn * BM + wc * 32 + 8 * fq;
#pragma unroll
        for (int ai = 0; ai < 2; ++ai)
#pragma unroll
            for (int m = 0; m < 4; ++m) { const size_t o = (size_t)(row0 + ai * HALF + m * 16) * 1024 + col0;
#pragma unroll
                for (int bj = 0; bj < 2; ++bj) {
                    const f32x4 x0 = *(const f32x4*)(X + o + bj * HALF), x1 = *(const f32x4*)(X + o + bj * HALF + 4);
                    const f32x4 c0 = *(const f32x4*)(cs + col0 + bj * HALF), c1 = *(const f32x4*)(cs + col0 + bj * HALF + 4);
                    *(u32x4*)(Y + o + bj * HALF) = pack8(x0 * alpha + acc[ai][bj][m][0] * c0, x1 * alpha + acc[ai][bj][m][1] * c1); } }
    }
};

__device__ __forceinline__ float ep_exp(float x) { return __builtin_amdgcn_exp2f(x * 1.4426950408889634f); }
__device__ __forceinline__ float ep_sig(float x) { return __builtin_amdgcn_rcpf(1.f + ep_exp(-x)); }
__device__ __forceinline__ f32x4 silu4(const f32x4& v) { f32x4 r; r[0] = v[0] * ep_sig(v[0]); r[1] = v[1] * ep_sig(v[1]); r[2] = v[2] * ep_sig(v[2]); r[3] = v[3] * ep_sig(v[3]); return r; }

struct EpiProj {
    static constexpr bool PERM = true, AFTER_DRAIN = false;
    bf16_t *QLAT, *QIDX, *CKV, *KIDX; float *WIDX, *SSQ; bf16_t* HQ; float* HLF; bf16_t *HV, *HG; const float* lb; const float* rs; const float* cs;
    __device__ __forceinline__ void operator()(const f32x4 (&acc)[2][2][4][2], const Unit& u, int wr, int wc, int fr, int fq) const {
        const int row0 = u.pm * BM + wr * 64 + fr, pn = u.pn;
        f32x4 cv[2][2];
#pragma unroll
        for (int bj = 0; bj < 2; ++bj)
#pragma unroll
            for (int n = 0; n < 2; ++n) cv[bj][n] = *(const f32x4*)(cs + pn * BM + bj * HALF + wc * 32 + 8 * fq + 4 * n);
#define PJ_A(ai, bj, m, n, sr) (__builtin_convertvector(__builtin_bit_cast(pg8_i32x4, acc[ai][bj][m][n]), f32x4) * (sr) * cv[bj][n])
        if (pn < 6) {
            bf16_t* base = pn < 4 ? QLAT : QIDX; const int ld = pn < 4 ? 1024 : 512; const int col0 = (pn < 4 ? pn : pn - 4) * BM + wc * 32 + 8 * fq;
#pragma unroll
            for (int ai = 0; ai < 2; ++ai)
#pragma unroll
                for (int m = 0; m < 4; ++m) { const int row = row0 + ai * HALF + m * 16; const float sr = rs[row]; bf16_t* rowp = base + (size_t)row * ld + col0;
#pragma unroll
                    for (int bj = 0; bj < 2; ++bj) *(u32x4*)(rowp + bj * HALF) = pack8(PJ_A(ai, bj, m, 0, sr), PJ_A(ai, bj, m, 1, sr)); }
        } else if (pn == 6) {
#pragma unroll
            for (int ai = 0; ai < 2; ++ai)
#pragma unroll
                for (int m = 0; m < 4; ++m) { const size_t r = (size_t)(row0 + ai * HALF + m * 16); const float sr = rs[r];
                    const f32x4 v0 = PJ_A(ai, 0, m, 0, sr), v1 = PJ_A(ai, 0, m, 1, sr);
                    *(u32x4*)(CKV + r * 128 + wc * 32 + 8 * fq) = pack8(v0, v1);
                    float ss = v0[0] * v0[0] + v0[1] * v0[1] + v0[2] * v0[2] + v0[3] * v0[3] + v1[0] * v1[0] + v1[1] * v1[1] + v1[2] * v1[2] + v1[3] * v1[3];
                    ss += __shfl_xor(ss, 16); ss += __shfl_xor(ss, 32);
                    if (fq == 0) SSQ[r * 4 + wc] = ss;
                    const f32x4 w0 = PJ_A(ai, 1, m, 0, sr), w1 = PJ_A(ai, 1, m, 1, sr);
                    if (wc < 2) *(u32x4*)(KIDX + r * 64 + wc * 32 + 8 * fq) = pack8(w0, w1);
                    else if (wc == 2 && fq == 0) { *(f32x4*)(WIDX + r * 8) = w0; *(f32x4*)(WIDX + r * 8 + 4) = w1; } }
        } else {
            const int h = pn - 7; const int e0 = (wc & 1) * 32 + 8 * fq;
            f32x4 l0 = {0.f, 0.f, 0.f, 0.f}, l1 = l0;
            if (wc >= 2) { l0 = *(const f32x4*)(lb + h * 64 + e0); l1 = *(const f32x4*)(lb + h * 64 + e0 + 4); }
#pragma unroll
            for (int ai = 0; ai < 2; ++ai)
#pragma unroll
                for (int m = 0; m < 4; ++m) { const int row = row0 + ai * HALF + m * 16; const float sr = rs[row]; const size_t o = (size_t)row * 512 + h * 64 + e0;
                    const f32x4 a0 = PJ_A(ai, 0, m, 0, sr), a1 = PJ_A(ai, 0, m, 1, sr), b0 = PJ_A(ai, 1, m, 0, sr), b1 = PJ_A(ai, 1, m, 1, sr);
                    if (wc < 2) {
                        *(u32x4*)(HQ + o) = pack8(silu4(a0), silu4(a1));
                        *(u32x4*)(HV + o) = pack8(b0, b1);
                    } else {
                        f32x4 f0, f1;
#pragma unroll
                        for (int j = 0; j < 4; ++j) { f0[j] = __builtin_amdgcn_logf(l0[j] + (1.f - l0[j]) * ep_sig(a0[j])) * 0.6931471805599453f; f1[j] = __builtin_amdgcn_logf(l1[j] + (1.f - l1[j]) * ep_sig(a1[j])) * 0.6931471805599453f; }
                        *(f32x4*)(HLF + o) = f0; *(f32x4*)(HLF + o + 4) = f1;
                        *(u32x4*)(HG + o) = pack8(silu4(b0), silu4(b1));
                    } }
        }
#undef PJ_A
    }
};
template <bool I8> __device__ __forceinline__ f32x4 mma_sel(const bf16x8& a, const bf16x8& b, const f32x4& c) {
    if constexpr (I8) return __builtin_bit_cast(f32x4, __builtin_amdgcn_mfma_i32_16x16x64_i8(__builtin_bit_cast(pg8_i32x4, a), __builtin_bit_cast(pg8_i32x4, b), __builtin_bit_cast(pg8_i32x4, c), 0, 0, 0));
    else return __builtin_amdgcn_mfma_f32_16x16x32_bf16(a, b, c, 0, 0, 0);
}
template <class Epi, class Sched, bool ALIGN_EPI = false, bool SP2 = false, bool I8 = false, int KSW = 0>
__device__ __forceinline__ void gemm_phase(PG8_LAS unsigned char* lds, const Gemm g, const Sched& S, const Epi& E) {
    const int tid = threadIdx.x, wid = __builtin_amdgcn_readfirstlane(tid >> 6), lane = tid & 63, wr = wid >> 2, wc = wid & 3, fr = lane & 15, fq = lane >> 4;
    const int K = g.K, nt = K / BK;
    unsigned voffA[2], voffB[2];
#pragma unroll
    for (int i = 0; i < 2; ++i) { int R, C; stage_rc(tid * 16 + i * 8192, R, C); const int Rb = Epi::PERM ? ((R & ~31) + perm32(R & 31)) : R;
        voffA[i] = (unsigned)(R * K + C) * 2u; voffB[i] = (unsigned)(Rb * K + C) * 2u; }
    const size_t kstep = (size_t)(BK * 2);
    const size_t hstep = (size_t)HALF * K * 2;
    const size_t tstep = 2 * hstep;
    const unsigned ldsw = (unsigned)wid * 1024u;
    const int aoff = lds_byte(wr * 64 + fr, fq * 8), boff = lds_byte(wc * 32 + fr, fq * 8);
#define PG8_SA(b, h) (((b) * 2 + (h)) * HTB)
#define PG8_SB(b, h) ((4 + (b) * 2 + (h)) * HTB)
#define PG8_STAGE(bufoff, gbase, voff) do { _Pragma("unroll") for (int _i = 0; _i < 2; ++_i) \
        __builtin_amdgcn_global_load_lds((const unsigned*)((const char*)(gbase) + (voff)[_i]), (PG8_LAS unsigned*)(lds + (bufoff) + ldsw + _i * 8192), 16, 0, 0); } while (0)
#define PG8_LDA(dst, b, h) do { _Pragma("unroll") for (int m = 0; m < 4; ++m) _Pragma("unroll") for (int k = 0; k < 2; ++k) dst[m][k] = *(const PG8_LAS bf16x8*)(lds + PG8_SA(b, h) + aoff + m * 2048 + k * 1024); } while (0)
#define PG8_LDB(dst, b, h) do { _Pragma("unroll") for (int n = 0; n < 2; ++n) _Pragma("unroll") for (int k = 0; k < 2; ++k) dst[n][k] = *(const PG8_LAS bf16x8*)(lds + PG8_SB(b, h) + boff + n * 2048 + k * 1024); } while (0)
#define PG8_MMA_LOOP(ai, bj, At, Bt, SEL) _Pragma("unroll") for (int m = 0; m < 4; ++m) _Pragma("unroll") for (int n = 0; n < 2; ++n) _Pragma("unroll") for (int k = 0; k < 2; ++k) \
        acc[ai][bj][m][n] = mma_sel<SEL>(Bt[n][k], At[m][k], acc[ai][bj][m][n]);
#define PG8_MMA(ai, bj, At, Bt) do { __builtin_amdgcn_s_setprio(1); \
        if constexpr (KSW > 0) { if (i8m) { PG8_MMA_LOOP(ai, bj, At, Bt, true) } else { PG8_MMA_LOOP(ai, bj, At, Bt, false) } } else { PG8_MMA_LOOP(ai, bj, At, Bt, I8) } \
        __builtin_amdgcn_s_setprio(0); } while (0)
#define PG8_WAIT_V(n) asm volatile("s_waitcnt vmcnt(" #n ")" ::: "memory")
#define PG8_WAIT_L(n) asm volatile("s_waitcnt lgkmcnt(" #n ")" ::: "memory")
#define PG8_BAR __builtin_amdgcn_s_barrier()
#define PG8_SCHED __builtin_amdgcn_sched_barrier(0)
    Unit cur, nxt; int ui = 0;
    if (!S.next(0, cur)) return;
    f32x4 acc[2][2][4][2];
#pragma unroll
    for (int a = 0; a < 2; ++a)
#pragma unroll
        for (int b = 0; b < 2; ++b)
#pragma unroll
            for (int m = 0; m < 4; ++m)
#pragma unroll
                for (int n = 0; n < 2; ++n) acc[a][b][m][n] = (f32x4){0.f, 0.f, 0.f, 0.f};
    bf16x8 At[4][2], B0[2][2], B1[2][2];
    const char* cA = (const char*)g.A + (size_t)cur.pm * tstep; const char* cB = (const char*)g.Bt + (size_t)cur.pn * tstep;
    S.a_ready(cur);
    if constexpr (SP2) {
        PG8_STAGE(PG8_SB(0, 0), cB, voffB); PG8_STAGE(PG8_SB(0, 1), cB + hstep, voffB); PG8_STAGE(PG8_SA(0, 0), cA, voffA); PG8_STAGE(PG8_SA(0, 1), cA + hstep, voffA);
        if (wr == 1) PG8_BAR;
        PG8_WAIT_V(2); PG8_BAR;
        PG8_STAGE(PG8_SB(1, 0), cB + kstep, voffB); PG8_STAGE(PG8_SA(1, 0), cA + kstep, voffA); PG8_STAGE(PG8_SB(1, 1), cB + hstep + kstep, voffB);
        PG8_WAIT_V(6); PG8_BAR;
    } else {
        PG8_STAGE(PG8_SB(0, 0), cB, voffB); PG8_STAGE(PG8_SA(0, 0), cA, voffA); PG8_STAGE(PG8_SB(0, 1), cB + hstep, voffB); PG8_STAGE(PG8_SA(0, 1), cA + hstep, voffA);
        if (wr == 1) PG8_BAR;
        PG8_WAIT_V(4); PG8_BAR;
        PG8_STAGE(PG8_SB(1, 0), cB + kstep, voffB); PG8_STAGE(PG8_SA(1, 0), cA + kstep, voffA); PG8_STAGE(PG8_SB(1, 1), cB + hstep + kstep, voffB);
        PG8_WAIT_V(6); PG8_BAR;
    }
    for (;;) {
        const bool has_next = S.next(ui + 1, nxt);
        const char* nA = has_next ? (const char*)g.A + (size_t)nxt.pm * tstep : cA; const char* nB = has_next ? (const char*)g.Bt + (size_t)nxt.pn * tstep : cB;
#pragma unroll
        for (int seg = 0; seg < (KSW > 0 ? 2 : 1); ++seg) {
        const bool i8m = (seg == 0); (void)i8m;
        if constexpr (KSW > 0) { if (seg == 1) E.to_float(acc, cur, wr, wc, fr, fq); }
        for (int t = (seg ? KSW : 0); t < ((KSW > 0 && seg == 0) ? KSW : nt); t += 2) {
            const bool last = (t == nt - 2);
            const char* a1 = cA + (size_t)(t + 1) * kstep;
            const char* a2 = last ? nA : cA + (size_t)(t + 2) * kstep; const char* b2 = last ? nB : cB + (size_t)(t + 2) * kstep;
            const char* a3 = a2 + kstep; const char* b3 = b2 + kstep;
            if (last && has_next) S.a_ready(nxt);
            if constexpr (SP2) {
            PG8_LDB(B0, 0, 0); PG8_LDB(B1, 0, 1); PG8_SCHED; PG8_LDA(At, 0, 0); PG8_STAGE(PG8_SA(1, 1), a1 + hstep, voffA);
            PG8_WAIT_V(8); PG8_WAIT_L(0); PG8_BAR; PG8_MMA(0, 0, At, B0); PG8_MMA(0, 1, At, B1); PG8_BAR; PG8_SCHED;
            PG8_LDA(At, 0, 1); PG8_STAGE(PG8_SB(0, 0), b2, voffB); PG8_STAGE(PG8_SB(0, 1), b2 + hstep, voffB); PG8_STAGE(PG8_SA(0, 0), a2, voffA);
            PG8_WAIT_V(8); PG8_WAIT_L(0); PG8_BAR; PG8_MMA(1, 0, At, B0); PG8_MMA(1, 1, At, B1); PG8_BAR; PG8_SCHED;
            PG8_LDB(B0, 1, 0); PG8_LDB(B1, 1, 1); PG8_SCHED; PG8_LDA(At, 1, 0); PG8_STAGE(PG8_SA(0, 1), a2 + hstep, voffA);
            PG8_WAIT_V(8); PG8_WAIT_L(0); PG8_BAR; PG8_MMA(0, 0, At, B0); PG8_MMA(0, 1, At, B1); PG8_BAR; PG8_SCHED;
            PG8_LDA(At, 1, 1); PG8_STAGE(PG8_SB(1, 0), b3, voffB); PG8_STAGE(PG8_SB(1, 1), b3 + hstep, voffB); PG8_STAGE(PG8_SA(1, 0), a3, voffA);
            PG8_WAIT_V(8); PG8_WAIT_L(0); PG8_BAR; PG8_MMA(1, 0, At, B0); PG8_MMA(1, 1, At, B1); PG8_BAR; PG8_SCHED;
            } else {
            PG8_LDB(B0, 0, 0); PG8_SCHED; PG8_LDA(At, 0, 0); PG8_STAGE(PG8_SA(1, 1), a1 + hstep, voffA);
            PG8_WAIT_L(8); PG8_BAR; PG8_WAIT_L(0); PG8_MMA(0, 0, At, B0); PG8_BAR; PG8_SCHED;
            PG8_LDB(B1, 0, 1); PG8_STAGE(PG8_SB(0, 0), b2, voffB);
            PG8_BAR; PG8_WAIT_L(0); PG8_MMA(0, 1, At, B1); PG8_BAR;
            PG8_LDA(At, 0, 1); PG8_STAGE(PG8_SA(0, 0), a2, voffA);
            PG8_BAR; PG8_WAIT_L(0); PG8_MMA(1, 0, At, B0); PG8_BAR; PG8_SCHED;
            PG8_STAGE(PG8_SB(0, 1), b2 + hstep, voffB);
            PG8_WAIT_V(6); PG8_BAR; PG8_MMA(1, 1, At, B1); PG8_BAR;
            PG8_LDB(B0, 1, 0); PG8_SCHED; PG8_LDA(At, 1, 0); PG8_STAGE(PG8_SA(0, 1), a2 + hstep, voffA);
            PG8_WAIT_L(8); PG8_BAR; PG8_WAIT_L(0); PG8_MMA(0, 0, At, B0); PG8_BAR; PG8_SCHED;
            PG8_LDB(B1, 1, 1); PG8_STAGE(PG8_SB(1, 0), b3, voffB);
            PG8_BAR; PG8_WAIT_L(0); PG8_MMA(0, 1, At, B1); PG8_BAR;
            PG8_LDA(At, 1, 1); PG8_STAGE(PG8_SA(1, 0), a3, voffA);
            PG8_BAR; PG8_WAIT_L(0); PG8_MMA(1, 0, At, B0); PG8_BAR; PG8_SCHED;
            PG8_STAGE(PG8_SB(1, 1), b3 + hstep, voffB);
            PG8_WAIT_V(6); PG8_BAR; PG8_MMA(1, 1, At, B1); PG8_BAR;
            }
        }
        }
        if constexpr (ALIGN_EPI) { if (wr == 0) PG8_BAR; }
        if constexpr (!Epi::AFTER_DRAIN) { E(acc, cur, wr, wc, fr, fq); S.done(cur); }
        if (!has_next) break;
#pragma unroll
        for (int a = 0; a < 2; ++a)
#pragma unroll
            for (int b = 0; b < 2; ++b)
#pragma unroll
                for (int m = 0; m < 4; ++m)
#pragma unroll
                    for (int n = 0; n < 2; ++n) acc[a][b][m][n] = (f32x4){0.f, 0.f, 0.f, 0.f};
        cur = nxt; cA = nA; cB = nB; ++ui;
        if constexpr (ALIGN_EPI) { if (wr == 1) PG8_BAR; }
    }
    PG8_WAIT_V(0);
    if constexpr (!ALIGN_EPI) { if (wr == 0) PG8_BAR; }
    PG8_BAR;
    if constexpr (Epi::AFTER_DRAIN) { E.fused(acc, cur, wr, wc, fr, fq, lds, wid, lane); S.done(cur); }
#undef PG8_SA
#undef PG8_SB
#undef PG8_STAGE
#undef PG8_LDA
#undef PG8_LDB
#undef PG8_MMA
#undef PG8_MMA_LOOP
#undef PG8_WAIT_V
#undef PG8_WAIT_L
#undef PG8_BAR
#undef PG8_SCHED
}
}

struct Args { const float* in[16]; float* out; unsigned char* ws; int ph_lo, ph_hi; };
enum { I_X = 0, I_WIN, I_KVG, I_WUK, I_WUV, I_LBL, I_HGN, I_WOUT, I_LN1G, I_LN1B, I_PWQ, I_PSK, I_PU, I_PV, I_LN2G, I_LN2B };

struct Ctx {
    LAS unsigned char* lds; int tid, lane, wave; int G, bid;
    const float* in[16]; float* out; unsigned char* ws;
};

template <class ColMap>
__device__ __forceinline__ void tr_tile(const Ctx& C, const float* src, int ld_src, int k0, int n0, const ColMap& cm, u16* dst, int ld_dst, int koff) {
    LAS float* T = (LAS float*)C.lds;
    const int nn = C.tid & 63, kq = C.tid >> 6;
    const int col = cm(n0 + nn);
#pragma unroll
    for (int i = 0; i < 8; ++i) { const int kk = kq + 8 * i; T[kk * 65 + nn] = col >= 0 ? src[(size_t)(k0 + kk) * ld_src + col] : 0.f; }
    __syncthreads();
    const int kk2 = C.tid & 63, nq = C.tid >> 6;
#pragma unroll
    for (int i = 0; i < 8; ++i) { const int n2 = nq + 8 * i; const float v = T[kk2 * 65 + n2];
        dst[(size_t)(n0 + n2) * ld_dst + koff + k0 + kk2] = (u16)(cvtpk(v, 0.f) & 0xffffu); }
    __syncthreads();
}

__device__ __forceinline__ int w1_col(int n) {
    if (n < 1536) return 640 + (n - 1024);
    if (n < 1792) { const int j = n - 1536; return j < 128 ? 512 + j : (j < 192 ? 1152 + (j - 128) : (j < 200 ? 1216 + (j - 192) : -1)); }
    const int j = n - 1792, h = j >> 8, part = (j & 255) >> 6, e = j & 63;
    return 1224 + part * 512 + h * 64 + e;
}

__device__ __forceinline__ void cvt_copy(const Ctx& C, const float* src, u16* dst, size_t n8) {
    const size_t stride = (size_t)C.G * NTHREADS;
    for (size_t i = (size_t)C.bid * NTHREADS + C.tid; i < n8; i += stride) {
        const f32x4v a = *(const f32x4v*)(src + i * 8), b = *(const f32x4v*)(src + i * 8 + 4);
        u32x4v w; w.x = cvtpk(a[0], a[1]); w.y = cvtpk(a[2], a[3]); w.z = cvtpk(b[0], b[1]); w.w = cvtpk(b[2], b[3]);
        *(u32x4v*)(dst + i * 8) = w;
    }
}

__device__ __forceinline__ void quant_rows_fp8(const Ctx& C, const float* src, unsigned char* dst, float* inv, int nrows) {
    const int lane = C.lane, gw = C.bid * 8 + C.wave, nw = C.G * 8;
    for (int r = gw; r < nrows; r += nw) {
        f32x4v v[4];
#pragma unroll
        for (int i = 0; i < 4; ++i) v[i] = *(const f32x4v*)(src + (size_t)r * 1024 + lane * 16 + 4 * i);
        float am = 0.f;
#pragma unroll
        for (int i = 0; i < 4; ++i) am = fmaxf(am, fmaxf(fmaxf(fabsf(v[i][0]), fabsf(v[i][1])), fmaxf(fabsf(v[i][2]), fabsf(v[i][3]))));
        am = wave_max_f(am);
        const int e = (int)((__builtin_bit_cast(unsigned, am) >> 23) & 0xffu) - 126;
        int k = 8 - e; k = k > 100 ? 100 : (k < -100 ? -100 : k); if (am == 0.f) k = 0;
        const float s = __builtin_bit_cast(float, (unsigned)(127 + k) << 23), si = __builtin_bit_cast(float, (unsigned)(127 - k) << 23);
        u32x4v w;
#pragma unroll
        for (int i = 0; i < 4; ++i) { int t = 0; t = __builtin_amdgcn_cvt_pk_fp8_f32(v[i][0] * s, v[i][1] * s, t, false); t = __builtin_amdgcn_cvt_pk_fp8_f32(v[i][2] * s, v[i][3] * s, t, true); w[i] = (unsigned)t; }
        *(u32x4v*)(dst + ((size_t)(lane >> 3) * nrows + r) * 128 + (lane & 7) * 16) = w;
        if (lane == 0) inv[r] = si;
    }
}

template <bool SLICED = true>
__device__ __forceinline__ void quant_rows_i8(const Ctx& C, const float* src, unsigned char* dst, float* inv, int nrows) {
    const int lane = C.lane, gw = C.bid * 8 + C.wave, nw = C.G * 8;
    f32x4v vn[4];
    if (gw < nrows) {
#pragma unroll
        for (int i = 0; i < 4; ++i) vn[i] = *(const f32x4v*)(src + (size_t)gw * 1024 + lane * 16 + 4 * i); }
    for (int r = gw; r < nrows; r += nw) {
        f32x4v v[4];
#pragma unroll
        for (int i = 0; i < 4; ++i) v[i] = vn[i];
        { const int rn = r + nw < nrows ? r + nw : r;
#pragma unroll
          for (int i = 0; i < 4; ++i) vn[i] = *(const f32x4v*)(src + (size_t)rn * 1024 + lane * 16 + 4 * i); }
        float am = 0.f;
#pragma unroll
        for (int i = 0; i < 4; ++i) am = fmaxf(am, fmaxf(fmaxf(fabsf(v[i][0]), fabsf(v[i][1])), fmaxf(fabsf(v[i][2]), fabsf(v[i][3]))));
        am = wave_max_f(am);
        const float s = am > 0.f ? 127.f / am : 0.f;
        u32x4v w;
#pragma unroll
        for (int i = 0; i < 4; ++i) w[i] = pack_i8(v[i][0] * s, v[i][1] * s, v[i][2] * s, v[i][3] * s);
        if constexpr (SLICED) *(u32x4v*)(dst + ((size_t)(lane >> 3) * nrows + r) * 128 + (lane & 7) * 16) = w;
        else *(u32x4v*)(dst + (size_t)r * 1024 + lane * 16) = w;
        if (lane == 0) inv[r] = am * (1.f / 127.f);
    }
}

__device__ __forceinline__ void quant_wrows_i8(const Ctx& C, const u16* src, unsigned char* dst, float* sc, int nrows) {
    const int lane = C.lane, gw = C.bid * 8 + C.wave, nw = C.G * 8;
    for (int r = gw; r < nrows; r += nw) {
        const u32x4v y0 = *(const u32x4v*)(src + (size_t)r * 1024 + lane * 16), y1 = *(const u32x4v*)(src + (size_t)r * 1024 + lane * 16 + 8);
        float v[16]; float am = 0.f;
#pragma unroll
        for (int j = 0; j < 4; ++j) { v[2 * j] = bf_lo(y0[j]); v[2 * j + 1] = bf_hi(y0[j]); v[8 + 2 * j] = bf_lo(y1[j]); v[8 + 2 * j + 1] = bf_hi(y1[j]); }
#pragma unroll
        for (int j = 0; j < 16; ++j) am = fmaxf(am, fabsf(v[j]));
        am = wave_max_f(am);
        const float s = am > 0.f ? 127.f / am : 0.f;
        u32x4v w;
#pragma unroll
        for (int i = 0; i < 4; ++i) w[i] = pack_i8(v[4 * i] * s, v[4 * i + 1] * s, v[4 * i + 2] * s, v[4 * i + 3] * s);
        *(u32x4v*)(dst + (size_t)r * 1024 + lane * 16) = w;
        if (lane == 0) sc[r] = am * (1.f / 127.f);
    }
}
__device__ __forceinline__ void quant_w3_mixed(const Ctx& C) {
    const u16* src = (const u16*)(C.ws + WS_W3T); unsigned char* dst = C.ws + WS_W3M; float* sc = (float*)(C.ws + WS_W3S);
    const int lane = C.lane, gw = C.bid * 8 + C.wave, nw = C.G * 8;
    for (int r = gw; r < DM; r += nw) {
        const u32x4v y0 = *(const u32x4v*)(src + (size_t)r * K3 + lane * 16), y1 = *(const u32x4v*)(src + (size_t)r * K3 + lane * 16 + 8);
        const u32x4v hb = *(const u32x4v*)(src + (size_t)r * K3 + 1024 + lane * 8);
        float v[16]; float am = 0.f;
#pragma unroll
        for (int j = 0; j < 4; ++j) { v[2 * j] = bf_lo(y0[j]); v[2 * j + 1] = bf_hi(y0[j]); v[8 + 2 * j] = bf_lo(y1[j]); v[8 + 2 * j + 1] = bf_hi(y1[j]); }
#pragma unroll
        for (int j = 0; j < 16; ++j) am = fmaxf(am, fabsf(v[j]));
        am = wave_max_f(am);
        if (am == 0.f) am = 127.f;
        const float s = 127.f / am;
        u32x4v w, hs;
#pragma unroll
        for (int i = 0; i < 4; ++i) { w[i] = pack_i8(v[4 * i] * s, v[4 * i + 1] * s, v[4 * i + 2] * s, v[4 * i + 3] * s); hs[i] = cvtpk(bf_lo(hb[i]) * s, bf_hi(hb[i]) * s); }
        *(u32x4v*)(dst + (size_t)r * MIXB + lane * 16) = w;
        *(u32x4v*)(dst + (size_t)r * MIXB + 1024 + lane * 16) = hs;
        if (lane == 0) sc[r] = am * (1.f / 127.f);
    }
}
__device__ __forceinline__ void p0b_quant(const Ctx& C) {
    quant_w3_mixed(C);
    quant_wrows_i8(C, (const u16*)(C.ws + WS_W5T), C.ws + WS_W5Q, (float*)(C.ws + WS_W5S), NPQ);
    quant_wrows_i8(C, (const u16*)(C.ws + WS_W1T), C.ws + WS_W1Q, (float*)(C.ws + WS_W1S), N1);
}

__device__ __forceinline__ void p0_prologue(const Ctx& C) {
    unsigned char* ws = C.ws;
    if (C.bid == 0 && C.tid < 64) ((unsigned*)(ws + WS_CTL))[C.tid] = 0u;
    if (C.bid == 0) {
        const float* l = C.in[I_LBL]; float* lb = (float*)(ws + WS_LB);
        const float a = l[C.tid], b = l[512 + C.tid]; lb[C.tid] = 1.f / (1.f + expf(b - a));
    }
    quant_rows_i8<false>(C, C.in[I_X], ws + WS_XB, (float*)(ws + WS_XS), MTOK);
    quant_rows_i8(C, C.in[I_PU], ws + WS_UB, (float*)(ws + WS_USC), 16384);
    quant_rows_i8(C, C.in[I_PV], ws + WS_VB, (float*)(ws + WS_VSC), 16384);
    cvt_copy(C, C.in[I_PSK], (u16*)(ws + WS_SKB), (size_t)8 * 2 * 128 * 128 / 8);
    const float* w_in = C.in[I_WIN]; const float* w_out = C.in[I_WOUT]; const float* wq = C.in[I_PWQ];
    const float* kvg = C.in[I_KVG]; const float* wuk = C.in[I_WUK]; const float* wuv = C.in[I_WUV];
    u16* W1T = (u16*)(ws + WS_W1T); u16* W3T = (u16*)(ws + WS_W3T); u16* W5T = (u16*)(ws + WS_W5T);
    constexpr int T_W1F = 256, T_W1P = 44 * 16, T_W3F = 256, T_W3P = 16 * 8, T_W5 = 32 * 16, T_ALL = T_W1F + T_W1P + T_W3F + T_W3P + T_W5;
    LAS float* TA = (LAS float*)C.lds;
    LAS float* TB = TA + 64 * 65;
    for (int task = C.bid; task < T_ALL; task += C.G) {
        int t = task;
        if (t < T_W1F) {
            const int h = t >> 5, cb = (t >> 4) & 1, kb = t & 15, c0 = cb * 64, k0 = kb * 64;
            { const int d = C.tid & 63, q = C.tid >> 6;
#pragma unroll
              for (int i = 0; i < 8; ++i) { const int r = q + 8 * i; TA[r * 65 + d] = w_in[(size_t)(k0 + r) * DIN + h * 64 + d]; TB[r * 65 + d] = wuk[(size_t)(h * 128 + c0 + r) * 64 + d]; } }
            __syncthreads();
            { const int kk = C.tid & 63, q = C.tid >> 6;
#pragma unroll
              for (int i = 0; i < 8; ++i) { const int cc = q + 8 * i; float s = 0.f;
#pragma unroll 8
                  for (int d = 0; d < 64; ++d) s += TA[kk * 65 + d] * TB[cc * 65 + d];
                  s *= kvg[c0 + cc] * 0.125f;
                  W1T[(size_t)(h * 128 + c0 + cc) * 1024 + k0 + kk] = (u16)(cvtpk(s, 0.f) & 0xffffu); } }
            __syncthreads();
            continue;
        }
        t -= T_W1F;
        if (t < T_W1P) { const int nb = t >> 4, kb = t & 15; tr_tile(C, w_in, DIN, kb * 64, 1024 + nb * 64, [](int n) { return w1_col(n); }, W1T, 1024, 0); continue; }
        t -= T_W1P;
        if (t < T_W3F) {
            const int h = t >> 5, cb = (t >> 4) & 1, nb = t & 15, c0 = cb * 64, n0 = nb * 64;
            { const int x = C.tid & 63, q = C.tid >> 6;
#pragma unroll
              for (int i = 0; i < 8; ++i) { const int r = q + 8 * i; TA[r * 65 + x] = w_out[(size_t)(h * 64 + r) * 1024 + n0 + x]; TB[r * 65 + x] = wuv[(size_t)(h * 128 + c0 + r) * 64 + x]; } }
            __syncthreads();
            { const int cc = C.tid & 63, q = C.tid >> 6;
#pragma unroll
              for (int i = 0; i < 8; ++i) { const int nn = q + 8 * i; float s = 0.f;
#pragma unroll 8
                  for (int d = 0; d < 64; ++d) s += TB[cc * 65 + d] * TA[d * 65 + nn];
                  s *= kvg[c0 + cc];
                  W3T[(size_t)(n0 + nn) * K3 + h * 128 + c0 + cc] = (u16)(cvtpk(s, 0.f) & 0xffffu); } }
            __syncthreads();
            continue;
        }
        t -= T_W3F;
        if (t < T_W3P) { const int nb = t >> 3, kb = t & 7; tr_tile(C, w_out + (size_t)512 * 1024, 1024, kb * 64, nb * 64, [](int n) { return n; }, W3T, K3, 1024); continue; }
        t -= T_W3P;
        { const int nb = t >> 4, kb = t & 15; tr_tile(C, wq, NPQ, kb * 64, nb * 64, [](int n) { return n; }, W5T, 1024, 0); }
    }
}

#ifndef MK_CUSTOM_BAR
#define MK_CUSTOM_BAR 0
#endif
__device__ __forceinline__ void grid_bar(const Ctx& C, unsigned& target, int word = 24) {
    __syncthreads();
    if (C.tid == 0) {
        unsigned* ctr = (unsigned*)(C.ws + WS_CTL) + word;
        __builtin_amdgcn_fence(__ATOMIC_RELEASE, "agent");
        asm volatile("s_waitcnt vmcnt(0)" ::: "memory");
        __hip_atomic_fetch_add(ctr, 1u, __ATOMIC_RELAXED, __HIP_MEMORY_SCOPE_AGENT);
        target += (unsigned)C.G;
        for (unsigned spin = 0; spin < (1u << 24); ++spin) { if (__hip_atomic_load(ctr, __ATOMIC_RELAXED, __HIP_MEMORY_SCOPE_AGENT) >= target) break; __builtin_amdgcn_s_sleep(1); }
        __builtin_amdgcn_fence(__ATOMIC_ACQUIRE, "agent");
        asm volatile("s_waitcnt vmcnt(0)" ::: "memory");
    }
    __syncthreads();
}


__device__ __forceinline__ f32x4v mfma16(s16x8 a, s16x8 b, f32x4v c) { return __builtin_amdgcn_mfma_f32_16x16x32_bf16(a, b, c, 0, 0, 0); }
__device__ __forceinline__ f32x16v mfma32(s16x8 a, s16x8 b, f32x16v c) { return __builtin_amdgcn_mfma_f32_32x32x16_bf16(a, b, c, 0, 0, 0); }
__device__ __forceinline__ s16x4 tr4(const LAS u16* p) { return __builtin_bit_cast(s16x4, __builtin_amdgcn_ds_read_tr16_b64_v4i16((LAS s16x4*)p)); }
__device__ __forceinline__ s16x8 cat4(s16x4 a, s16x4 b) { s16x8 r; r[0] = a[0]; r[1] = a[1]; r[2] = a[2]; r[3] = a[3]; r[4] = b[0]; r[5] = b[1]; r[6] = b[2]; r[7] = b[3]; return r; }
__device__ __forceinline__ s16x8 pack8f(const f32x4v& a, const f32x4v& b) { u32x4v w; w.x = cvtpk(a[0], a[1]); w.y = cvtpk(a[2], a[3]); w.z = cvtpk(b[0], b[1]); w.w = cvtpk(b[2], b[3]); return __builtin_bit_cast(s16x8, w); }

__device__ __forceinline__ float scan32_incl(float v) {
    v += __builtin_bit_cast(float, __builtin_amdgcn_update_dpp(0, __builtin_bit_cast(int, v), 0x111, 0xf, 0xf, true));
    v += __builtin_bit_cast(float, __builtin_amdgcn_update_dpp(0, __builtin_bit_cast(int, v), 0x112, 0xf, 0xf, true));
    v += __builtin_bit_cast(float, __builtin_amdgcn_update_dpp(0, __builtin_bit_cast(int, v), 0x114, 0xf, 0xf, true));
    v += __builtin_bit_cast(float, __builtin_amdgcn_update_dpp(0, __builtin_bit_cast(int, v), 0x118, 0xf, 0xf, true));
    v += __builtin_bit_cast(float, __builtin_amdgcn_update_dpp(0, __builtin_bit_cast(int, v), 0x142, 0xa, 0xf, false));
    return v;
}
constexpr int HG_SET = 16640, HG_OI = 2 * HG_SET, HG_SSQ = HG_OI + 2 * 8192;

__device__ __forceinline__ void hgrn_seq(const Ctx& C, int bh) {
    const int b = bh >> 3, h = bh & 7;
    const int tid = C.tid, lane = C.lane, wave = C.wave, fr = lane & 15, fq = lane >> 4;
    unsigned char* ws = C.ws;
    const u16* HQ = (const u16*)(ws + WS_HQ); const float* HLF = (const float*)(ws + WS_HLF); const u16* HV = (const u16*)(ws + WS_HV); const u16* HG = (const u16*)(ws + WS_HG);
    u16* MIX = (u16*)(ws + WS_MIX);
    const size_t rowbase = (size_t)b * SEQ;
    constexpr int NCH = SEQ / 32;
    LAS float* SSQ = (LAS float*)(C.lds + HG_SSQ);
    if (wave >= 4) {
        const int t = lane & 31, cg = (tid - 256) >> 5;
        f32x4v gn0 = *(const f32x4v*)(C.in[I_HGN] + 8 * cg), gn1 = *(const f32x4v*)(C.in[I_HGN] + 8 * cg + 4);
        f32x4v lfa[4], lfb[4]; u32x4v qv[4], vv[4], gg[4]; u32x4v gp1 = {0u, 0u, 0u, 0u}, gp2 = gp1;
#define HG_LOAD(k_, n_) do { const int nc_ = (n_) < NCH ? (n_) : NCH - 1; const size_t o_ = (rowbase + (size_t)nc_ * 32 + t) * 512 + h * 64 + 8 * cg; lfa[k_] = *(const f32x4v*)(HLF + o_); lfb[k_] = *(const f32x4v*)(HLF + o_ + 4); \
            qv[k_] = *(const u32x4v*)(HQ + o_); vv[k_] = *(const u32x4v*)(HV + o_); gg[k_] = *(const u32x4v*)(HG + o_); } while (0)
        HG_LOAD(0, 0); HG_LOAD(1, 1); HG_LOAD(2, 2); HG_LOAD(3, 3);
#define S_BODY(n, k) { \
              \
            if ((n) >= 1) { \
                const LAS float* OI = (const LAS float*)(C.lds + HG_OI) + (((n) - 1) & 1) * 2048; \
                const LAS float* sq = SSQ + (((n) - 1) & 1) * 128; \
                const float rstd = __builtin_amdgcn_rsqf(((sq[t] + sq[32 + t]) + (sq[64 + t] + sq[96 + t])) * (1.f / 64.f) + EPS); \
                float o[8]; \
                _Pragma("unroll") for (int j = 0; j < 8; ++j) o[j] = OI[(8 * cg + j) * 32 + t] * rstd; \
                u32x4v w; \
                w.x = cvtpk(o[0] * gn0[0] * bf_lo(gp2.x), o[1] * gn0[1] * bf_hi(gp2.x)); w.y = cvtpk(o[2] * gn0[2] * bf_lo(gp2.y), o[3] * gn0[3] * bf_hi(gp2.y)); \
                w.z = cvtpk(o[4] * gn1[0] * bf_lo(gp2.z), o[5] * gn1[1] * bf_hi(gp2.z)); w.w = cvtpk(o[6] * gn1[2] * bf_lo(gp2.w), o[7] * gn1[3] * bf_hi(gp2.w)); \
                *(u32x4v*)(MIX + (rowbase + (size_t)((n) - 1) * 32 + t) * (MIXB / 2) + 512 + h * 64 + 8 * cg) = w;     \
            } \
              \
            if ((n) + 1 < NCH) { \
                LAS unsigned char* S_ = C.lds + (((n) + 1) & 1) * HG_SET; \
                LAS u16* QT = (LAS u16*)S_; LAS u16* KT = QT + 2048; LAS u16* KDT = KT + 2048; LAS u16* VS = KDT + 2048; LAS float* DEC = (LAS float*)(VS + 2048); \
                float lf[8], qf[8]; \
                _Pragma("unroll") for (int j = 0; j < 4; ++j) { lf[j] = lfa[k][j]; lf[4 + j] = lfb[k][j]; qf[2 * j] = bf_lo(qv[k][j]); qf[2 * j + 1] = bf_hi(qv[k][j]); } \
                float qt[8], kt[8], kd[8], dc[8]; \
                _Pragma("unroll") for (int j = 0; j < 8; ++j) { \
                    const float bcum = scan32_incl(lf[j]); \
                    const float bl31 = __builtin_bit_cast(float, __builtin_amdgcn_readlane(__builtin_bit_cast(int, bcum), 31)), bl63 = __builtin_bit_cast(float, __builtin_amdgcn_readlane(__builtin_bit_cast(int, bcum), 63)); \
                    const float bl = lane < 32 ? bl31 : bl63; \
                    const float kk = 1.f - fast_exp(lf[j]); \
                    qt[j] = qf[j] * fast_exp(bcum); kt[j] = kk * fast_exp(-bcum); kd[j] = kk * fast_exp(bl - bcum); dc[j] = fast_exp(bl); \
                } \
                { u32x4v w; w.x = cvtpk(qt[0], qt[1]); w.y = cvtpk(qt[2], qt[3]); w.z = cvtpk(qt[4], qt[5]); w.w = cvtpk(qt[6], qt[7]); *(LAS u32x4v*)(QT + t * 64 + 8 * cg) = w; \
                  w.x = cvtpk(kt[0], kt[1]); w.y = cvtpk(kt[2], kt[3]); w.z = cvtpk(kt[4], kt[5]); w.w = cvtpk(kt[6], kt[7]); *(LAS u32x4v*)(KT + t * 64 + 8 * cg) = w; \
                  *(LAS u32x4v*)(VS + t * 64 + 8 * cg) = vv[k]; \
                  _Pragma("unroll") for (int j = 0; j < 8; ++j) KDT[(8 * cg + j) * 32 + t] = (u16)(cvtpk(kd[j], 0.f) & 0xffffu); \
                  if (t == 0) { *(LAS f32x4v*)(DEC + 8 * cg) = (f32x4v){dc[0], dc[1], dc[2], dc[3]}; *(LAS f32x4v*)(DEC + 8 * cg + 4) = (f32x4v){dc[4], dc[5], dc[6], dc[7]}; } } \
                gp2 = gp1; gp1 = gg[k]; \
            } else { gp2 = gp1; } \
            HG_LOAD(k, (n) + 5);                                             \
            __syncthreads(); }
        for (int n0 = -1; ; n0 += 4) {
            S_BODY(n0, 0) S_BODY(n0 + 1, 1)
            if (n0 + 1 >= NCH) break;
            S_BODY(n0 + 2, 2) S_BODY(n0 + 3, 3)
        }
#undef S_BODY
#undef HG_LOAD
    } else {
        const int et = wave;
        f32x4v Sst[4];
#pragma unroll
        for (int i = 0; i < 4; ++i) Sst[i] = (f32x4v){0.f, 0.f, 0.f, 0.f};
        const int q = (lane & 15) >> 2, p = lane & 3;
        for (int n = -1; n <= NCH; ++n) {
            if (n >= 0 && n < NCH) {
                LAS unsigned char* S_ = C.lds + (n & 1) * HG_SET;
                const LAS u16* QT = (const LAS u16*)S_; const LAS u16* KT = QT + 2048; const LAS u16* KDT = KT + 2048; const LAS u16* VS = KDT + 2048; const LAS float* DEC = (const LAS float*)(VS + 2048);
                LAS float* OI = (LAS float*)(C.lds + HG_OI) + (n & 1) * 2048;
                f32x4v oi[2] = {{0.f, 0.f, 0.f, 0.f}, {0.f, 0.f, 0.f, 0.f}};
#pragma unroll
                for (int ks = 0; ks < 2; ++ks) {
                    const s16x8 sa = pack8f(Sst[2 * ks], Sst[2 * ks + 1]);
#pragma unroll
                    for (int tt = 0; tt < 2; ++tt) {
                        const s16x4 lo = *(const LAS s16x4*)(QT + (16 * tt + fr) * 64 + 32 * ks + 4 * fq), hi = *(const LAS s16x4*)(QT + (16 * tt + fr) * 64 + 32 * ks + 16 + 4 * fq);
                        oi[tt] = mfma16(sa, cat4(lo, hi), oi[tt]);
                    }
                }
                f32x4v a00 = {0.f, 0.f, 0.f, 0.f}, a10 = a00, a11 = a00;
#pragma unroll
                for (int ks = 0; ks < 2; ++ks) {
                    const s16x8 k0 = *(const LAS s16x8*)(KT + fr * 64 + 32 * ks + 8 * fq), k1 = *(const LAS s16x8*)(KT + (16 + fr) * 64 + 32 * ks + 8 * fq);
                    const s16x8 q0 = *(const LAS s16x8*)(QT + fr * 64 + 32 * ks + 8 * fq), q1 = *(const LAS s16x8*)(QT + (16 + fr) * 64 + 32 * ks + 8 * fq);
                    a00 = mfma16(k0, q0, a00); a10 = mfma16(k0, q1, a10); a11 = mfma16(k1, q1, a11);
                }
#pragma unroll
                for (int i = 0; i < 4; ++i) { const bool keep = (4 * fq + i) <= fr; a00[i] = keep ? a00[i] : 0.f; a11[i] = keep ? a11[i] : 0.f; }
                const f32x4v z = {0.f, 0.f, 0.f, 0.f};
                const s16x8 pb0 = pack8f(a00, z), pb1 = pack8f(a10, a11);
                const s16x8 va = cat4(tr4(VS + (4 * fq + q) * 64 + 16 * et + 4 * p), tr4(VS + (16 + 4 * fq + q) * 64 + 16 * et + 4 * p));
                oi[0] = mfma16(va, pb0, oi[0]); oi[1] = mfma16(va, pb1, oi[1]);
                const s16x8 vb = cat4(tr4(VS + (8 * fq + q) * 64 + 16 * et + 4 * p), tr4(VS + (8 * fq + 4 + q) * 64 + 16 * et + 4 * p));
#pragma unroll
                for (int dt = 0; dt < 4; ++dt) {
                    const s16x8 ka = *(const LAS s16x8*)(KDT + (16 * dt + fr) * 32 + 8 * fq);
                    const f32x4v ds = mfma16(ka, vb, z);
                    const f32x4v dc = *(const LAS f32x4v*)(DEC + 16 * dt + 4 * fq);
                    Sst[dt] = Sst[dt] * dc + ds;
                }
                LAS float* sq = SSQ + (n & 1) * 128 + et * 32;
#pragma unroll
                for (int tt = 0; tt < 2; ++tt) { float s = 0.f;
#pragma unroll
                    for (int i = 0; i < 4; ++i) { OI[(16 * et + 4 * fq + i) * 32 + 16 * tt + fr] = oi[tt][i]; s += oi[tt][i] * oi[tt][i]; }
                    s += __shfl_xor(s, 16); s += __shfl_xor(s, 32);
                    if (fq == 0) sq[16 * tt + fr] = s; }
            }
            __syncthreads();
        }
    }
    __syncthreads();
}

constexpr int DSA_SC = 0, DSA_H1 = 131072, DSA_IDX = 139264, DSA_KST = 143360, DSA_ITEM = 159744;
__device__ __forceinline__ unsigned off_b(unsigned row, unsigned ch) { return 256u * row + 16u * (ch ^ (((row & 3) << 2) | ((row >> 2) & 3))); }
__device__ __forceinline__ unsigned mono16(unsigned h) { return (h & 0x8000u) ? (~h & 0xffffu) : (h | 0x8000u); }

__device__ __forceinline__ int wave_incl_scan_dpp(int v) {
    v += __builtin_amdgcn_update_dpp(0, v, 0x111, 0xf, 0xf, true);
    v += __builtin_amdgcn_update_dpp(0, v, 0x112, 0xf, 0xf, true);
    v += __builtin_amdgcn_update_dpp(0, v, 0x114, 0xf, 0xf, true);
    v += __builtin_amdgcn_update_dpp(0, v, 0x118, 0xf, 0xf, true);
    v += __builtin_amdgcn_update_dpp(0, v, 0x142, 0xa, 0xf, false);
    v += __builtin_amdgcn_update_dpp(0, v, 0x143, 0xc, 0xf, false);
    return v;
}
__device__ __forceinline__ void find_bin(const LAS unsigned* hist, int lane, int target, int& B, int& above) {
    const u32x4v c = *(const LAS u32x4v*)(hist + 4 * lane);
    const int tot = (int)(c.x + c.y + c.z + c.w);
    const int pre = wave_incl_scan_dpp(tot);
    const int all = __builtin_amdgcn_readlane(pre, 63);
    const int suf = all - pre + tot;
    const int ab = suf - tot;
    const bool here = (ab < target) && (suf >= target);
    int b = -1, a = 0;
    if (here) {
        int cum = ab;
        if (cum + (int)c.w >= target) { b = 4 * lane + 3; a = cum; }
        else { cum += (int)c.w;
            if (cum + (int)c.z >= target) { b = 4 * lane + 2; a = cum; }
            else { cum += (int)c.z;
                if (cum + (int)c.y >= target) { b = 4 * lane + 1; a = cum; }
                else { cum += (int)c.y; b = 4 * lane; a = cum; } } }
    }
    const unsigned long long m = __ballot(here);
    const int src = m ? (int)__builtin_ctzll(m) : 0;
    B = __shfl(b, src); above = __shfl(a, src);
}

__device__ __forceinline__ int wave_incl_scan(int v, int lane) {
#pragma unroll
    for (int d = 1; d < 64; d <<= 1) { const int o = __shfl_up(v, d); if (lane >= d) v += o; }
    return v;
}

typedef short s16x2v __attribute__((ext_vector_type(2)));
__device__ __forceinline__ unsigned relu_pk_bf16(unsigned x) { return __builtin_bit_cast(unsigned, __builtin_elementwise_max(__builtin_bit_cast(s16x2v, x), (s16x2v){0, 0})); }

struct APre { s16x8 Aop[4][2]; f32x4v w0[2], w1[2]; u32x4v g[4][2]; };
__device__ __forceinline__ void dsa_pre(const Ctx& C, int b, int qt, APre& P) {
    const int lane = C.lane, wave = C.wave, fr = lane & 15, fq = lane >> 4;
    unsigned char* ws = C.ws;
    const u16* QIDX = (const u16*)(ws + WS_QIDX); const u16* KIDX = (const u16*)(ws + WS_KIDX); const float* WIDX = (const float*)(ws + WS_WIDX);
    const size_t tb = (size_t)b * SEQ; const int q0 = qt * 8, nt16 = (q0 + 8 + 15) >> 4;
#pragma unroll
    for (int m = 0; m < 4; ++m) { const u16* p = QIDX + (tb + q0 + 4 * (m >> 1) + (fr >> 2)) * 512 + (4 * (m & 1) + (fr & 3)) * 64 + 8 * fq;
#pragma unroll
        for (int ks = 0; ks < 2; ++ks) P.Aop[m][ks] = *(const s16x8*)(p + 32 * ks); }
#pragma unroll
    for (int qq = 0; qq < 2; ++qq) { const float* wp = WIDX + (tb + q0 + 4 * qq + fq) * 8; P.w0[qq] = *(const f32x4v*)wp; P.w1[qq] = *(const f32x4v*)(wp + 4); }
    const int lrow = lane >> 3, lpc = lane & 7;
    const u16* kbase = KIDX + (tb + lrow) * 64 + lpc * 8;
#pragma unroll
    for (int j = 0; j < 4; ++j) { const int t_ = wave + 8 * j < nt16 ? wave + 8 * j : (wave < nt16 ? wave : 0);
        P.g[j][0] = *(const u32x4v*)(kbase + (size_t)t_ * 1024); P.g[j][1] = *(const u32x4v*)(kbase + (size_t)t_ * 1024 + 512); }
}

__device__ __forceinline__ int dsa_item(const Ctx& C, int b, int qt, APre& P, int nxt) {
    const int tid = C.tid, lane = C.lane, wave = C.wave;
    unsigned char* ws = C.ws;
    const u16* QLAT = (const u16*)(ws + WS_QLAT); const u16* QIDX = (const u16*)(ws + WS_QIDX); const u16* CKV = (const u16*)(ws + WS_CKV); const u16* KIDX = (const u16*)(ws + WS_KIDX);
    const float* WIDX = (const float*)(ws + WS_WIDX); const float* SSQ = (const float*)(ws + WS_SSQ); u16* MIX = (u16*)(ws + WS_MIX);
    LAS _Float16* SC = (LAS _Float16*)(C.lds + DSA_SC); LAS u16* SCK = (LAS u16*)(C.lds + DSA_SC);
    LAS unsigned* H1 = (LAS unsigned*)(C.lds + DSA_H1);
    const size_t tb = (size_t)b * SEQ; const int q0 = qt * 8;
    { constexpr int repA = 0;
        const int fr = lane & 15, fq = lane >> 4;
        s16x8 Aop[4][2]; s16x8 Wop[2];
#pragma unroll
        for (int m = 0; m < 4; ++m) { Aop[m][0] = P.Aop[m][0]; Aop[m][1] = P.Aop[m][1]; }
#pragma unroll
        for (int qq = 0; qq < 2; ++qq) { const f32x4v w0 = P.w0[qq], w1 = P.w1[qq];
            const f32x4v zz = {0.f, 0.f, 0.f, 0.f}; const bool own = fr == 4 * fq + qq;
            Wop[qq] = pack8f(own ? w0 : zz, own ? w1 : zz); }
        const int nt16 = (q0 + 8 + 15) >> 4;
        LAS unsigned char* KST = C.lds + DSA_KST + wave * 2048;
        const int lrow = lane >> 3, lpc = lane & 7;
        const u16* kbase = KIDX + (tb + lrow) * 64 + lpc * 8;
        const unsigned wo0 = (unsigned)(lrow * 128 + ((lpc ^ (lrow & 7)) * 16)), wo1 = wo0 + 1024u;
        const unsigned ro0 = (unsigned)(fr * 128 + ((fq ^ (fr & 7)) * 16)), ro1 = (unsigned)(fr * 128 + (((4 + fq) ^ (fr & 7)) * 16));
        u32x4v g0a, g0b, g1a, g1b;
#define A_GLOAD(da, db, kt_) do { da = *(const u32x4v*)(kbase + (size_t)(kt_) * 1024); db = *(const u32x4v*)(kbase + (size_t)(kt_) * 1024 + 512); } while (0)
#define A_STAGE(da, db, B0_, B1_) do { *(LAS u32x4v*)(KST + wo0) = da; *(LAS u32x4v*)(KST + wo1) = db; LDS_FENCE(); B0_ = *(const LAS s16x8*)(KST + ro0); B1_ = *(const LAS s16x8*)(KST + ro1); } while (0)
#define A_MMA(acc_, B0_, B1_) do { _Pragma("unroll") for (int m = 0; m < 4; ++m) { acc_[m] = mfma16(Aop[m][0], B0_, (f32x4v){0.f, 0.f, 0.f, 0.f}); acc_[m] = mfma16(Aop[m][1], B1_, acc_[m]); } } while (0)
#define A_EPI1(acc_, d0_, d1_) do { if (((MK_REPEAT >> 17) & 1) && repA) { d0_ = acc_[0] + acc_[1] + acc_[2] + acc_[3]; break; } u32x4v pa_, pb_;                      \
            pa_.x = relu_pk_bf16(cvtpk(acc_[0][0], acc_[0][1])); pa_.y = relu_pk_bf16(cvtpk(acc_[0][2], acc_[0][3])); pa_.z = relu_pk_bf16(cvtpk(acc_[1][0], acc_[1][1])); pa_.w = relu_pk_bf16(cvtpk(acc_[1][2], acc_[1][3])); \
            pb_.x = relu_pk_bf16(cvtpk(acc_[2][0], acc_[2][1])); pb_.y = relu_pk_bf16(cvtpk(acc_[2][2], acc_[2][3])); pb_.z = relu_pk_bf16(cvtpk(acc_[3][0], acc_[3][1])); pb_.w = relu_pk_bf16(cvtpk(acc_[3][2], acc_[3][3])); \
            d0_ = mfma16(Wop[0], __builtin_bit_cast(s16x8, pa_), (f32x4v){0.f, 0.f, 0.f, 0.f}); \
            d0_ = mfma16(Wop[1], __builtin_bit_cast(s16x8, pb_), d0_); } while (0)
#define A_EPI2(d0_, d1_, kt_) do { if (((MK_REPEAT >> 16) & 1) && repA) { dummyA += d0_[0] + d0_[1]; break; } const int kpos = (kt_) * 16 + fr;     \
            const unsigned hh_ = __builtin_bit_cast(unsigned, __builtin_amdgcn_cvt_pkrtz(d0_[0], d0_[1])); \
            const unsigned kk_ = hh_ ^ (__builtin_bit_cast(unsigned, __builtin_bit_cast(s16x2v, hh_) >> 15) | 0x80008000u);      \
            SCK[fq * 8192 + kpos] = (u16)kk_; SCK[(4 + fq) * 8192 + kpos] = (u16)(kk_ >> 16); \
            if (repA == 0) { if (kpos <= q0 + fq) atomicAdd((unsigned*)(H1 + fq * 256 + ((kk_ >> 8) & 0xffu)), 1u); if (kpos <= q0 + 4 + fq) atomicAdd((unsigned*)(H1 + (4 + fq) * 256 + (kk_ >> 24)), 1u); } } while (0)
        float dummyA = 0.f;
#define A_WRITE(da, db) do { *(LAS u32x4v*)(KST + wo0) = da; *(LAS u32x4v*)(KST + wo1) = db; } while (0)
#define A_READ(B0_, B1_) do { LDS_FENCE(); B0_ = *(const LAS s16x8*)(KST + ro0); B1_ = *(const LAS s16x8*)(KST + ro1); } while (0)
        if (wave < nt16) {
            s16x8 bc0, bc1, bn0, bn1; f32x4v accA[4], accB[4], hd; u32x4v g2a, g2b, g3a, g3b;
#define A_TCL(t_) ((t_) < nt16 ? (t_) : wave)
            g0a = P.g[0][0]; g0b = P.g[0][1]; g1a = P.g[1][0]; g1b = P.g[1][1]; g2a = P.g[2][0]; g2b = P.g[2][1]; g3a = P.g[3][0]; g3b = P.g[3][1];
            A_WRITE(g0a, g0b); A_READ(bc0, bc1);
            A_MMA(accA, bc0, bc1);
            A_GLOAD(g0a, g0b, A_TCL(wave + 32));
            A_WRITE(g1a, g1b); A_GLOAD(g1a, g1b, A_TCL(wave + 40));
            int kt = wave;
#define A_STEP(aX, aY, bx0, bx1, ga, gb) { A_READ(bx0, bx1); A_EPI1(aX, hd, hd); A_MMA(aY, bx0, bx1); A_EPI2(hd, hd, kt); if (kt + 8 >= nt16) break; \
                A_WRITE(ga, gb); A_GLOAD(ga, gb, (kt + 48 < nt16 ? kt + 48 : kt)); kt += 8; }
            for (;;) {
                A_STEP(accA, accB, bn0, bn1, g2a, g2b)
                A_STEP(accB, accA, bc0, bc1, g3a, g3b)
                A_STEP(accA, accB, bn0, bn1, g0a, g0b)
                A_STEP(accB, accA, bc0, bc1, g1a, g1b)
            }
#undef A_STEP
#undef A_TCL
        }
#undef A_WRITE
#undef A_READ
        if (dummyA == 12345.678f) SC[0] = (_Float16)0.f;
#undef A_GLOAD
#undef A_STAGE
#undef A_MMA
#undef A_EPI1
#undef A_EPI2
    }
    LAS int* itemw2 = (LAS int*)(C.lds + DSA_ITEM) + 1;
    if (tid == 0) *itemw2 = nxt;
    __syncthreads();
    const int nx = __builtin_amdgcn_readfirstlane(*itemw2);
    const int tq = q0 + wave, nk = tq + 1;
    LAS unsigned* h1 = H1 + wave * 256;
    LAS unsigned* hist = h1;
    LAS u16* idx = (LAS u16*)(C.lds + DSA_IDX) + wave * 256;
    LAS float* rsel = (LAS float*)(C.lds + DSA_KST + wave * 2048);
    const LAS u16* scq = (const LAS u16*)(C.lds + DSA_SC) + wave * 8192;
    s16x8 Bq[4];
    { const int fr = lane & 15, fq = lane >> 4;
#pragma unroll
      for (int ks = 0; ks < 4; ++ks) { Bq[ks] = (s16x8){0, 0, 0, 0, 0, 0, 0, 0}; if (fr < 8) Bq[ks] = *(const s16x8*)(QLAT + (tb + tq) * 1024 + fr * 128 + 32 * ks + 8 * fq); } }
    int cnt;
    const int frC = lane & 15, fqC = lane >> 4;
    const u16* ckb = CKV + tb * 128 + frC * 8;
    u32x4v gbuf[8]; f32x4v q4e = {0.f, 0.f, 0.f, 0.f}; bool early = false;
#define C_ISSUE(ch_) do { int kk_[8]; _Pragma("unroll") for (int i = 0; i < 8; ++i) { const int s_ = (ch_) * 32 + 4 * i + fqC; kk_[i] = (int)idx[s_ < cnt ? s_ : cnt - 1]; }     \
            _Pragma("unroll") for (int i = 0; i < 8; ++i) gbuf[i] = *(const u32x4v*)(ckb + (size_t)kk_[i] * 128); } while (0)
#define C_EARLY() do { LDS_FENCE(); C_ISSUE(0); q4e = *(const f32x4v*)(SSQ + (tb + idx[lane < cnt ? lane : cnt - 1]) * 4); } while (0)
    u32x4v h1save = (u32x4v){0u, 0u, 0u, 0u};
    if ((MK_REPEAT >> 9) & 1) h1save = *(const LAS u32x4v*)(h1 + 4 * lane);
    for (int repB = 0; repB < (((MK_REPEAT >> 9) & 1) ? 2 : 1); ++repB) { LDS_FENCE();
    if (repB) { *(LAS u32x4v*)(h1 + 4 * lane) = h1save; LDS_FENCE(); }
    if (nk <= TOPK) {
        cnt = nk;
#pragma unroll
        for (int i = 0; i < 4; ++i) idx[lane + 64 * i] = (u16)(lane + 64 * i);
    } else {
        cnt = TOPK;
        const int nit = (nk + 511) >> 9;
        int B1, above1; find_bin(h1, lane, TOPK, B1, above1);
        LDS_FENCE();
        *(LAS u32x4v*)(hist + 4 * lane) = (u32x4v){0u, 0u, 0u, 0u};
        LDS_FENCE();
#pragma unroll 2
        for (int it = 0; it < nit; ++it) { const int base = it * 512 + lane * 8;
            if ((it + 1) * 512 <= nk) {
                const u32x4v v = *(const LAS u32x4v*)(scq + base);
#pragma unroll
                for (int j = 0; j < 8; ++j) { const unsigned key = (v[j >> 1] >> ((j & 1) * 16)) & 0xffffu; if ((int)(key >> 8) == B1) atomicAdd((unsigned*)(hist + (key & 255u)), 1u); }
            } else if (base < nk) { const u32x4v v = *(const LAS u32x4v*)(scq + base);
#pragma unroll
                for (int j = 0; j < 8; ++j) { const unsigned key = (v[j >> 1] >> ((j & 1) * 16)) & 0xffffu; if (base + j < nk && (int)(key >> 8) == B1) atomicAdd((unsigned*)(hist + (key & 255u)), 1u); } } }
        LDS_FENCE();
        int B2, above2; find_bin(hist, lane, TOPK - above1, B2, above2);
        const unsigned T = ((unsigned)B1 << 8) | (unsigned)B2;
        const int ngt = above1 + above2, need_eq = TOPK - ngt;
        int pos_gt = 0, pos_eq = 0;
#pragma unroll 2
        for (int it = 0; it < nit; ++it) { const int base = it * 512 + lane * 8;
            u32x4v v = (u32x4v){0u, 0u, 0u, 0u};
            if (base < nk) v = *(const LAS u32x4v*)(scq + base);
            unsigned key[8];
#pragma unroll
            for (int j = 0; j < 8; ++j) key[j] = (v[j >> 1] >> ((j & 1) * 16)) & 0xffffu;
            if ((it + 1) * 512 > nk) {
#pragma unroll
                for (int j = 0; j < 8; ++j) if (base + j >= nk) key[j] = 0u; }
            unsigned mgt = 0u, meq = 0u;
#pragma unroll
            for (int j = 0; j < 8; ++j) { mgt |= (key[j] > T ? 1u : 0u) << j; meq |= (key[j] == T ? 1u : 0u) << j; }
            const int cgt = __builtin_popcount(mgt), ceq = __builtin_popcount(meq);
            const int packed = cgt | (ceq << 16);
            const int incl = wave_incl_scan_dpp(packed), excl = incl - packed, tot = __builtin_amdgcn_readlane(incl, 63);
            int og = pos_gt + (excl & 0xffff), oe = pos_eq + (excl >> 16);
            pos_gt += tot & 0xffff; pos_eq += tot >> 16;
            while (mgt) { const int j = __builtin_ctz(mgt); mgt &= mgt - 1u; idx[og] = (u16)(base + j); ++og; }
            while (meq) { const int j = __builtin_ctz(meq); meq &= meq - 1u; if (oe < need_eq) idx[ngt + oe] = (u16)(base + j); ++oe; }
            if (!early && pos_gt >= 64 && it + 1 < nit) { early = true; C_EARLY(); } }
    }
    }
    *(LAS u32x4v*)(h1 + 4 * lane) = (u32x4v){0u, 0u, 0u, 0u};
    LDS_FENCE();
    for (int repC = 0; repC < (((MK_REPEAT >> 10) & 1) ? 2 : 1); ++repC) {
        const int fr = lane & 15, fq = lane >> 4;
        const size_t tok = tb + tq;
        const int nch = (cnt + 31) >> 5;
        if (!early || repC) C_EARLY();
        { int kr[3]; f32x4v q4[4]; q4[0] = q4e;
#pragma unroll
          for (int i = 1; i < 4; ++i) { const int s = lane + 64 * i; kr[i - 1] = (int)idx[s < cnt ? s : cnt - 1]; }
#pragma unroll
          for (int i = 1; i < 4; ++i) q4[i] = *(const f32x4v*)(SSQ + (tb + kr[i - 1]) * 4);
#pragma unroll
          for (int i = 0; i < 4; ++i) { const int s = lane + 64 * i; rsel[s] = s < cnt ? __builtin_amdgcn_rsqf((q4[i][0] + q4[i][1] + q4[i][2] + q4[i][3]) * (1.f / 128.f) + EPS) : 0.f; } }
        f32x4v O[8];
#pragma unroll
        for (int ct = 0; ct < 8; ++ct) O[ct] = (f32x4v){0.f, 0.f, 0.f, 0.f};
        float mrun = -__builtin_inff(), lsum = 0.f;
        const int rho0 = 8 * (fr >> 2) + (fr & 3);
        const int tq_ = (lane & 15) >> 2, tp = lane & 3;
        LAS unsigned char* const CB = C.lds + DSA_SC + wave * 16384;
        auto c_chunk = [&](const int ch, LAS unsigned char* const CH) __attribute__((always_inline)) {
            f32x4v sacc[2];
#pragma unroll
            for (int T = 0; T < 2; ++T) { sacc[T] = (f32x4v){0.f, 0.f, 0.f, 0.f};
#pragma unroll
                for (int ks = 0; ks < 4; ++ks) { const s16x8 a = *(const LAS s16x8*)(CH + off_b(rho0 + 4 * T, 4 * ks + fq)); sacc[T] = mfma16(a, Bq[ks], sacc[T]); } }
            const f32x4v r0 = *(const LAS f32x4v*)(rsel + ch * 32 + 8 * fq), r1 = *(const LAS f32x4v*)(rsel + ch * 32 + 8 * fq + 4);
            float sv[8];
#pragma unroll
            for (int i = 0; i < 4; ++i) { sv[i] = sacc[0][i] * r0[i]; sv[4 + i] = sacc[1][i] * r1[i]; }
            if (ch * 32 + 32 > cnt) {
#pragma unroll
                for (int i = 0; i < 4; ++i) { const int s0 = ch * 32 + 8 * fq + i; if (s0 >= cnt) sv[i] = -__builtin_inff(); if (s0 + 4 >= cnt) sv[4 + i] = -__builtin_inff(); } }
            float cmax = fmaxf(fmaxf(fmaxf(sv[0], sv[1]), fmaxf(sv[2], sv[3])), fmaxf(fmaxf(sv[4], sv[5]), fmaxf(sv[6], sv[7])));
            cmax = fmaxf(cmax, __shfl_xor(cmax, 16)); cmax = fmaxf(cmax, __shfl_xor(cmax, 32));
            const bool need = cmax > mrun + 8.f;
            if (__any(need)) {
                const float mnew = need ? cmax : mrun;
                const float alpha = fast_exp(mrun - mnew);
                mrun = mnew; lsum *= alpha;
#pragma unroll
                for (int ct = 0; ct < 8; ++ct) O[ct] = O[ct] * alpha;
            }
            float p[8]; float ps = 0.f;
#pragma unroll
            for (int i = 0; i < 8; ++i) { p[i] = fast_exp(sv[i] - mrun); ps += p[i]; }
            lsum += ps;
            f32x4v pa, pb;
#pragma unroll
            for (int i = 0; i < 4; ++i) { pa[i] = p[i] * r0[i]; pb[i] = p[4 + i] * r1[i]; }
            const s16x8 pop = pack8f(pa, pb);
#pragma unroll
            for (int ct = 0; ct < 8; ++ct) {
                const s16x4 t0 = tr4((const LAS u16*)(CH + off_b(8 * fq + tq_, 2 * ct + (tp >> 1)) + 8 * (tp & 1)));
                const s16x4 t1 = tr4((const LAS u16*)(CH + off_b(8 * fq + 4 + tq_, 2 * ct + (tp >> 1)) + 8 * (tp & 1)));
                O[ct] = mfma16(cat4(t0, t1), pop, O[ct]);
            }
        };
#pragma unroll 1
        for (int ch = 0; ch < nch; ch += 2) {
#pragma unroll
            for (int i = 0; i < 8; ++i) *(LAS u32x4v*)(CB + off_b(4 * i + fq, fr)) = gbuf[i];
            if (ch + 1 < nch) C_ISSUE(ch + 1);
            LDS_FENCE();
            c_chunk(ch, CB);
            if (ch + 1 < nch) {
#pragma unroll
                for (int i = 0; i < 8; ++i) *(LAS u32x4v*)(CB + 8192 + off_b(4 * i + fq, fr)) = gbuf[i];
                if (ch + 2 < nch) C_ISSUE(ch + 2);
                LDS_FENCE();
                c_chunk(ch + 1, CB + 8192);
            }
        }
#undef C_ISSUE
#undef C_EARLY
        lsum += __shfl_xor(lsum, 16); lsum += __shfl_xor(lsum, 32);
        const float inv = 1.f / lsum;
        float am = 0.f;
#pragma unroll
        for (int ct = 0; ct < 8; ++ct) { O[ct] = O[ct] * inv; am = fmaxf(am, fmaxf(fmaxf(fabsf(O[ct][0]), fabsf(O[ct][1])), fmaxf(fabsf(O[ct][2]), fabsf(O[ct][3])))); }
        if (fr >= 8) am = 0.f;
        am = wave_max_f(am);
        const float qs = am > 0.f ? 127.f / am : 0.f;
        if (fr < 8) {
            unsigned char* mp = (unsigned char*)MIX + tok * MIXB + fr * 128 + 4 * fq;
#pragma unroll
            for (int ct = 0; ct < 8; ++ct) *(unsigned*)(mp + 16 * ct) = pack_i8(O[ct][0] * qs, O[ct][1] * qs, O[ct][2] * qs, O[ct][3] * qs);
        }
        if (lane == 0) ((float*)(ws + WS_MIXS))[tok] = am * (1.f / 127.f);
    }
    dsa_pre(C, b, (SEQ / 8 - 1) - (nx < SEQ / 8 ? nx : SEQ / 8 - 1), P);
    return nx;
}

__device__ __forceinline__ void p2_mixers(const Ctx& C, int cw = 0) {
    if (C.bid < 64) { hgrn_seq(C, C.bid); if ((MK_REPEAT >> 7) & 1) hgrn_seq(C, C.bid); }
    unsigned* qctr = (unsigned*)(C.ws + WS_CTL);
    for (int i = C.tid; i < 2048; i += NTHREADS) ((LAS unsigned*)(C.lds + DSA_H1))[i] = 0u;
    __syncthreads();
    LAS int* itemw = (LAS int*)(C.lds + DSA_ITEM);
    APre P;
    const int xcc = (int)(__builtin_amdgcn_s_getreg((3 << 11) | 20) & 0x7u);
    for (int k = 0; k < NB; ++k) { const int bq = (xcc + k) & 7;
        if (C.tid == 0) *itemw = (int)atomicAdd(qctr + 8 * cw + bq, 1u);
        __syncthreads();
        int item = *itemw;
        __syncthreads();
        if (item < SEQ / 8) dsa_pre(C, bq, (SEQ / 8 - 1) - item, P);
        while (item < SEQ / 8) {
            int nxt = 0;
            if (C.tid == 0) nxt = (int)atomicAdd(qctr + 8 * cw + bq, 1u);
            item = dsa_item(C, bq, (SEQ / 8 - 1) - item, P, nxt);
            __syncthreads();
        }
    }
}


__device__ __forceinline__ float wave_sum(float v) {
#pragma unroll
    for (int d = 1; d < 64; d <<= 1) v += __shfl_xor(v, d);
    return v;
}
__device__ __forceinline__ void p4_ln1(const Ctx& C) {
    const u16* Y1 = (const u16*)(C.ws + WS_Y1); u16* HB = (u16*)(C.ws + WS_HB); unsigned char* H8 = C.ws + WS_H8; float* HS = (float*)(C.ws + WS_HS);
    const float* g = C.in[I_LN1G]; const float* bb = C.in[I_LN1B];
    const int lane = C.lane, gw = C.bid * 8 + C.wave, nw = C.G * 8;
    f32x4v gv[4], bv[4];
#pragma unroll
    for (int c = 0; c < 4; ++c) { gv[c] = *(const f32x4v*)(g + lane * 16 + 4 * c); bv[c] = *(const f32x4v*)(bb + lane * 16 + 4 * c); }
    u32x4v yn0 = *(const u32x4v*)(Y1 + (size_t)gw * 1024 + lane * 16), yn1 = *(const u32x4v*)(Y1 + (size_t)gw * 1024 + lane * 16 + 8);
    for (int r = gw; r < MTOK; r += nw) {
        const u32x4v y0 = yn0, y1 = yn1;
        { const int rn = r + nw < MTOK ? r + nw : r; yn0 = *(const u32x4v*)(Y1 + (size_t)rn * 1024 + lane * 16); yn1 = *(const u32x4v*)(Y1 + (size_t)rn * 1024 + lane * 16 + 8); }
        float v[16]; float s = 0.f;
#pragma unroll
        for (int j = 0; j < 4; ++j) { v[2 * j] = bf_lo(y0[j]); v[2 * j + 1] = bf_hi(y0[j]); v[8 + 2 * j] = bf_lo(y1[j]); v[8 + 2 * j + 1] = bf_hi(y1[j]); }
#pragma unroll
        for (int j = 0; j < 16; ++j) s += v[j];
        const float mu = wave_sum_f(s) * (1.f / 1024.f);
        float q = 0.f;
#pragma unroll
        for (int j = 0; j < 16; ++j) { v[j] -= mu; q += v[j] * v[j]; }
        const float rstd = __builtin_amdgcn_rsqf(wave_sum_f(q) * (1.f / 1024.f) + EPS);
        float am = 0.f;
#pragma unroll
        for (int j = 0; j < 16; ++j) { v[j] = v[j] * rstd * gv[j >> 2][j & 3] + bv[j >> 2][j & 3]; am = fmaxf(am, fabsf(v[j])); }
        u32x4v w0, w1;
#pragma unroll
        for (int j = 0; j < 4; ++j) { w0[j] = cvtpk(v[2 * j], v[2 * j + 1]); w1[j] = cvtpk(v[8 + 2 * j], v[8 + 2 * j + 1]); }
        *(u32x4v*)(HB + (size_t)r * 1024 + lane * 16) = w0; *(u32x4v*)(HB + (size_t)r * 1024 + lane * 16 + 8) = w1;
        am = wave_max_f(am);
        const float qs = am > 0.f ? 127.f / am : 0.f;
        u32x4v w8;
#pragma unroll
        for (int j = 0; j < 4; ++j) w8[j] = pack_i8(v[4 * j] * qs, v[4 * j + 1] * qs, v[4 * j + 2] * qs, v[4 * j + 3] * qs);
        *(u32x4v*)(H8 + (size_t)r * 1024 + lane * 16) = w8;
        if (lane == 0) HS[r] = am * (1.f / 127.f);
    }
}

constexpr int SSROW = 136;
constexpr int PE_SS = 0, PE_TV = 0, PE_TI = 32768, PE_EU = 53248, PE_EID = 131072, PE_EG = 147456;

__device__ __forceinline__ void ins16(float (&tv)[16], int (&ti)[16], float v, int id) {
#pragma unroll
    for (int j = 15; j >= 0; --j) {
        const bool c = v > tv[j];
        const bool cp = (j > 0) ? (v > tv[j > 0 ? j - 1 : 0]) : false;
        const float nv = cp ? tv[j > 0 ? j - 1 : 0] : v; const int ni = cp ? ti[j > 0 ? j - 1 : 0] : id;
        tv[j] = c ? nv : tv[j]; ti[j] = c ? ni : ti[j];
    }
}

__device__ __forceinline__ float gelu_tanh(float x) {
    const float u = 0.7978845608028654f * (x + 0.044715f * x * x * x);
    const float e = fast_exp(2.f * u);
    const float th = 1.f - 2.f * __builtin_amdgcn_rcpf(e + 1.f);
    return 0.5f * x * (1.f + th);
}


#ifndef MK_PASSBAR
#define MK_PASSBAR 0
#endif
constexpr int PE_PD = 0, PE_STAT = 131072, PE_WSC = 133120;
constexpr size_t WS_GSID = WS_MIX, WS_GSG = WS_MIX + 32 * MiB, WS_GSU = WS_MIX + 64 * MiB;
constexpr int NSEG = 8, SEGB = 128;

__device__ __forceinline__ void p6_peer(const Ctx& C) {
    unsigned char* ws = C.ws;
    const u16* PQ = (const u16*)(ws + WS_PQ); const u16* HB = (const u16*)(ws + WS_HB); const u16* SKB = (const u16*)(ws + WS_SKB); const unsigned char* H8 = ws + WS_H8; const float* HS = (const float*)(ws + WS_HS);
    const unsigned char* U8 = ws + WS_UB; const unsigned char* V8 = ws + WS_VB; const float* USC = (const float*)(ws + WS_USC); const float* VSC = (const float*)(ws + WS_VSC);
    u16* YB = (u16*)(ws + WS_YB);
    unsigned* G_SID = (unsigned*)(ws + WS_GSID); float* G_SG = (float*)(ws + WS_GSG); float* G_SU = (float*)(ws + WS_GSU);
    const float* g2 = C.in[I_LN2G]; const float* b2 = C.in[I_LN2B];
    const int tid = C.tid, lane = C.lane, wave = C.wave, fr = lane & 15, fq = lane >> 4;
    LAS u16* SSK = (LAS u16*)(C.lds + PE_SS);
    LAS float* TV = (LAS float*)(C.lds + PE_TV); LAS u16* TI = (LAS u16*)(C.lds + PE_TI);
    LAS int* EID = (LAS int*)(C.lds + PE_EID); LAS float* EG = (LAS float*)(C.lds + PE_EG); LAS float* EU = (LAS float*)(C.lds + PE_EU);
    cg::grid_group grid = cg::this_grid();
    const int ntile = MTOK / 32, tiles_per_wg = (ntile + C.G - 1) / C.G, nsr = (tiles_per_wg + 7) / 8;
    for (int sr = 0; sr < nsr; ++sr) {
    for (int jj = 0; jj < 8; ++jj) { const int tile = C.bid + (8 * sr + jj) * C.G; if (tile >= ntile) break;
        const size_t t0 = (size_t)tile * 32;
        int tid_r = C.tid; asm volatile("" : "+v"(tid_r));
        const int lane_r = tid_r & 63, fr_r = lane_r & 15, fq_r = lane_r >> 4;
#define tid tid_r
#define lane lane_r
#define fr fr_r
#define fq fq_r
#define SK_KEYS(x_, y_) ({ const unsigned hh_ = __builtin_bit_cast(unsigned, __builtin_amdgcn_cvt_pkrtz(x_, y_)); hh_ ^ (__builtin_bit_cast(unsigned, __builtin_bit_cast(s16x2v, hh_) >> 15) | 0x80008000u); })
#define SK_LOAD(dst, hp_, k0_) do { _Pragma("unroll") for (int kk = 0; kk < 4; ++kk) _Pragma("unroll") for (int ks = 0; ks < 4; ++ks) \
            dst[kk][ks] = *(const s16x8*)(SKB + ((size_t)(hp_) * 128 + 16 * ((k0_) + kk) + fr) * 128 + 32 * ks + 8 * fq); } while (0)
#define PQ_LOAD(dst, hp_) do { _Pragma("unroll") for (int tt = 0; tt < 2; ++tt) _Pragma("unroll") for (int ks = 0; ks < 4; ++ks) dst[tt][ks] = *(const s16x8*)(PQ + (t0 + 16 * tt + fr) * NPQ + (hp_) * 128 + 32 * ks + 8 * fq); } while (0)
#define SK_COMP(src, Bq_, hp_, k0_) do { _Pragma("unroll") for (int kk = 0; kk < 4; ++kk) { const int kt = (k0_) + kk; f32x4v a0 = {0.f, 0.f, 0.f, 0.f}, a1 = a0; \
            _Pragma("unroll") for (int ks = 0; ks < 4; ++ks) { a0 = mfma16(src[kk][ks], Bq_[0][ks], a0); a1 = mfma16(src[kk][ks], Bq_[1][ks], a1); } \
              \
            u32x2v kwa_, kwb_; kwa_.x = SK_KEYS(a0[0], a0[1]); kwa_.y = SK_KEYS(a0[2], a0[3]); kwb_.x = SK_KEYS(a1[0], a1[1]); kwb_.y = SK_KEYS(a1[2], a1[3]); \
            *(LAS u32x2v*)(SSK + ((hp_) * 32 + fr) * SSROW + 16 * kt + 4 * fq) = kwa_; *(LAS u32x2v*)(SSK + ((hp_) * 32 + 16 + fr) * SSROW + 16 * kt + 4 * fq) = kwb_; } } while (0)
#pragma unroll 1
        for (int rep1 = 0; rep1 < (((MK_REPEAT >> 11) & 1) ? 2 : 1); ++rep1) {
            const int hp0 = 2 * wave, hp1 = hp0 + 1;
            s16x8 akA[4][4], akB[4][4], Bt0[2][4], Bt1[2][4];
            PQ_LOAD(Bt0, hp0); SK_LOAD(akA, hp0, 0); SK_LOAD(akB, hp0, 4); PQ_LOAD(Bt1, hp1);
            SK_COMP(akA, Bt0, hp0, 0); SK_LOAD(akA, hp1, 0);
            SK_COMP(akB, Bt0, hp0, 4); SK_LOAD(akB, hp1, 4);
            SK_COMP(akA, Bt1, hp1, 0);
            SK_COMP(akB, Bt1, hp1, 4);
        }
#undef SK_LOAD
#undef PQ_LOAD
#undef SK_COMP
#undef SK_KEYS
        __syncthreads();
        for (int repS = 0; repS < (((MK_REPEAT >> 12) & 1) ? 2 : 1); ++repS) {
            if (repS) __syncthreads();
            const int tok = tid & 31, hp = tid >> 5;
            float tk[16];
#pragma unroll
            for (int j = 0; j < 16; ++j) tk[j] = __builtin_bit_cast(float, 0x40000000u);
            const LAS u16* rowp = SSK + (hp * 32 + tok) * SSROW;
#pragma unroll 2
            for (int kb = 0; kb < 16; ++kb) {
                const u32x4v w = *(const LAS u32x4v*)(rowp + 8 * kb);
#pragma unroll
                for (int j = 0; j < 8; ++j) { const int k = 8 * kb + j; const unsigned k16 = (j & 1) ? (w[j >> 1] >> 16) : (w[j >> 1] & 0xffffu);
                    const float x = __builtin_bit_cast(float, (k16 << 7) | (0x40000000u | (unsigned)(127 - k)));
                    float nk[16];
                    nk[0] = __builtin_amdgcn_fmed3f(__builtin_inff(), x, tk[0]);
#pragma unroll
                    for (int jj = 1; jj < 16; ++jj) nk[jj] = __builtin_amdgcn_fmed3f(tk[jj - 1], x, tk[jj]);
#pragma unroll
                    for (int jj = 0; jj < 16; ++jj) tk[jj] = nk[jj]; }
            }
            if (repS + 1 < (((MK_REPEAT >> 12) & 1) ? 2 : 1)) continue;
            __syncthreads();
#pragma unroll
            for (int j = 0; j < 16; ++j) { const unsigned bits = __builtin_bit_cast(unsigned, tk[j]); const unsigned k16 = (bits >> 7) & 0xffffu;
                const unsigned hb = (k16 & 0x8000u) ? (k16 & 0x7fffu) : (~k16 & 0xffffu);
                TV[tid * 16 + j] = (float)__builtin_bit_cast(_Float16, (unsigned short)hb); TI[tid * 16 + j] = (u16)(127u - (bits & 0x7fu)); }
        }
        __syncthreads();
        for (int repK = 0; repK < (((MK_REPEAT >> 13) & 1) ? 2 : 1); ++repK) if (tid < 256) {
            int tid_o = tid; asm volatile("" : "+v"(tid_o));
            const int tok = tid_o & 31, h = tid_o >> 5;
            const int ra = ((2 * h) * 32 + tok) * 16, rb = ((2 * h + 1) * 32 + tok) * 16;
            float va[16], vb[16];
#pragma unroll
            for (int j = 0; j < 16; ++j) { va[j] = TV[ra + j]; vb[j] = TV[rb + j]; }
            float tk[16];
#pragma unroll
            for (int j = 0; j < 16; ++j) tk[j] = -__builtin_inff();
#pragma unroll
            for (int a = 0; a < 16; ++a)
#pragma unroll
                for (int b = 0; b < 16; ++b) if ((a + 1) * (b + 1) <= 16) {
                    const float x = __builtin_bit_cast(float, (__builtin_bit_cast(unsigned, va[a] + vb[b]) & 0xffffff00u) | (unsigned)(a * 16 + b));
                    float nk[16];
                    nk[0] = __builtin_amdgcn_fmed3f(__builtin_inff(), x, tk[0]);
#pragma unroll
                    for (int j = 1; j < 16; ++j) nk[j] = __builtin_amdgcn_fmed3f(tk[j - 1], x, tk[j]);
#pragma unroll
                    for (int j = 0; j < 16; ++j) tk[j] = nk[j];
                }
            float tv[16]; int ti[16];
#pragma unroll
            for (int j = 0; j < 16; ++j) { const unsigned bits = __builtin_bit_cast(unsigned, tk[j]); tv[j] = __builtin_bit_cast(float, bits & 0xffffff00u);
                ti[j] = (int)TI[ra + ((bits >> 4) & 15u)] * 128 + (int)TI[rb + (bits & 15u)]; }
            float mx = tv[0], sum = 0.f, e[16];
#pragma unroll
            for (int j = 0; j < 16; ++j) { e[j] = fast_exp(tv[j] - mx); sum += e[j]; }
            const float inv = __builtin_amdgcn_rcpf(sum);
#pragma unroll
            for (int j = 0; j < 16; ++j) { EID[tok * 128 + h * 16 + j] = ti[j]; EG[tok * 128 + h * 16 + j] = e[j] * inv * VSC[ti[j]]; EU[tok * 128 + h * 16 + j] = USC[ti[j]]; }
        }
        __syncthreads();
        { const u32x4v i0 = *(const LAS u32x4v*)(EID + tid * 8), i1 = *(const LAS u32x4v*)(EID + tid * 8 + 4);
          const f32x4v a0 = *(const LAS f32x4v*)(EG + tid * 8), a1 = *(const LAS f32x4v*)(EG + tid * 8 + 4), u0 = *(const LAS f32x4v*)(EU + tid * 8), u1 = *(const LAS f32x4v*)(EU + tid * 8 + 4);
          *(u32x4v*)(G_SID + t0 * 128 + tid * 8) = i0; *(u32x4v*)(G_SID + t0 * 128 + tid * 8 + 4) = i1;
          *(f32x4v*)(G_SG + t0 * 128 + tid * 8) = a0; *(f32x4v*)(G_SG + t0 * 128 + tid * 8 + 4) = a1;
          *(f32x4v*)(G_SU + t0 * 128 + tid * 8) = u0; *(f32x4v*)(G_SU + t0 * 128 + tid * 8 + 4) = u1; }
        __syncthreads();
#undef tid
#undef lane
#undef fr
#undef fq
    }
    __syncthreads();
    int lane_o = C.lane, wave_o = C.wave; asm volatile("" : "+v"(lane_o), "+s"(wave_o));
#define lane lane_o
#define wave wave_o
    LAS float* PD = (LAS float*)(C.lds + PE_PD) + wave * 4096;
    LAS float* STAT = (LAS float*)(C.lds + PE_STAT) + wave * 64;
    LAS float* WSC = (LAS float*)(C.lds + PE_WSC) + wave * 32;
    {
#pragma unroll
        for (int i = 0; i < 16; ++i) *(LAS f32x4v*)(PD + (i * 64 + lane) * 4) = (f32x4v){0.f, 0.f, 0.f, 0.f};
        STAT[lane] = 0.f;
        LDS_FENCE();
    }
#define ID_LOAD(kb_) (*(const u32x2v*)(sid + 16 * (kb_) + 2 * pc))
#define ROW_ISSUE(buf, idv, hb_, tbl) do { _Pragma("unroll") for (int jj_ = 0; jj_ < 8; ++jj_) { const int j_ = 8 * ((hb_) & 1) + jj_; \
            const unsigned id_ = (unsigned)__shfl((int)((j_ & 1) ? idv.y : idv.x), 8 * g + (j_ >> 1)); \
            buf[jj_] = *(const u32x4v*)((tbl) + ((id_ << 7) + (unsigned)(pc * 16))); } } while (0)
#define STREAM(tbl, CONSUME) do { \
        u32x2v idA_ = idP0, idB_ = idP1; u32x4v bA_[8], bB_[8];                       \
        idP0 = *(const u32x2v*)(sidn + 2 * pc); idP1 = *(const u32x2v*)(sidn + 16 + 2 * pc); \
        ROW_ISSUE(bA_, idA_, 0, tbl); ROW_ISSUE(bB_, idA_, 1, tbl); \
        _Pragma("unroll 1") for (int hb = 0; hb < 16; hb += 2) { \
            __builtin_amdgcn_sched_barrier(0); CONSUME(bA_, hb); __builtin_amdgcn_sched_barrier(0);        \
            if (hb + 2 < 16) ROW_ISSUE(bA_, idB_, hb + 2, tbl); \
            __builtin_amdgcn_sched_barrier(0); CONSUME(bB_, hb + 1); __builtin_amdgcn_sched_barrier(0); \
            if (hb + 2 < 16) { ROW_ISSUE(bB_, idB_, hb + 3, tbl); idA_ = idB_; if (hb + 4 < 16) idB_ = ID_LOAD((hb >> 1) + 2); } } } while (0)
#define R_TOKEN(r_) ({ const int q_ = 8 * (r_) + g; const int tl_ = C.bid + (8 * sr + (q_ >> 2)) * C.G; (tl_ < ntile ? (size_t)tl_ * 32 + 4 * wave + (q_ & 3) : (size_t)0); })
    asm volatile("" : "+v"(lane_o));
    { const int g = lane >> 3, pc = lane & 7;
    u32x2v idP0, idP1; { const unsigned* s0_ = G_SID + R_TOKEN(0) * 128; idP0 = *(const u32x2v*)(s0_ + 2 * pc); idP1 = *(const u32x2v*)(s0_ + 16 + 2 * pc); }
    for (int repU = 0; repU < (((MK_REPEAT >> 20) & 5) ? 2 : 1); ++repU)
#pragma unroll 1
    for (int seg = 0; seg < NSEG; ++seg) {
#if MK_PASSBAR == 1
        grid.sync();
#endif
        const unsigned char* tbl = U8 + (size_t)seg * (16384u * SEGB);
#pragma unroll 1
        for (int r = 0; r < 4; ++r) {
            const int q = 8 * r + g; const int tile = C.bid + (8 * sr + (q >> 2)) * C.G; const bool valid = tile < ntile;
            const size_t token = valid ? (size_t)tile * 32 + 4 * wave + (q & 3) : 0;
            const unsigned* sid = G_SID + token * 128; const unsigned* sidn = G_SID + R_TOKEN((r + 1) & 3) * 128;
            const u32x4v x8 = *(const u32x4v*)(H8 + token * 1024 + seg * SEGB + pc * 16);
            LAS int* pdq = (LAS int*)PD + q * 128;
#define U_CONSUME(buf, hb_) do { int pv_[8]; \
                _Pragma("unroll") for (int i = 0; i < 8; ++i) { int a_ = __builtin_amdgcn_sdot4((int)buf[i][0], (int)x8[0], 0, false); a_ = __builtin_amdgcn_sdot4((int)buf[i][1], (int)x8[1], a_, false);     \
                    a_ = __builtin_amdgcn_sdot4((int)buf[i][2], (int)x8[2], a_, false); pv_[i] = __builtin_amdgcn_sdot4((int)buf[i][3], (int)x8[3], a_, false); } \
                int r_[4], q_[2];                                               \
                _Pragma("unroll") for (int i = 0; i < 4; ++i) { const int snd_ = (pc & 4) ? pv_[i] : pv_[i + 4], kp_ = (pc & 4) ? pv_[i + 4] : pv_[i]; r_[i] = kp_ + dppi_xor4(snd_); } \
                _Pragma("unroll") for (int i = 0; i < 2; ++i) { const int snd_ = (pc & 2) ? r_[i] : r_[i + 2], kp_ = (pc & 2) ? r_[i + 2] : r_[i]; q_[i] = kp_ + dppi_xor2(snd_); } \
                const int z_ = ((pc & 1) ? q_[1] : q_[0]) + dppi_xor1((pc & 1) ? q_[0] : q_[1]); \
                if (valid && repU == 0) pdq[8 * (hb_) + pc] += z_; } while (0)
#ifndef MK_NOU
            STREAM(tbl, U_CONSUME);
#endif
#undef U_CONSUME
        }
    }
    }
    LDS_FENCE();
    asm volatile("" : "+v"(lane_o));
#define W_TOKEN(q_) ({ const int tl_ = C.bid + (8 * sr + ((q_) >> 2)) * C.G; (size_t)(tl_ < ntile ? tl_ : C.bid) * 32 + 4 * wave + ((q_) & 3); })
    float nsg0, nsg1, nsu0, nsu1, nhs;
    { const size_t tk_ = W_TOKEN(0); nsg0 = G_SG[tk_ * 128 + lane]; nsg1 = G_SG[tk_ * 128 + 64 + lane]; nsu0 = G_SU[tk_ * 128 + lane]; nsu1 = G_SU[tk_ * 128 + 64 + lane]; nhs = HS[tk_]; }
#pragma unroll 1
    for (int q = 0; q < 32; ++q) { const int tile = C.bid + (8 * sr + (q >> 2)) * C.G;
        const float sg0 = nsg0, sg1 = nsg1, su0 = nsu0, su1 = nsu1, hs = nhs;
        { const size_t tk_ = W_TOKEN(q + 1 < 32 ? q + 1 : q); nsg0 = G_SG[tk_ * 128 + lane]; nsg1 = G_SG[tk_ * 128 + 64 + lane]; nsu0 = G_SU[tk_ * 128 + lane]; nsu1 = G_SU[tk_ * 128 + 64 + lane]; nhs = HS[tk_]; }
        if (tile >= ntile) continue;
        const float w0 = sg0 * gelu_tanh((float)((LAS int*)PD)[q * 128 + lane] * (su0 * hs));
        const float w1 = sg1 * gelu_tanh((float)((LAS int*)PD)[q * 128 + 64 + lane] * (su1 * hs));
        float am = fmaxf(fabsf(w0), fabsf(w1));
        am = wave_max_f(am);
        const float qs = am > 0.f ? 127.f / am : 0.f;
        LAS signed char* w8 = (LAS signed char*)(PD + q * 128);
        w8[lane] = (signed char)(int)__builtin_rintf(w0 * qs); w8[64 + lane] = (signed char)(int)__builtin_rintf(w1 * qs);
        if (lane == 0) WSC[q] = am * (1.f / 127.f); }
#undef W_TOKEN
    LDS_FENCE();
    asm volatile("" : "+v"(lane_o));
    { const int g = lane >> 3, pc = lane & 7;
    const unsigned shb = 8u * (unsigned)(lane & 3), selb = 0x0c0c0c0cu & ~(0xffu << shb);
    u32x2v idP0, idP1; { const unsigned* s0_ = G_SID + R_TOKEN(0) * 128; idP0 = *(const u32x2v*)(s0_ + 2 * pc); idP1 = *(const u32x2v*)(s0_ + 16 + 2 * pc); }
#pragma unroll 1
    for (int seg = 0; seg < NSEG; ++seg) {
#if MK_PASSBAR == 1
        grid.sync();
#endif
        const unsigned char* tbl = V8 + (size_t)seg * (16384u * SEGB);
#pragma unroll 1
        for (int r = 0; r < 4; ++r) {
            const int q = 8 * r + g; const int tile = C.bid + (8 * sr + (q >> 2)) * C.G; const bool valid = tile < ntile;
            const size_t token = valid ? (size_t)tile * 32 + 4 * wave + (q & 3) : 0;
            const unsigned* sid = G_SID + token * 128; const unsigned* sidn = G_SID + R_TOKEN((r + 1) & 3) * 128;
            const LAS unsigned char* wq_ = (const LAS unsigned char*)(PD + q * 128);
            const u32x4v h0 = *(const u32x4v*)(HB + token * 1024 + seg * SEGB + pc * 16), h1 = *(const u32x4v*)(HB + token * 1024 + seg * SEGB + pc * 16 + 8);
            i32x4v accR[4];
#pragma unroll
            for (int j = 0; j < 4; ++j) accR[j] = (i32x4v){0, 0, 0, 0};
#define V_CONSUME(buf, hb_) do { const u32x2v w8_ = *(const LAS u32x2v*)(wq_ + 8 * (hb_)); \
                _Pragma("unroll") for (int i = 0; i < 8; ++i) { const int bop_ = (int)__builtin_amdgcn_perm(w8_.y, w8_.x, selb | ((unsigned)i << shb)); \
                    _Pragma("unroll") for (int r_ = 0; r_ < 4; ++r_) accR[r_] = __builtin_amdgcn_mfma_i32_4x4x4i8((int)buf[i][r_], bop_, accR[r_], 0, 0, 0); } } while (0)
#ifndef MK_NOV
            STREAM(tbl, V_CONSUME);
#endif
#undef V_CONSUME
#pragma unroll
            for (int r_ = 0; r_ < 4; ++r_) {
#pragma unroll
                for (int a = 0; a < 4; a += 2) { const int snd = (pc & 1) ? accR[r_][a] : accR[r_][a + 1]; const int rcv = dppi_xor1(snd); if (pc & 1) accR[r_][a] = rcv; else accR[r_][a + 1] = rcv; }
#pragma unroll
                for (int a = 0; a < 2; ++a) { const int snd = (pc & 2) ? accR[r_][a] : accR[r_][a + 2]; const int rcv = dppi_xor2(snd); if (pc & 2) accR[r_][a] = rcv; else accR[r_][a + 2] = rcv; }
            }
            const float wsq = WSC[q];
            float y[16]; float s1 = 0.f, s2 = 0.f;
#pragma unroll
            for (int j = 0; j < 4; ++j) { y[2 * j] = ALPHA * bf_lo(h0[j]) + (float)accR[j >> 1][2 * (j & 1)] * wsq; y[2 * j + 1] = ALPHA * bf_hi(h0[j]) + (float)accR[j >> 1][2 * (j & 1) + 1] * wsq;
                y[8 + 2 * j] = ALPHA * bf_lo(h1[j]) + (float)accR[2 + (j >> 1)][2 * (j & 1)] * wsq; y[8 + 2 * j + 1] = ALPHA * bf_hi(h1[j]) + (float)accR[2 + (j >> 1)][2 * (j & 1) + 1] * wsq; }
#pragma unroll
            for (int j = 0; j < 16; ++j) { s1 += y[j]; s2 += y[j] * y[j]; }
            s1 += dpp_xor1(s1); s2 += dpp_xor1(s2); s1 += dpp_xor2(s1); s2 += dpp_xor2(s2); s1 += dpp_xor4(s1); s2 += dpp_xor4(s2);
            if (valid) { u16* op = YB + token * 1024 + seg * SEGB + pc * 16;
                u32x4v w0, w1;
#pragma unroll
                for (int c = 0; c < 4; ++c) { w0[c] = cvtpk(y[2 * c], y[2 * c + 1]); w1[c] = cvtpk(y[8 + 2 * c], y[8 + 2 * c + 1]); }
                *(u32x4v*)op = w0; *(u32x4v*)(op + 8) = w1;
                if (pc == 0) { STAT[2 * q] += s1; STAT[2 * q + 1] += s2; } }
        }
    }
    }
    LDS_FENCE();
    asm volatile("" : "+v"(lane_o));
    __builtin_amdgcn_fence(__ATOMIC_RELEASE, "workgroup");
    asm volatile("s_waitcnt vmcnt(0)" ::: "memory");
#define L_TOKEN(q_) ({ const int tl_ = C.bid + (8 * sr + ((q_) >> 2)) * C.G; (size_t)(tl_ < ntile ? tl_ : C.bid) * 32 + 4 * wave + ((q_) & 3); })
    u32x4v yn0, yn1; { const size_t tk_ = L_TOKEN(0); yn0 = *(const u32x4v*)(YB + tk_ * 1024 + lane * 16); yn1 = *(const u32x4v*)(YB + tk_ * 1024 + lane * 16 + 8); }
    f32x4v ga4[4], ba4[4];
#pragma unroll
    for (int c = 0; c < 4; ++c) { ga4[c] = *(const f32x4v*)(g2 + lane * 16 + 4 * c); ba4[c] = *(const f32x4v*)(b2 + lane * 16 + 4 * c); }
#pragma unroll 1
    for (int q = 0; q < 32; ++q) { const int tile = C.bid + (8 * sr + (q >> 2)) * C.G;
        const u32x4v y0 = yn0, y1 = yn1;
        { const size_t tk_ = L_TOKEN(q + 1 < 32 ? q + 1 : q); yn0 = *(const u32x4v*)(YB + tk_ * 1024 + lane * 16); yn1 = *(const u32x4v*)(YB + tk_ * 1024 + lane * 16 + 8); }
        if (tile >= ntile) continue;
        const size_t token = (size_t)tile * 32 + 4 * wave + (q & 3);
        const float mu = STAT[2 * q] * (1.f / 1024.f), var = STAT[2 * q + 1] * (1.f / 1024.f) - mu * mu;
        const float rstd = __builtin_amdgcn_rsqf(fmaxf(var, 0.f) + EPS);
        float* op = C.out + token * 1024 + lane * 16;
#pragma unroll
        for (int c = 0; c < 4; ++c) { const u32x4v& yy = c < 2 ? y0 : y1; const f32x4v yv = {bf_lo(yy[2 * (c & 1)]), bf_hi(yy[2 * (c & 1)]), bf_lo(yy[2 * (c & 1) + 1]), bf_hi(yy[2 * (c & 1) + 1])};
            *(f32x4v*)(op + 4 * c) = (yv - mu) * rstd * ga4[c] + ba4[c]; } }
#undef L_TOKEN
#undef ID_LOAD
#undef R_TOKEN
#undef ROW_ISSUE
#undef STREAM
#undef lane
#undef wave
    __syncthreads();
    }
}


#ifndef MK_LAUNCHES
#define MK_LAUNCHES 1
#endif
constexpr int NPHASE = 7;
#define REP(k) for (int rep_ = 0; rep_ < (((MK_REPEAT >> (k)) & 1) ? 2 : 1); ++rep_, ((MK_REPEAT >> (k)) & 1) ? grid.sync() : (void)0)


__global__ void __launch_bounds__(NTHREADS, 2) hymba_fwd(Args args) {
    extern __shared__ __attribute__((aligned(16))) unsigned char lds_raw[];
    Ctx C;
    C.lds = (LAS unsigned char*)lds_raw;
    C.tid = threadIdx.x; C.lane = C.tid & 63; C.wave = __builtin_amdgcn_readfirstlane(C.tid >> 6);
    C.G = gridDim.x; C.bid = blockIdx.x;
#pragma unroll
    for (int i = 0; i < 16; ++i) C.in[i] = args.in[i];
    C.out = args.out; C.ws = args.ws;
    const int lo = args.ph_lo, hi = args.ph_hi;
    cg::grid_group grid = cg::this_grid();
#ifdef MK_ONLY
#define IN(k) ((k) == MK_ONLY)
#else
#define IN(k) (lo <= (k) && (k) < hi)
#endif
    unsigned bar_target = 0u;
#define SEAM(k) do { if (IN(k) && IN((k) + 1)) { if ((k) == 0 || MK_REPEAT || !MK_CUSTOM_BAR) grid.sync(); else grid_bar(C, bar_target); } } while (0)
    unsigned char* ws = C.ws;
    if (IN(0)) REP(0) p0_prologue(C);
    SEAM(0);
    if (IN(0)) p0b_quant(C);
    SEAM(0);
    if (IN(1)) REP(1) {
        pg8::Gemm g{(const pg8::bf16_t*)(ws + WS_XB), (const pg8::bf16_t*)(ws + WS_W1Q), MTOK, N1, DM / 2};
        pg8::StaticOrder S; S.init(MTOK, N1, C.G, C.bid);
        pg8::EpiProj E{(pg8::bf16_t*)(ws + WS_QLAT), (pg8::bf16_t*)(ws + WS_QIDX), (pg8::bf16_t*)(ws + WS_CKV), (pg8::bf16_t*)(ws + WS_KIDX), (float*)(ws + WS_WIDX), (float*)(ws + WS_SSQ),
                       (pg8::bf16_t*)(ws + WS_HQ), (float*)(ws + WS_HLF), (pg8::bf16_t*)(ws + WS_HV), (pg8::bf16_t*)(ws + WS_HG), (const float*)(ws + WS_LB), (const float*)(ws + WS_XS), (const float*)(ws + WS_W1S)};
        pg8::gemm_phase<pg8::EpiProj, pg8::StaticOrder, true, true, true>(C.lds, g, S, E);
    }
    SEAM(1);
    if (IN(2)) REP(2) p2_mixers(C, rep_);
    SEAM(2);
    if (IN(3)) REP(3) {
        pg8::Gemm g{(const pg8::bf16_t*)(ws + WS_MIX), (const pg8::bf16_t*)(ws + WS_W3M), MTOK, DM, MIXB / 2};
        pg8::StaticOrder S; S.init(MTOK, DM, C.G, C.bid);
        pg8::EpiY1 E{C.in[I_X], (pg8::bf16_t*)(ws + WS_Y1), ALPHA, (const float*)(ws + WS_MIXS), (const float*)(ws + WS_W3S)};
        pg8::gemm_phase<pg8::EpiY1, pg8::StaticOrder, true, true, false, 8>(C.lds, g, S, E);
    }
    SEAM(3);
    if (IN(4)) REP(4) p4_ln1(C);
    SEAM(4);
    if (IN(5)) REP(5) {
        pg8::Gemm g{(const pg8::bf16_t*)(ws + WS_H8), (const pg8::bf16_t*)(ws + WS_W5Q), MTOK, NPQ, DM / 2};
        pg8::StaticOrder S; S.init(MTOK, NPQ, C.G, C.bid);
        pg8::EpiPQ E{(pg8::bf16_t*)(ws + WS_PQ), NPQ, (const float*)(ws + WS_HS), (const float*)(ws + WS_W5S)};
        pg8::gemm_phase<pg8::EpiPQ, pg8::StaticOrder, true, true, true>(C.lds, g, S, E);
    }
    SEAM(5);
    if (IN(6)) REP(6) p6_peer(C);
#undef IN
#undef SEAM
}

extern "C" void kernel_launch(void* const* d_in, const int* in_sizes, int n_in, void* d_out, int out_size, void* d_ws, size_t ws_size, hipStream_t stream) {
    static int grid = 0;
    if (grid == 0) {
        if (n_in != 16 || out_size != MTOK * DM || ws_size < WS_END) { fprintf(stderr, "kernel_launch: unexpected shapes (n_in %d, out %d, ws %zu)\n", n_in, out_size, ws_size); grid = -1; return; }
        int dev = 0, cus = 0, per_cu = 0;
        if (hipGetDevice(&dev) != hipSuccess || hipDeviceGetAttribute(&cus, hipDeviceAttributeMultiprocessorCount, dev) != hipSuccess) { grid = -1; return; }
        if (hipFuncSetAttribute((const void*)hymba_fwd, hipFuncAttributeMaxDynamicSharedMemorySize, LDS_BYTES) != hipSuccess) { fprintf(stderr, "kernel_launch: hipFuncSetAttribute failed\n"); grid = -1; return; }
        if (hipOccupancyMaxActiveBlocksPerMultiprocessor(&per_cu, (const void*)hymba_fwd, NTHREADS, LDS_BYTES) != hipSuccess || per_cu < 1) { fprintf(stderr, "kernel_launch: occupancy query says %d blocks per CU\n", per_cu); (void)hipGetLastError(); grid = -1; return; }
        grid = cus;
    }
    if (grid < 0) return;
    Args a{};
    for (int i = 0; i < 16; ++i) a.in[i] = (const float*)d_in[i];
    a.out = (float*)d_out; a.ws = (unsigned char*)d_ws;
#if MK_LAUNCHES == 1
    a.ph_lo = 0; a.ph_hi = NPHASE;
    void* kargs[] = {&a};
    hipError_t e = hipLaunchCooperativeKernel((const void*)hymba_fwd, dim3(grid), dim3(NTHREADS), kargs, LDS_BYTES, stream);
    if (e != hipSuccess) fprintf(stderr, "kernel_launch: cooperative launch failed: %s (grid %d)\n", hipGetErrorString(e), grid);
#else
    for (int p = 0; p < NPHASE; ++p) { a.ph_lo = p; a.ph_hi = p + 1; hipLaunchKernelGGL(hymba_fwd, dim3(grid), dim3(NTHREADS), LDS_BYTES, stream, a); }
#endif
}
```

```cpp
#include <hip/hip_runtime.h>
#include <hip/hip_cooperative_groups.h>
#include <cstdio>
#include <cstdint>
namespace cg = cooperative_groups;

#define LAS __attribute__((address_space(3)))
typedef unsigned short u16;
typedef short s16x8 __attribute__((ext_vector_type(8)));
typedef short s16x4 __attribute__((ext_vector_type(4)));
typedef float f32x4v __attribute__((ext_vector_type(4)));
typedef float f32x16v __attribute__((ext_vector_type(16)));
typedef unsigned u32x4v __attribute__((ext_vector_type(4)));
typedef unsigned u32x2v __attribute__((ext_vector_type(2)));
typedef __bf16 bf16x2v __attribute__((ext_vector_type(2)));

constexpr int NB = 8, SEQ = 8192, DM = 1024, MTOK = NB * SEQ;
constexpr int DIN = 3272;
constexpr int N1 = 3840;
constexpr int K3 = 1536;
constexpr int NPQ = 2048;
constexpr float EPS = 1e-5f;
constexpr float ALPHA = 1.189207115002721f;
constexpr int TOPK = 256;

constexpr size_t MiB = 1u << 20;
constexpr size_t WS_CTL = 0, WS_LB = 4096, WS_USC = 65536, WS_VSC = 131072;
constexpr size_t WS_W1T = 1 * MiB, WS_W3T = 9 * MiB, WS_W5T = 12 * MiB, WS_SKB = 16 * MiB, WS_UB = 17 * MiB, WS_VB = 49 * MiB;
constexpr size_t WS_XB = 96 * MiB, WS_MIX = 96 * MiB;
constexpr size_t WS_H8 = WS_MIX + 96 * MiB, WS_HS = WS_MIX + 160 * MiB;
constexpr size_t WS_W1Q = 36 * MiB, WS_W1S = 272 * 1024, WS_XS = 40 * MiB;
constexpr size_t WS_W3M = 44 * MiB, WS_W3S = 288 * 1024, WS_MIXS = 41 * MiB;
constexpr int MIXB = 2048;
constexpr size_t WS_W5Q = 34 * MiB, WS_W5S = 256 * 1024;
constexpr size_t WS_R2 = 288 * MiB;
constexpr size_t WS_QLAT = WS_R2, WS_QIDX = WS_R2 + 128 * MiB, WS_CKV = WS_R2 + 192 * MiB, WS_KIDX = WS_R2 + 208 * MiB, WS_WIDX = WS_R2 + 216 * MiB, WS_SSQ = WS_R2 + 218 * MiB;
constexpr size_t WS_HQ = WS_R2 + 224 * MiB, WS_HLF = WS_R2 + 288 * MiB, WS_HV = WS_R2 + 416 * MiB, WS_HG = WS_R2 + 480 * MiB;
constexpr size_t WS_Y1 = WS_R2, WS_HB = WS_R2 + 256 * MiB, WS_PQ = WS_R2;
constexpr size_t WS_YB = WS_R2 + 384 * MiB;
constexpr size_t WS_END = WS_R2 + 544 * MiB;

#ifndef MK_REPEAT
#define MK_REPEAT 0
#endif
#ifndef MK_NOSORT
#define MK_NOSORT 0
#endif
constexpr int LDS_BYTES = 160 * 1024;
constexpr int NTHREADS = 512;

typedef float f32x2v __attribute__((ext_vector_type(2)));
__device__ __forceinline__ unsigned cvtpk(float lo, float hi) { const f32x2v v = {lo, hi}; const bf16x2v b = __builtin_convertvector(v, bf16x2v); return __builtin_bit_cast(unsigned, b); }
__device__ __forceinline__ float bf_lo(unsigned w) { return __builtin_bit_cast(float, w << 16); }
__device__ __forceinline__ float bf_hi(unsigned w) { return __builtin_bit_cast(float, w & 0xffff0000u); }
__device__ __forceinline__ float bf1(u16 w) { return __builtin_bit_cast(float, (unsigned)w << 16); }
__device__ __forceinline__ float fast_exp(float x) { return __builtin_amdgcn_exp2f(x * 1.4426950408889634f); }
__device__ __forceinline__ float sigmoidf_(float x) { return __builtin_amdgcn_rcpf(1.f + fast_exp(-x)); }
__device__ __forceinline__ float siluf_(float x) { return x * sigmoidf_(x); }
typedef int i32x4v __attribute__((ext_vector_type(4)));
__device__ __forceinline__ unsigned pack_i8(float a, float b, float c, float d) {
    const int ia = (int)__builtin_rintf(a), ib = (int)__builtin_rintf(b), ic = (int)__builtin_rintf(c), id = (int)__builtin_rintf(d);
    return ((unsigned)ia & 0xffu) | (((unsigned)ib & 0xffu) << 8) | (((unsigned)ic & 0xffu) << 16) | ((unsigned)id << 24);
}
__device__ __forceinline__ float dot2bf(unsigned a, unsigned b, float acc) { return __builtin_amdgcn_fdot2_f32_bf16(__builtin_bit_cast(bf16x2v, a), __builtin_bit_cast(bf16x2v, b), acc, false); }
__device__ __forceinline__ float dpp_xor1(float v) { return __builtin_bit_cast(float, __builtin_amdgcn_update_dpp(0, __builtin_bit_cast(int, v), 0xB1, 0xf, 0xf, true)); }
__device__ __forceinline__ float dpp_xor2(float v) { return __builtin_bit_cast(float, __builtin_amdgcn_update_dpp(0, __builtin_bit_cast(int, v), 0x4E, 0xf, 0xf, true)); }
__device__ __forceinline__ int dppi_xor1(int v) { return __builtin_amdgcn_update_dpp(0, v, 0xB1, 0xf, 0xf, true); }
__device__ __forceinline__ int dppi_xor2(int v) { return __builtin_amdgcn_update_dpp(0, v, 0x4E, 0xf, 0xf, true); }
__device__ __forceinline__ int dppi_xor4(int v) { return __builtin_amdgcn_update_dpp(0, __builtin_amdgcn_update_dpp(0, v, 0x141, 0xf, 0xf, true), 0x1B, 0xf, 0xf, true); }
__device__ __forceinline__ float dpp_xor4(float v) { const int t = __builtin_amdgcn_update_dpp(0, __builtin_bit_cast(int, v), 0x141, 0xf, 0xf, true); return __builtin_bit_cast(float, __builtin_amdgcn_update_dpp(0, t, 0x1B, 0xf, 0xf, true)); }
__device__ __forceinline__ float dpp_rowmirror(float v) { return __builtin_bit_cast(float, __builtin_amdgcn_update_dpp(0, __builtin_bit_cast(int, v), 0x140, 0xf, 0xf, true)); }
__device__ __forceinline__ float wave_max_f(float v) { v = fmaxf(v, dpp_xor1(v)); v = fmaxf(v, dpp_xor2(v)); v = fmaxf(v, dpp_xor4(v)); v = fmaxf(v, dpp_rowmirror(v)); v = fmaxf(v, __shfl_xor(v, 16)); return fmaxf(v, __shfl_xor(v, 32)); }
__device__ __forceinline__ float wave_sum_f(float v) { v += dpp_xor1(v); v += dpp_xor2(v); v += dpp_xor4(v); v += dpp_rowmirror(v); v += __shfl_xor(v, 16); return v + __shfl_xor(v, 32); }
#define LDS_FENCE() asm volatile("s_waitcnt lgkmcnt(0)" ::: "memory")

namespace pg8 {
#define PG8_LAS __attribute__((address_space(3)))
typedef unsigned short bf16_t;
typedef short bf16x8 __attribute__((ext_vector_type(8)));
typedef float f32x4 __attribute__((ext_vector_type(4)));
typedef unsigned u32x4 __attribute__((ext_vector_type(4)));
constexpr int BM = 256, BK = 64, HALF = 128, HTB = HALF * BK * 2  , STAGE_BYTES = 8 * HTB, NXCD = 8, WGM = 8;

__host__ __device__ __forceinline__ int lds_byte(int r, int c) { const int st = (r >> 4) * 2 + (c >> 5), rr = r & 15, cc = c & 31, ob = rr * 64 + cc * 2; return st * 1024 + (ob ^ (((ob >> 9) & 1) << 5)); }
__host__ __device__ __forceinline__ void stage_rc(int b, int& R, int& C) { const int st = b / 1024, sb = b % 1024, swz = sb ^ (((sb >> 9) & 1) << 5); R = (st >> 1) * 16 + swz / 64; C = (st & 1) * 32 + (swz % 64) / 2; }
__host__ __device__ __forceinline__ int perm32(int rho) { const int n = rho >> 4, i = rho & 15; return 8 * (i >> 2) + 4 * n + (i & 3); }

typedef int pg8_i32x4 __attribute__((ext_vector_type(4)));
struct Unit { int pm, pn; };
struct Gemm { const bf16_t* A; const bf16_t* Bt; int M, N, K; };

struct StaticOrder {
    int nM, nN, nwg, G, c;
    __host__ __device__ void init(int M, int N, int G_, int c_) { nM = M / BM; nN = N / BM; nwg = nM * nN; G = G_; c = c_; }
    __host__ __device__ bool next(int i, Unit& u) const {
        const long L = (long)i * G + c; if (L >= nwg) return false;
        int wgid = (int)L; { const int q = nwg / NXCD, r = nwg % NXCD, xcd = wgid % NXCD, off = wgid / NXCD; wgid = (xcd < r ? xcd * (q + 1) : r * (q + 1) + (xcd - r) * q) + off; }
        const int nig = WGM * nN, gid = wgid / nig, fm = gid * WGM, gsz = (nM - fm) < WGM ? (nM - fm) : WGM;
        u.pm = fm + ((wgid % nig) % gsz); u.pn = (wgid % nig) / gsz; return true;
    }
    __device__ __forceinline__ void a_ready(const Unit&) const {}
    __device__ __forceinline__ void done(const Unit&) const {}
};

__device__ __forceinline__ unsigned cvt_pk_bf16(float lo, float hi) { return cvtpk(lo, hi); }
typedef float f32x2 __attribute__((ext_vector_type(2)));

__device__ __forceinline__ u32x4 pack8(const f32x4& v0, const f32x4& v1) { u32x4 w; w.x = cvt_pk_bf16(v0[0], v0[1]); w.y = cvt_pk_bf16(v0[2], v0[3]); w.z = cvt_pk_bf16(v1[0], v1[1]); w.w = cvt_pk_bf16(v1[2], v1[3]); return w; }

struct EpiPlain {
    static constexpr bool PERM = true, AFTER_DRAIN = false;
    bf16_t* O; int ldc;
    __device__ __forceinline__ void operator()(const f32x4 (&acc)[2][2][4][2], const Unit& u, int wr, int wc, int fr, int fq) const {
        const int row0 = u.pm * BM + wr * 64 + fr, col0 = u.pn * BM + wc * 32 + 8 * fq;
#pragma unroll
        for (int ai = 0; ai < 2; ++ai)
#pragma unroll
            for (int m = 0; m < 4; ++m) { bf16_t* rowp = O + (size_t)(row0 + ai * HALF + m * 16) * ldc + col0;
#pragma unroll
                for (int bj = 0; bj < 2; ++bj) *(u32x4*)(rowp + bj * HALF) = pack8(acc[ai][bj][m][0], acc[ai][bj][m][1]); }
    }
};

struct EpiPQ {
    static constexpr bool PERM = true, AFTER_DRAIN = false;
    bf16_t* O; int ldc; const float* rs; const float* cs;
    __device__ __forceinline__ void operator()(const f32x4 (&acc)[2][2][4][2], const Unit& u, int wr, int wc, int fr, int fq) const {
        const int row0 = u.pm * BM + wr * 64 + fr, col0 = u.pn * BM + wc * 32 + 8 * fq;
        f32x4 c0[2], c1[2];
#pragma unroll
        for (int bj = 0; bj < 2; ++bj) { c0[bj] = *(const f32x4*)(cs + col0 + bj * HALF); c1[bj] = *(const f32x4*)(cs + col0 + bj * HALF + 4); }
#pragma unroll
        for (int ai = 0; ai < 2; ++ai)
#pragma unroll
            for (int m = 0; m < 4; ++m) { const int row = row0 + ai * HALF + m * 16; const float sr = rs[row]; bf16_t* rowp = O + (size_t)row * ldc + col0;
#pragma unroll
                for (int bj = 0; bj < 2; ++bj) {
                    const f32x4 v0 = __builtin_convertvector(__builtin_bit_cast(pg8_i32x4, acc[ai][bj][m][0]), f32x4) * sr * c0[bj], v1 = __builtin_convertvector(__builtin_bit_cast(pg8_i32x4, acc[ai][bj][m][1]), f32x4) * sr * c1[bj];
                    *(u32x4*)(rowp + bj * HALF) = pack8(v0, v1); } }
    }
};

struct EpiY1 {
    static constexpr bool PERM = true, AFTER_DRAIN = false;
    const float* X; bf16_t* Y; float alpha; const float* rs; const float* cs;
    __device__ __forceinline__ void to_float(f32x4 (&acc)[2][2][4][2], const Unit& u, int wr, int wc, int fr, int fq) const {
        const int row0 = u.pm * BM + wr * 64 + fr;
#pragma unroll
        for (int ai = 0; ai < 2; ++ai)
#pragma unroll
            for (int m = 0; m < 4; ++m) { const float sr = rs[row0 + ai * HALF + m * 16];
#pragma unroll
                for (int bj = 0; bj < 2; ++bj)
#pragma unroll
                    for (int n = 0; n < 2; ++n) acc[ai][bj][m][n] = __builtin_convertvector(__builtin_bit_cast(pg8_i32x4, acc[ai][bj][m][n]), f32x4) * sr; }
    }
    __device__ __forceinline__ void operator()(const f32x4 (&acc)[2][2][4][2], const Unit& u, int wr, int wc, int fr, int fq) const {
        const int row0 = u.pm * BM + wr * 64 + fr, col0 = u.pn * BM + wc * 32 + 8 * fq;
#pragma unroll
        for (int ai = 0; ai < 2; ++ai)
#pragma unroll
            for (int m = 0; m < 4; ++m) { const size_t o = (size_t)(row0 + ai * HALF + m * 16) * 1024 + col0;
#pragma unroll
                for (int bj = 0; bj < 2; ++bj) {
                    const f32x4 x0 = *(const f32x4*)(X + o + bj * HALF), x1 = *(const f32x4*)(X + o + bj * HALF + 4);
                    const f32x4 c0 = *(const f32x4*)(cs + col0 + bj * HALF), c1 = *(const f32x4*)(cs + col0 + bj * HALF + 4);
                    *(u32x4*)(Y + o + bj * HALF) = pack8(x0 * alpha + acc[ai][bj][m][0] * c0, x1 * alpha + acc[ai][bj][m][1] * c1); } }
    }
};

__device__ __forceinline__ float ep_exp(float x) { return __builtin_amdgcn_exp2f(x * 1.4426950408889634f); }
__device__ __forceinline__ float ep_sig(float x) { return __builtin_amdgcn_rcpf(1.f + ep_exp(-x)); }
__device__ __forceinline__ f32x4 silu4(const f32x4& v) { f32x4 r; r[0] = v[0] * ep_sig(v[0]); r[1] = v[1] * ep_sig(v[1]); r[2] = v[2] * ep_sig(v[2]); r[3] = v[3] * ep_sig(v[3]); return r; }

struct EpiProj {
    static constexpr bool PERM = true, AFTER_DRAIN = false;
    bf16_t *QLAT, *QIDX, *CKV, *KIDX; float *WIDX, *SSQ; bf16_t* HQ; float* HLF; bf16_t *HV, *HG; const float* lb; const float* rs; const float* cs;
    __device__ __forceinline__ void operator()(const f32x4 (&acc)[2][2][4][2], const Unit& u, int wr, int wc, int fr, int fq) const {
        const int row0 = u.pm * BM + wr * 64 + fr, pn = u.pn;
        f32x4 cv[2][2];
#pragma unroll
        for (int bj = 0; bj < 2; ++bj)
#pragma unroll
            for (int n = 0; n < 2; ++n) cv[bj][n] = *(const f32x4*)(cs + pn * BM + bj * HALF + wc * 32 + 8 * fq + 4 * n);
#define PJ_A(ai, bj, m, n, sr) (__builtin_convertvector(__builtin_bit_cast(pg8_i32x4, acc[ai][bj][m][n]), f32x4) * (sr) * cv[bj][n])
        if (pn < 6) {
            bf16_t* base = pn < 4 ? QLAT : QIDX; const int ld = pn < 4 ? 1024 : 512; const int col0 = (pn < 4 ? pn : pn - 4) * BM + wc * 32 + 8 * fq;
#pragma unroll
            for (int ai = 0; ai < 2; ++ai)
#pragma unroll
                for (int m = 0; m < 4; ++m) { const int row = row0 + ai * HALF + m * 16; const float sr = rs[row]; bf16_t* rowp = base + (size_t)row * ld + col0;
#pragma unroll
                    for (int bj = 0; bj < 2; ++bj) *(u32x4*)(rowp + bj * HALF) = pack8(PJ_A(ai, bj, m, 0, sr), PJ_A(ai, bj, m, 1, sr)); }
        } else if (pn == 6) {
#pragma unroll
            for (int ai = 0; ai < 2; ++ai)
#pragma unroll
                for (int m = 0; m < 4; ++m) { const size_t r = (size_t)(row0 + ai * HALF + m * 16); const float sr = rs[r];
                    const f32x4 v0 = PJ_A(ai, 0, m, 0, sr), v1 = PJ_A(ai, 0, m, 1, sr);
                    *(u32x4*)(CKV + r * 128 + wc * 32 + 8 * fq) = pack8(v0, v1);
                    float ss = v0[0] * v0[0] + v0[1] * v0[1] + v0[2] * v0[2] + v0[3] * v0[3] + v1[0] * v1[0] + v1[1] * v1[1] + v1[2] * v1[2] + v1[3] * v1[3];
                    ss += __shfl_xor(ss, 16); ss += __shfl_xor(ss, 32);
                    if (fq == 0) SSQ[r * 4 + wc] = ss;
                    const f32x4 w0 = PJ_A(ai, 1, m, 0, sr), w1 = PJ_A(ai, 1, m, 1, sr);
                    if (wc < 2) *(u32x4*)(KIDX + r * 64 + wc * 32 + 8 * fq) = pack8(w0, w1);
                    else if (wc == 2 && fq == 0) { *(f32x4*)(WIDX + r * 8) = w0; *(f32x4*)(WIDX + r * 8 + 4) = w1; } }
        } else {
            const int h = pn - 7; const int e0 = (wc & 1) * 32 + 8 * fq;
            f32x4 l0 = {0.f, 0.f, 0.f, 0.f}, l1 = l0;
            if (wc >= 2) { l0 = *(const f32x4*)(lb + h * 64 + e0); l1 = *(const f32x4*)(lb + h * 64 + e0 + 4); }
#pragma unroll
            for (int ai = 0; ai < 2; ++ai)
#pragma unroll
                for (int m = 0; m < 4; ++m) { const int row = row0 + ai * HALF + m * 16; const float sr = rs[row]; const size_t o = (size_t)row * 512 + h * 64 + e0;
                    const f32x4 a0 = PJ_A(ai, 0, m, 0, sr), a1 = PJ_A(ai, 0, m, 1, sr), b0 = PJ_A(ai, 1, m, 0, sr), b1 = PJ_A(ai, 1, m, 1, sr);
                    if (wc < 2) {
                        *(u32x4*)(HQ + o) = pack8(silu4(a0), silu4(a1));
                        *(u32x4*)(HV + o) = pack8(b0, b1);
                    } else {
                        f32x4 f0, f1;
#pragma unroll
                        for (int j = 0; j < 4; ++j) { f0[j] = __builtin_amdgcn_logf(l0[j] + (1.f - l0[j]) * ep_sig(a0[j])) * 0.6931471805599453f; f1[j] = __builtin_amdgcn_logf(l1[j] + (1.f - l1[j]) * ep_sig(a1[j])) * 0.6931471805599453f; }
                        *(f32x4*)(HLF + o) = f0; *(f32x4*)(HLF + o + 4) = f1;
                        *(u32x4*)(HG + o) = pack8(silu4(b0), silu4(b1));
                    } }
        }
#undef PJ_A
    }
};
template <bool I8> __device__ __forceinline__ f32x4 mma_sel(const bf16x8& a, const bf16x8& b, const f32x4& c) {
    if constexpr (I8) return __builtin_bit_cast(f32x4, __builtin_amdgcn_mfma_i32_16x16x64_i8(__builtin_bit_cast(pg8_i32x4, a), __builtin_bit_cast(pg8_i32x4, b), __builtin_bit_cast(pg8_i32x4, c), 0, 0, 0));
    else return __builtin_amdgcn_mfma_f32_16x16x32_bf16(a, b, c, 0, 0, 0);
}
template <class Epi, class Sched, bool ALIGN_EPI = false, bool SP2 = false, bool I8 = false, int KSW = 0>
__device__ __forceinline__ void gemm_phase(PG8_LAS unsigned char* lds, const Gemm g, const Sched& S, const Epi& E) {
    const int tid = threadIdx.x, wid = __builtin_amdgcn_readfirstlane(tid >> 6), lane = tid & 63, wr = wid >> 2, wc = wid & 3, fr = lane & 15, fq = lane >> 4;
    const int K = g.K, nt = K / BK;
    unsigned voffA[2], voffB[2];
#pragma unroll
    for (int i = 0; i < 2; ++i) { int R, C; stage_rc(tid * 16 + i * 8192, R, C); const int Rb = Epi::PERM ? ((R & ~31) + perm32(R & 31)) : R;
        voffA[i] = (unsigned)(R * K + C) * 2u; voffB[i] = (unsigned)(Rb * K + C) * 2u; }
    const size_t kstep = (size_t)(BK * 2);
    const size_t hstep = (size_t)HALF * K * 2;
    const size_t tstep = 2 * hstep;
    const unsigned ldsw = (unsigned)wid * 1024u;
    const int aoff = lds_byte(wr * 64 + fr, fq * 8), boff = lds_byte(wc * 32 + fr, fq * 8);
#define PG8_SA(b, h) (((b) * 2 + (h)) * HTB)
#define PG8_SB(b, h) ((4 + (b) * 2 + (h)) * HTB)
#define PG8_STAGE(bufoff, gbase, voff) do { _Pragma("unroll") for (int _i = 0; _i < 2; ++_i) \
        __builtin_amdgcn_global_load_lds((const unsigned*)((const char*)(gbase) + (voff)[_i]), (PG8_LAS unsigned*)(lds + (bufoff) + ldsw + _i * 8192), 16, 0, 0); } while (0)
#define PG8_LDA(dst, b, h) do { _Pragma("unroll") for (int m = 0; m < 4; ++m) _Pragma("unroll") for (int k = 0; k < 2; ++k) dst[m][k] = *(const PG8_LAS bf16x8*)(lds + PG8_SA(b, h) + aoff + m * 2048 + k * 1024); } while (0)
#define PG8_LDB(dst, b, h) do { _Pragma("unroll") for (int n = 0; n < 2; ++n) _Pragma("unroll") for (int k = 0; k < 2; ++k) dst[n][k] = *(const PG8_LAS bf16x8*)(lds + PG8_SB(b, h) + boff + n * 2048 + k * 1024); } while (0)
#define PG8_MMA_LOOP(ai, bj, At, Bt, SEL) _Pragma("unroll") for (int m = 0; m < 4; ++m) _Pragma("unroll") for (int n = 0; n < 2; ++n) _Pragma("unroll") for (int k = 0; k < 2; ++k) \
        acc[ai][bj][m][n] = mma_sel<SEL>(Bt[n][k], At[m][k], acc[ai][bj][m][n]);
#define PG8_MMA(ai, bj, At, Bt) do { __builtin_amdgcn_s_setprio(1); \
        if constexpr (KSW > 0) { if (i8m) { PG8_MMA_LOOP(ai, bj, At, Bt, true) } else { PG8_MMA_LOOP(ai, bj, At, Bt, false) } } else { PG8_MMA_LOOP(ai, bj, At, Bt, I8) } \
        __builtin_amdgcn_s_setprio(0); } while (0)
#define PG8_WAIT_V(n) asm volatile("s_waitcnt vmcnt(" #n ")" ::: "memory")
#define PG8_WAIT_L(n) asm volatile("s_waitcnt lgkmcnt(" #n ")" ::: "memory")
#define PG8_BAR __builtin_amdgcn_s_barrier()
#define PG8_SCHED __builtin_amdgcn_sched_barrier(0)
    Unit cur, nxt; int ui = 0;
    if (!S.next(0, cur)) return;
    f32x4 acc[2][2][4][2];
#pragma unroll
    for (int a = 0; a < 2; ++a)
#pragma unroll
        for (int b = 0; b < 2; ++b)
#pragma unroll
            for (int m = 0; m < 4; ++m)
#pragma unroll
                for (int n = 0; n < 2; ++n) acc[a][b][m][n] = (f32x4){0.f, 0.f, 0.f, 0.f};
    bf16x8 At[4][2], B0[2][2], B1[2][2];
    const char* cA = (const char*)g.A + (size_t)cur.pm * tstep; const char* cB = (const char*)g.Bt + (size_t)cur.pn * tstep;
    S.a_ready(cur);
    if constexpr (SP2) {
        PG8_STAGE(PG8_SB(0, 0), cB, voffB); PG8_STAGE(PG8_SB(0, 1), cB + hstep, voffB); PG8_STAGE(PG8_SA(0, 0), cA, voffA); PG8_STAGE(PG8_SA(0, 1), cA + hstep, voffA);
        if (wr == 1) PG8_BAR;
        PG8_WAIT_V(2); PG8_BAR;
        PG8_STAGE(PG8_SB(1, 0), cB + kstep, voffB); PG8_STAGE(PG8_SA(1, 0), cA + kstep, voffA); PG8_STAGE(PG8_SB(1, 1), cB + hstep + kstep, voffB);
        PG8_WAIT_V(6); PG8_BAR;
    } else {
        PG8_STAGE(PG8_SB(0, 0), cB, voffB); PG8_STAGE(PG8_SA(0, 0), cA, voffA); PG8_STAGE(PG8_SB(0, 1), cB + hstep, voffB); PG8_STAGE(PG8_SA(0, 1), cA + hstep, voffA);
        if (wr == 1) PG8_BAR;
        PG8_WAIT_V(4); PG8_BAR;
        PG8_STAGE(PG8_SB(1, 0), cB + kstep, voffB); PG8_STAGE(PG8_SA(1, 0), cA + kstep, voffA); PG8_STAGE(PG8_SB(1, 1), cB + hstep + kstep, voffB);
        PG8_WAIT_V(6); PG8_BAR;
    }
    for (;;) {
        const bool has_next = S.next(ui + 1, nxt);
        const char* nA = has_next ? (const char*)g.A + (size_t)nxt.pm * tstep : cA; const char* nB = has_next ? (const char*)g.Bt + (size_t)nxt.pn * tstep : cB;
#pragma unroll
        for (int seg = 0; seg < (KSW > 0 ? 2 : 1); ++seg) {
        const bool i8m = (seg == 0); (void)i8m;
        if constexpr (KSW > 0) { if (seg == 1) E.to_float(acc, cur, wr, wc, fr, fq); }
        for (int t = (seg ? KSW : 0); t < ((KSW > 0 && seg == 0) ? KSW : nt); t += 2) {
            const bool last = (t == nt - 2);
            const char* a1 = cA + (size_t)(t + 1) * kstep;
            const char* a2 = last ? nA : cA + (size_t)(t + 2) * kstep; const char* b2 = last ? nB : cB + (size_t)(t + 2) * kstep;
            const char* a3 = a2 + kstep; const char* b3 = b2 + kstep;
            if (last && has_next) S.a_ready(nxt);
            if constexpr (SP2) {
            PG8_LDB(B0, 0, 0); PG8_LDB(B1, 0, 1); PG8_SCHED; PG8_LDA(At, 0, 0); PG8_STAGE(PG8_SA(1, 1), a1 + hstep, voffA);
            PG8_WAIT_V(8); PG8_WAIT_L(0); PG8_BAR; PG8_MMA(0, 0, At, B0); PG8_MMA(0, 1, At, B1); PG8_BAR; PG8_SCHED;
            PG8_LDA(At, 0, 1); PG8_STAGE(PG8_SB(0, 0), b2, voffB); PG8_STAGE(PG8_SB(0, 1), b2 + hstep, voffB); PG8_STAGE(PG8_SA(0, 0), a2, voffA);
            PG8_WAIT_V(8); PG8_WAIT_L(0); PG8_BAR; PG8_MMA(1, 0, At, B0); PG8_MMA(1, 1, At, B1); PG8_BAR; PG8_SCHED;
            PG8_LDB(B0, 1, 0); PG8_LDB(B1, 1, 1); PG8_SCHED; PG8_LDA(At, 1, 0); PG8_STAGE(PG8_SA(0, 1), a2 + hstep, voffA);
            PG8_WAIT_V(8); PG8_WAIT_L(0); PG8_BAR; PG8_MMA(0, 0, At, B0); PG8_MMA(0, 1, At, B1); PG8_BAR; PG8_SCHED;
            PG8_LDA(At, 1, 1); PG8_STAGE(PG8_SB(1, 0), b3, voffB); PG8_STAGE(PG8_SB(1, 1), b3 + hstep, voffB); PG8_STAGE(PG8_SA(1, 0), a3, voffA);
            PG8_WAIT_V(8); PG8_WAIT_L(0); PG8_BAR; PG8_MMA(1, 0, At, B0); PG8_MMA(1, 1, At, B1); PG8_BAR; PG8_SCHED;
            } else {
            PG8_LDB(B0, 0, 0); PG8_SCHED; PG8_LDA(At, 0, 0); PG8_STAGE(PG8_SA(1, 1), a1 + hstep, voffA);
            PG8_WAIT_L(8); PG8_BAR; PG8_WAIT_L(0); PG8_MMA(0, 0, At, B0); PG8_BAR; PG8_SCHED;
            PG8_LDB(B1, 0, 1); PG8_STAGE(PG8_SB(0, 0), b2, voffB);
            PG8_BAR; PG8_WAIT_L(0); PG8_MMA(0, 1, At, B1); PG8_BAR;
            PG8_LDA(At, 0, 1); PG8_STAGE(PG8_SA(0, 0), a2, voffA);
            PG8_BAR; PG8_WAIT_L(0); PG8_MMA(1, 0, At, B0); PG8_BAR; PG8_SCHED;
            PG8_STAGE(PG8_SB(0, 1), b2 + hstep, voffB);
            PG8_WAIT_V(6); PG8_BAR; PG8_MMA(1, 1, At, B1); PG8_BAR;
            PG8_LDB(B0, 1, 0); PG8_SCHED; PG8_LDA(At, 1, 0); PG8_STAGE(PG8_SA(0, 1), a2 + hstep, voffA);
            PG8_WAIT_L(8); PG8_BAR; PG8_WAIT_L(0); PG8_MMA(0, 0, At, B0); PG8_BAR; PG8_SCHED;
            PG8_LDB(B1, 1, 1); PG8_STAGE(PG8_SB(1, 0), b3, voffB);
            PG8_BAR; PG8_WAIT_L(0); PG8_MMA(0, 1, At, B1); PG8_BAR;
            PG8_LDA(At, 1, 1); PG8_STAGE(PG8_SA(1, 0), a3, voffA);
            PG8_BAR; PG8_WAIT_L(0); PG8_MMA(1, 0, At, B0); PG8_BAR; PG8_SCHED;
            PG8_STAGE(PG8_SB(1, 1), b3 + hstep, voffB);
            PG8_WAIT_V(6); PG8_BAR; PG8_MMA(1, 1, At, B1); PG8_BAR;
            }
        }
        }
        if constexpr (ALIGN_EPI) { if (wr == 0) PG8_BAR; }
        if constexpr (!Epi::AFTER_DRAIN) { E(acc, cur, wr, wc, fr, fq); S.done(cur); }
        if (!has_next) break;
#pragma unroll
        for (int a = 0; a < 2; ++a)
#pragma unroll
            for (int b = 0; b < 2; ++b)
#pragma unroll
                for (int m = 0; m < 4; ++m)
#pragma unroll
                    for (int n = 0; n < 2; ++n) acc[a][b][m][n] = (f32x4){0.f, 0.f, 0.f, 0.f};
        cur = nxt; cA = nA; cB = nB; ++ui;
        if constexpr (ALIGN_EPI) { if (wr == 1) PG8_BAR; }
    }
    PG8_WAIT_V(0);
    if constexpr (!ALIGN_EPI) { if (wr == 0) PG8_BAR; }
    PG8_BAR;
    if constexpr (Epi::AFTER_DRAIN) { E.fused(acc, cur, wr, wc, fr, fq, lds, wid, lane); S.done(cur); }
#undef PG8_SA
#undef PG8_SB
#undef PG8_STAGE
#undef PG8_LDA
#undef PG8_LDB
#undef PG8_MMA
#undef PG8_MMA_LOOP
#undef PG8_WAIT_V
#undef PG8_WAIT_L
#undef PG8_BAR
#undef PG8_SCHED
}
}

struct Args { const float* in[16]; float* out; unsigned char* ws; int ph_lo, ph_hi; };
enum { I_X = 0, I_WIN, I_KVG, I_WUK, I_WUV, I_LBL, I_HGN, I_WOUT, I_LN1G, I_LN1B, I_PWQ, I_PSK, I_PU, I_PV, I_LN2G, I_LN2B };

struct Ctx {
    LAS unsigned char* lds; int tid, lane, wave; int G, bid;
    const float* in[16]; float* out; unsigned char* ws;
};

template <class ColMap>
__device__ __forceinline__ void tr_tile(const Ctx& C, const float* src, int ld_src, int k0, int n0, const ColMap& cm, u16* dst, int ld_dst, int koff) {
    LAS float* T = (LAS float*)C.lds;
    const int nn = C.tid & 63, kq = C.tid >> 6;
    const int col = cm(n0 + nn);
#pragma unroll
    for (int i = 0; i < 8; ++i) { const int kk = kq + 8 * i; T[kk * 65 + nn] = col >= 0 ? src[(size_t)(k0 + kk) * ld_src + col] : 0.f; }
    __syncthreads();
    const int kk2 = C.tid & 63, nq = C.tid >> 6;
#pragma unroll
    for (int i = 0; i < 8; ++i) { const int n2 = nq + 8 * i; const float v = T[kk2 * 65 + n2];
        dst[(size_t)(n0 + n2) * ld_dst + koff + k0 + kk2] = (u16)(cvtpk(v, 0.f) & 0xffffu); }
    __syncthreads();
}

__device__ __forceinline__ int w1_col(int n) {
    if (n < 1536) return 640 + (n - 1024);
    if (n < 1792) { const int j = n - 1536; return j < 128 ? 512 + j : (j < 192 ? 1152 + (j - 128) : (j < 200 ? 1216 + (j - 192) : -1)); }
    const int j = n - 1792, h = j >> 8, part = (j & 255) >> 6, e = j & 63;
    return 1224 + part * 512 + h * 64 + e;
}

__device__ __forceinline__ void cvt_copy(const Ctx& C, const float* src, u16* dst, size_t n8) {
    const size_t stride = (size_t)C.G * NTHREADS;
    for (size_t i = (size_t)C.bid * NTHREADS + C.tid; i < n8; i += stride) {
        const f32x4v a = *(const f32x4v*)(src + i * 8), b = *(const f32x4v*)(src + i * 8 + 4);
        u32x4v w; w.x = cvtpk(a[0], a[1]); w.y = cvtpk(a[2], a[3]); w.z = cvtpk(b[0], b[1]); w.w = cvtpk(b[2], b[3]);
        *(u32x4v*)(dst + i * 8) = w;
    }
}

__device__ __forceinline__ void quant_rows_fp8(const Ctx& C, const float* src, unsigned char* dst, float* inv, int nrows) {
    const int lane = C.lane, gw = C.bid * 8 + C.wave, nw = C.G * 8;
    for (int r = gw; r < nrows; r += nw) {
        f32x4v v[4];
#pragma unroll
        for (int i = 0; i < 4; ++i) v[i] = *(const f32x4v*)(src + (size_t)r * 1024 + lane * 16 + 4 * i);
        float am = 0.f;
#pragma unroll
        for (int i = 0; i < 4; ++i) am = fmaxf(am, fmaxf(fmaxf(fabsf(v[i][0]), fabsf(v[i][1])), fmaxf(fabsf(v[i][2]), fabsf(v[i][3]))));
        am = wave_max_f(am);
        const int e = (int)((__builtin_bit_cast(unsigned, am) >> 23) & 0xffu) - 126;
        int k = 8 - e; k = k > 100 ? 100 : (k < -100 ? -100 : k); if (am == 0.f) k = 0;
        const float s = __builtin_bit_cast(float, (unsigned)(127 + k) << 23), si = __builtin_bit_cast(float, (unsigned)(127 - k) << 23);
        u32x4v w;
#pragma unroll
        for (int i = 0; i < 4; ++i) { int t = 0; t = __builtin_amdgcn_cvt_pk_fp8_f32(v[i][0] * s, v[i][1] * s, t, false); t = __builtin_amdgcn_cvt_pk_fp8_f32(v[i][2] * s, v[i][3] * s, t, true); w[i] = (unsigned)t; }
        *(u32x4v*)(dst + ((size_t)(lane >> 3) * nrows + r) * 128 + (lane & 7) * 16) = w;
        if (lane == 0) inv[r] = si;
    }
}

template <bool SLICED = true>
__device__ __forceinline__ void quant_rows_i8(const Ctx& C, const float* src, unsigned char* dst, float* inv, int nrows) {
    const int lane = C.lane, gw = C.bid * 8 + C.wave, nw = C.G * 8;
    f32x4v vn[4];
    if (gw < nrows) {
#pragma unroll
        for (int i = 0; i < 4; ++i) vn[i] = *(const f32x4v*)(src + (size_t)gw * 1024 + lane * 16 + 4 * i); }
    for (int r = gw; r < nrows; r += nw) {
        f32x4v v[4];
#pragma unroll
        for (int i = 0; i < 4; ++i) v[i] = vn[i];
        { const int rn = r + nw < nrows ? r + nw : r;
#pragma unroll
          for (int i = 0; i < 4; ++i) vn[i] = *(const f32x4v*)(src + (size_t)rn * 1024 + lane * 16 + 4 * i); }
        float am = 0.f;
#pragma unroll
        for (int i = 0; i < 4; ++i) am = fmaxf(am, fmaxf(fmaxf(fabsf(v[i][0]), fabsf(v[i][1])), fmaxf(fabsf(v[i][2]), fabsf(v[i][3]))));
        am = wave_max_f(am);
        const float s = am > 0.f ? 127.f / am : 0.f;
        u32x4v w;
#pragma unroll
        for (int i = 0; i < 4; ++i) w[i] = pack_i8(v[i][0] * s, v[i][1] * s, v[i][2] * s, v[i][3] * s);
        if constexpr (SLICED) *(u32x4v*)(dst + ((size_t)(lane >> 3) * nrows + r) * 128 + (lane & 7) * 16) = w;
        else *(u32x4v*)(dst + (size_t)r * 1024 + lane * 16) = w;
        if (lane == 0) inv[r] = am * (1.f / 127.f);
    }
}

__device__ __forceinline__ void quant_wrows_i8(const Ctx& C, const u16* src, unsigned char* dst, float* sc, int nrows) {
    const int lane = C.lane, gw = C.bid * 8 + C.wave, nw = C.G * 8;
    for (int r = gw; r < nrows; r += nw) {
        const u32x4v y0 = *(const u32x4v*)(src + (size_t)r * 1024 + lane * 16), y1 = *(const u32x4v*)(src + (size_t)r * 1024 + lane * 16 + 8);
        float v[16]; float am = 0.f;
#pragma unroll
        for (int j = 0; j < 4; ++j) { v[2 * j] = bf_lo(y0[j]); v[2 * j + 1] = bf_hi(y0[j]); v[8 + 2 * j] = bf_lo(y1[j]); v[8 + 2 * j + 1] = bf_hi(y1[j]); }
#pragma unroll
        for (int j = 0; j < 16; ++j) am = fmaxf(am, fabsf(v[j]));
        am = wave_max_f(am);
        const float s = am > 0.f ? 127.f / am : 0.f;
        u32x4v w;
#pragma unroll
        for (int i = 0; i < 4; ++i) w[i] = pack_i8(v[4 * i] * s, v[4 * i + 1] * s, v[4 * i + 2] * s, v[4 * i + 3] * s);
        *(u32x4v*)(dst + (size_t)r * 1024 + lane * 16) = w;
        if (lane == 0) sc[r] = am * (1.f / 127.f);
    }
}
__device__ __forceinline__ void quant_w3_mixed(const Ctx& C) {
    const u16* src = (const u16*)(C.ws + WS_W3T); unsigned char* dst = C.ws + WS_W3M; float* sc = (float*)(C.ws + WS_W3S);
    const int lane = C.lane, gw = C.bid * 8 + C.wave, nw = C.G * 8;
    for (int r = gw; r < DM; r += nw) {
        const u32x4v y0 = *(const u32x4v*)(src + (size_t)r * K3 + lane * 16), y1 = *(const u32x4v*)(src + (size_t)r * K3 + lane * 16 + 8);
        const u32x4v hb = *(const u32x4v*)(src + (size_t)r * K3 + 1024 + lane * 8);
        float v[16]; float am = 0.f;
#pragma unroll
        for (int j = 0; j < 4; ++j) { v[2 * j] = bf_lo(y0[j]); v[2 * j + 1] = bf_hi(y0[j]); v[8 + 2 * j] = bf_lo(y1[j]); v[8 + 2 * j + 1] = bf_hi(y1[j]); }
#pragma unroll
        for (int j = 0; j < 16; ++j) am = fmaxf(am, fabsf(v[j]));
        am = wave_max_f(am);
        if (am == 0.f) am = 127.f;
        const float s = 127.f / am;
        u32x4v w, hs;
#pragma unroll
        for (int i = 0; i < 4; ++i) { w[i] = pack_i8(v[4 * i] * s, v[4 * i + 1] * s, v[4 * i + 2] * s, v[4 * i + 3] * s); hs[i] = cvtpk(bf_lo(hb[i]) * s, bf_hi(hb[i]) * s); }
        *(u32x4v*)(dst + (size_t)r * MIXB + lane * 16) = w;
        *(u32x4v*)(dst + (size_t)r * MIXB + 1024 + lane * 16) = hs;
        if (lane == 0) sc[r] = am * (1.f / 127.f);
    }
}
__device__ __forceinline__ void p0b_quant(const Ctx& C) {
    quant_w3_mixed(C);
    quant_wrows_i8(C, (const u16*)(C.ws + WS_W5T), C.ws + WS_W5Q, (float*)(C.ws + WS_W5S), NPQ);
    quant_wrows_i8(C, (const u16*)(C.ws + WS_W1T), C.ws + WS_W1Q, (float*)(C.ws + WS_W1S), N1);
}

__device__ __forceinline__ void p0_prologue(const Ctx& C) {
    unsigned char* ws = C.ws;
    if (C.bid == 0 && C.tid < 64) ((unsigned*)(ws + WS_CTL))[C.tid] = 0u;
    if (C.bid == 0) {
        const float* l = C.in[I_LBL]; float* lb = (float*)(ws + WS_LB);
        const float a = l[C.tid], b = l[512 + C.tid]; lb[C.tid] = 1.f / (1.f + expf(b - a));
    }
    quant_rows_i8<false>(C, C.in[I_X], ws + WS_XB, (float*)(ws + WS_XS), MTOK);
    quant_rows_i8(C, C.in[I_PU], ws + WS_UB, (float*)(ws + WS_USC), 16384);
    quant_rows_i8(C, C.in[I_PV], ws + WS_VB, (float*)(ws + WS_VSC), 16384);
    cvt_copy(C, C.in[I_PSK], (u16*)(ws + WS_SKB), (size_t)8 * 2 * 128 * 128 / 8);
    const float* w_in = C.in[I_WIN]; const float* w_out = C.in[I_WOUT]; const float* wq = C.in[I_PWQ];
    const float* kvg = C.in[I_KVG]; const float* wuk = C.in[I_WUK]; const float* wuv = C.in[I_WUV];
    u16* W1T = (u16*)(ws + WS_W1T); u16* W3T = (u16*)(ws + WS_W3T); u16* W5T = (u16*)(ws + WS_W5T);
    constexpr int T_W1F = 256, T_W1P = 44 * 16, T_W3F = 256, T_W3P = 16 * 8, T_W5 = 32 * 16, T_ALL = T_W1F + T_W1P + T_W3F + T_W3P + T_W5;
    LAS float* TA = (LAS float*)C.lds;
    LAS float* TB = TA + 64 * 65;
    for (int task = C.bid; task < T_ALL; task += C.G) {
        int t = task;
        if (t < T_W1F) {
            const int h = t >> 5, cb = (t >> 4) & 1, kb = t & 15, c0 = cb * 64, k0 = kb * 64;
            { const int d = C.tid & 63, q = C.tid >> 6;
#pragma unroll
              for (int i = 0; i < 8; ++i) { const int r = q + 8 * i; TA[r * 65 + d] = w_in[(size_t)(k0 + r) * DIN + h * 64 + d]; TB[r * 65 + d] = wuk[(size_t)(h * 128 + c0 + r) * 64 + d]; } }
            __syncthreads();
            { const int kk = C.tid & 63, q = C.tid >> 6;
#pragma unroll
              for (int i = 0; i < 8; ++i) { const int cc = q + 8 * i; float s = 0.f;
#pragma unroll 8
                  for (int d = 0; d < 64; ++d) s += TA[kk * 65 + d] * TB[cc * 65 + d];
                  s *= kvg[c0 + cc] * 0.125f;
                  W1T[(size_t)(h * 128 + c0 + cc) * 1024 + k0 + kk] = (u16)(cvtpk(s, 0.f) & 0xffffu); } }
            __syncthreads();
            continue;
        }
        t -= T_W1F;
        if (t < T_W1P) { const int nb = t >> 4, kb = t & 15; tr_tile(C, w_in, DIN, kb * 64, 1024 + nb * 64, [](int n) { return w1_col(n); }, W1T, 1024, 0); continue; }
        t -= T_W1P;
        if (t < T_W3F) {
            const int h = t >> 5, cb = (t >> 4) & 1, nb = t & 15, c0 = cb * 64, n0 = nb * 64;
            { const int x = C.tid & 63, q = C.tid >> 6;
#pragma unroll
              for (int i = 0; i < 8; ++i) { const int r = q + 8 * i; TA[r * 65 + x] = w_out[(size_t)(h * 64 + r) * 1024 + n0 + x]; TB[r * 65 + x] = wuv[(size_t)(h * 128 + c0 + r) * 64 + x]; } }
            __syncthreads();
            { const int cc = C.tid & 63, q = C.tid >> 6;
#pragma unroll
              for (int i = 0; i < 8; ++i) { const int nn = q + 8 * i; float s = 0.f;
#pragma unroll 8
                  for (int d = 0; d < 64; ++d) s += TB[cc * 65 + d] * TA[d * 65 + nn];
                  s *= kvg[c0 + cc];
                  W3T[(size_t)(n0 + nn) * K3 + h * 128 + c0 + cc] = (u16)(cvtpk(s, 0.f) & 0xffffu); } }
            __syncthreads();
            continue;
        }
        t -= T_W3F;
        if (t < T_W3P) { const int nb = t >> 3, kb = t & 7; tr_tile(C, w_out + (size_t)512 * 1024, 1024, kb * 64, nb * 64, [](int n) { return n; }, W3T, K3, 1024); continue; }
        t -= T_W3P;
        { const int nb = t >> 4, kb = t & 15; tr_tile(C, wq, NPQ, kb * 64, nb * 64, [](int n) { return n; }, W5T, 1024, 0); }
    }
}

#ifndef MK_CUSTOM_BAR
#define MK_CUSTOM_BAR 0
#endif
__device__ __forceinline__ void grid_bar(const Ctx& C, unsigned& target, int word = 24) {
    __syncthreads();
    if (C.tid == 0) {
        unsigned* ctr = (unsigned*)(C.ws + WS_CTL) + word;
        __builtin_amdgcn_fence(__ATOMIC_RELEASE, "agent");
        asm volatile("s_waitcnt vmcnt(0)" ::: "memory");
        __hip_atomic_fetch_add(ctr, 1u, __ATOMIC_RELAXED, __HIP_MEMORY_SCOPE_AGENT);
        target += (unsigned)C.G;
        for (unsigned spin = 0; spin < (1u << 24); ++spin) { if (__hip_atomic_load(ctr, __ATOMIC_RELAXED, __HIP_MEMORY_SCOPE_AGENT) >= target) break; __builtin_amdgcn_s_sleep(1); }
        __builtin_amdgcn_fence(__ATOMIC_ACQUIRE, "agent");
        asm volatile("s_waitcnt vmcnt(0)" ::: "memory");
    }
    __syncthreads();
}


__device__ __forceinline__ f32x4v mfma16(s16x8 a, s16x8 b, f32x4v c) { return __builtin_amdgcn_mfma_f32_16x16x32_bf16(a, b, c, 0, 0, 0); }
__device__ __forceinline__ f32x16v mfma32(s16x8 a, s16x8 b, f32x16v c) { return __builtin_amdgcn_mfma_f32_32x32x16_bf16(a, b, c, 0, 0, 0); }
__device__ __forceinline__ s16x4 tr4(const LAS u16* p) { return __builtin_bit_cast(s16x4, __builtin_amdgcn_ds_read_tr16_b64_v4i16((LAS s16x4*)p)); }
__device__ __forceinline__ s16x8 cat4(s16x4 a, s16x4 b) { s16x8 r; r[0] = a[0]; r[1] = a[1]; r[2] = a[2]; r[3] = a[3]; r[4] = b[0]; r[5] = b[1]; r[6] = b[2]; r[7] = b[3]; return r; }
__device__ __forceinline__ s16x8 pack8f(const f32x4v& a, const f32x4v& b) { u32x4v w; w.x = cvtpk(a[0], a[1]); w.y = cvtpk(a[2], a[3]); w.z = cvtpk(b[0], b[1]); w.w = cvtpk(b[2], b[3]); return __builtin_bit_cast(s16x8, w); }

__device__ __forceinline__ float scan32_incl(float v) {
    v += __builtin_bit_cast(float, __builtin_amdgcn_update_dpp(0, __builtin_bit_cast(int, v), 0x111, 0xf, 0xf, true));
    v += __builtin_bit_cast(float, __builtin_amdgcn_update_dpp(0, __builtin_bit_cast(int, v), 0x112, 0xf, 0xf, true));
    v += __builtin_bit_cast(float, __builtin_amdgcn_update_dpp(0, __builtin_bit_cast(int, v), 0x114, 0xf, 0xf, true));
    v += __builtin_bit_cast(float, __builtin_amdgcn_update_dpp(0, __builtin_bit_cast(int, v), 0x118, 0xf, 0xf, true));
    v += __builtin_bit_cast(float, __builtin_amdgcn_update_dpp(0, __builtin_bit_cast(int, v), 0x142, 0xa, 0xf, false));
    return v;
}
constexpr int HG_SET = 16640, HG_OI = 2 * HG_SET, HG_SSQ = HG_OI + 2 * 8192;

__device__ __forceinline__ void hgrn_seq(const Ctx& C, int bh) {
    const int b = bh >> 3, h = bh & 7;
    const int tid = C.tid, lane = C.lane, wave = C.wave, fr = lane & 15, fq = lane >> 4;
    unsigned char* ws = C.ws;
    const u16* HQ = (const u16*)(ws + WS_HQ); const float* HLF = (const float*)(ws + WS_HLF); const u16* HV = (const u16*)(ws + WS_HV); const u16* HG = (const u16*)(ws + WS_HG);
    u16* MIX = (u16*)(ws + WS_MIX);
    const size_t rowbase = (size_t)b * SEQ;
    constexpr int NCH = SEQ / 32;
    LAS float* SSQ = (LAS float*)(C.lds + HG_SSQ);
    if (wave >= 4) {
        const int t = lane & 31, cg = (tid - 256) >> 5;
        f32x4v gn0 = *(const f32x4v*)(C.in[I_HGN] + 8 * cg), gn1 = *(const f32x4v*)(C.in[I_HGN] + 8 * cg + 4);
        f32x4v lfa[4], lfb[4]; u32x4v qv[4], vv[4], gg[4]; u32x4v gp1 = {0u, 0u, 0u, 0u}, gp2 = gp1;
#define HG_LOAD(k_, n_) do { const int nc_ = (n_) < NCH ? (n_) : NCH - 1; const size_t o_ = (rowbase + (size_t)nc_ * 32 + t) * 512 + h * 64 + 8 * cg; lfa[k_] = *(const f32x4v*)(HLF + o_); lfb[k_] = *(const f32x4v*)(HLF + o_ + 4); \
            qv[k_] = *(const u32x4v*)(HQ + o_); vv[k_] = *(const u32x4v*)(HV + o_); gg[k_] = *(const u32x4v*)(HG + o_); } while (0)
        HG_LOAD(0, 0); HG_LOAD(1, 1); HG_LOAD(2, 2); HG_LOAD(3, 3);
#define S_BODY(n, k) { \
              \
            if ((n) >= 1) { \
                const LAS float* OI = (const LAS float*)(C.lds + HG_OI) + (((n) - 1) & 1) * 2048; \
                const LAS float* sq = SSQ + (((n) - 1) & 1) * 128; \
                const float rstd = __builtin_amdgcn_rsqf(((sq[t] + sq[32 + t]) + (sq[64 + t] + sq[96 + t])) * (1.f / 64.f) + EPS); \
                float o[8]; \
                _Pragma("unroll") for (int j = 0; j < 8; ++j) o[j] = OI[(8 * cg + j) * 32 + t] * rstd; \
                u32x4v w; \
                w.x = cvtpk(o[0] * gn0[0] * bf_lo(gp2.x), o[1] * gn0[1] * bf_hi(gp2.x)); w.y = cvtpk(o[2] * gn0[2] * bf_lo(gp2.y), o[3] * gn0[3] * bf_hi(gp2.y)); \
                w.z = cvtpk(o[4] * gn1[0] * bf_lo(gp2.z), o[5] * gn1[1] * bf_hi(gp2.z)); w.w = cvtpk(o[6] * gn1[2] * bf_lo(gp2.w), o[7] * gn1[3] * bf_hi(gp2.w)); \
                *(u32x4v*)(MIX + (rowbase + (size_t)((n) - 1) * 32 + t) * (MIXB / 2) + 512 + h * 64 + 8 * cg) = w;     \
            } \
              \
            if ((n) + 1 < NCH) { \
                LAS unsigned char* S_ = C.lds + (((n) + 1) & 1) * HG_SET; \
                LAS u16* QT = (LAS u16*)S_; LAS u16* KT = QT + 2048; LAS u16* KDT = KT + 2048; LAS u16* VS = KDT + 2048; LAS float* DEC = (LAS float*)(VS + 2048); \
                float lf[8], qf[8]; \
                _Pragma("unroll") for (int j = 0; j < 4; ++j) { lf[j] = lfa[k][j]; lf[4 + j] = lfb[k][j]; qf[2 * j] = bf_lo(qv[k][j]); qf[2 * j + 1] = bf_hi(qv[k][j]); } \
                float qt[8], kt[8], kd[8], dc[8]; \
                _Pragma("unroll") for (int j = 0; j < 8; ++j) { \
                    const float bcum = scan32_incl(lf[j]); \
                    const float bl31 = __builtin_bit_cast(float, __builtin_amdgcn_readlane(__builtin_bit_cast(int, bcum), 31)), bl63 = __builtin_bit_cast(float, __builtin_amdgcn_readlane(__builtin_bit_cast(int, bcum), 63)); \
                    const float bl = lane < 32 ? bl31 : bl63; \
                    const float kk = 1.f - fast_exp(lf[j]); \
                    qt[j] = qf[j] * fast_exp(bcum); kt[j] = kk * fast_exp(-bcum); kd[j] = kk * fast_exp(bl - bcum); dc[j] = fast_exp(bl); \
                } \
                { u32x4v w; w.x = cvtpk(qt[0], qt[1]); w.y = cvtpk(qt[2], qt[3]); w.z = cvtpk(qt[4], qt[5]); w.w = cvtpk(qt[6], qt[7]); *(LAS u32x4v*)(QT + t * 64 + 8 * cg) = w; \
                  w.x = cvtpk(kt[0], kt[1]); w.y = cvtpk(kt[2], kt[3]); w.z = cvtpk(kt[4], kt[5]); w.w = cvtpk(kt[6], kt[7]); *(LAS u32x4v*)(KT + t * 64 + 8 * cg) = w; \
                  *(LAS u32x4v*)(VS + t * 64 + 8 * cg) = vv[k]; \
                  _Pragma("unroll") for (int j = 0; j < 8; ++j) KDT[(8 * cg + j) * 32 + t] = (u16)(cvtpk(kd[j], 0.f) & 0xffffu); \
                  if (t == 0) { *(LAS f32x4v*)(DEC + 8 * cg) = (f32x4v){dc[0], dc[1], dc[2], dc[3]}; *(LAS f32x4v*)(DEC + 8 * cg + 4) = (f32x4v){dc[4], dc[5], dc[6], dc[7]}; } } \
                gp2 = gp1; gp1 = gg[k]; \
            } else { gp2 = gp1; } \
            HG_LOAD(k, (n) + 5);                                             \
            __syncthreads(); }
        for (int n0 = -1; ; n0 += 4) {
            S_BODY(n0, 0) S_BODY(n0 + 1, 1)
            if (n0 + 1 >= NCH) break;
            S_BODY(n0 + 2, 2) S_BODY(n0 + 3, 3)
        }
#undef S_BODY
#undef HG_LOAD
    } else {
        const int et = wave;
        f32x4v Sst[4];
#pragma unroll
        for (int i = 0; i < 4; ++i) Sst[i] = (f32x4v){0.f, 0.f, 0.f, 0.f};
        const int q = (lane & 15) >> 2, p = lane & 3;
        for (int n = -1; n <= NCH; ++n) {
            if (n >= 0 && n < NCH) {
                LAS unsigned char* S_ = C.lds + (n & 1) * HG_SET;
                const LAS u16* QT = (const LAS u16*)S_; const LAS u16* KT = QT + 2048; const LAS u16* KDT = KT + 2048; const LAS u16* VS = KDT + 2048; const LAS float* DEC = (const LAS float*)(VS + 2048);
                LAS float* OI = (LAS float*)(C.lds + HG_OI) + (n & 1) * 2048;
                f32x4v oi[2] = {{0.f, 0.f, 0.f, 0.f}, {0.f, 0.f, 0.f, 0.f}};
#pragma unroll
                for (int ks = 0; ks < 2; ++ks) {
                    const s16x8 sa = pack8f(Sst[2 * ks], Sst[2 * ks + 1]);
#pragma unroll
                    for (int tt = 0; tt < 2; ++tt) {
                        const s16x4 lo = *(const LAS s16x4*)(QT + (16 * tt + fr) * 64 + 32 * ks + 4 * fq), hi = *(const LAS s16x4*)(QT + (16 * tt + fr) * 64 + 32 * ks + 16 + 4 * fq);
                        oi[tt] = mfma16(sa, cat4(lo, hi), oi[tt]);
                    }
                }
                f32x4v a00 = {0.f, 0.f, 0.f, 0.f}, a10 = a00, a11 = a00;
#pragma unroll
                for (int ks = 0; ks < 2; ++ks) {
                    const s16x8 k0 = *(const LAS s16x8*)(KT + fr * 64 + 32 * ks + 8 * fq), k1 = *(const LAS s16x8*)(KT + (16 + fr) * 64 + 32 * ks + 8 * fq);
                    const s16x8 q0 = *(const LAS s16x8*)(QT + fr * 64 + 32 * ks + 8 * fq), q1 = *(const LAS s16x8*)(QT + (16 + fr) * 64 + 32 * ks + 8 * fq);
                    a00 = mfma16(k0, q0, a00); a10 = mfma16(k0, q1, a10); a11 = mfma16(k1, q1, a11);
                }
#pragma unroll
                for (int i = 0; i < 4; ++i) { const bool keep = (4 * fq + i) <= fr; a00[i] = keep ? a00[i] : 0.f; a11[i] = keep ? a11[i] : 0.f; }
                const f32x4v z = {0.f, 0.f, 0.f, 0.f};
                const s16x8 pb0 = pack8f(a00, z), pb1 = pack8f(a10, a11);
                const s16x8 va = cat4(tr4(VS + (4 * fq + q) * 64 + 16 * et + 4 * p), tr4(VS + (16 + 4 * fq + q) * 64 + 16 * et + 4 * p));
                oi[0] = mfma16(va, pb0, oi[0]); oi[1] = mfma16(va, pb1, oi[1]);
                const s16x8 vb = cat4(tr4(VS + (8 * fq + q) * 64 + 16 * et + 4 * p), tr4(VS + (8 * fq + 4 + q) * 64 + 16 * et + 4 * p));
#pragma unroll
                for (int dt = 0; dt < 4; ++dt) {
                    const s16x8 ka = *(const LAS s16x8*)(KDT + (16 * dt + fr) * 32 + 8 * fq);
                    const f32x4v ds = mfma16(ka, vb, z);
                    const f32x4v dc = *(const LAS f32x4v*)(DEC + 16 * dt + 4 * fq);
                    Sst[dt] = Sst[dt] * dc + ds;
                }
                LAS float* sq = SSQ + (n & 1) * 128 + et * 32;
#pragma unroll
                for (int tt = 0; tt < 2; ++tt) { float s = 0.f;
#pragma unroll
                    for (int i = 0; i < 4; ++i) { OI[(16 * et + 4 * fq + i) * 32 + 16 * tt + fr] = oi[tt][i]; s += oi[tt][i] * oi[tt][i]; }
                    s += __shfl_xor(s, 16); s += __shfl_xor(s, 32);
                    if (fq == 0) sq[16 * tt + fr] = s; }
            }
            __syncthreads();
        }
    }
    __syncthreads();
}

constexpr int DSA_SC = 0, DSA_H1 = 131072, DSA_IDX = 139264, DSA_KST = 143360, DSA_ITEM = 159744;
__device__ __forceinline__ unsigned off_b(unsigned row, unsigned ch) { return 256u * row + 16u * (ch ^ (((row & 3) << 2) | ((row >> 2) & 3))); }
__device__ __forceinline__ unsigned mono16(unsigned h) { return (h & 0x8000u) ? (~h & 0xffffu) : (h | 0x8000u); }

__device__ __forceinline__ int wave_incl_scan_dpp(int v) {
    v += __builtin_amdgcn_update_dpp(0, v, 0x111, 0xf, 0xf, true);
    v += __builtin_amdgcn_update_dpp(0, v, 0x112, 0xf, 0xf, true);
    v += __builtin_amdgcn_update_dpp(0, v, 0x114, 0xf, 0xf, true);
    v += __builtin_amdgcn_update_dpp(0, v, 0x118, 0xf, 0xf, true);
    v += __builtin_amdgcn_update_dpp(0, v, 0x142, 0xa, 0xf, false);
    v += __builtin_amdgcn_update_dpp(0, v, 0x143, 0xc, 0xf, false);
    return v;
}
__device__ __forceinline__ void find_bin(const LAS unsigned* hist, int lane, int target, int& B, int& above) {
    const u32x4v c = *(const LAS u32x4v*)(hist + 4 * lane);
    const int tot = (int)(c.x + c.y + c.z + c.w);
    const int pre = wave_incl_scan_dpp(tot);
    const int all = __builtin_amdgcn_readlane(pre, 63);
    const int suf = all - pre + tot;
    const int ab = suf - tot;
    const bool here = (ab < target) && (suf >= target);
    int b = -1, a = 0;
    if (here) {
        int cum = ab;
        if (cum + (int)c.w >= target) { b = 4 * lane + 3; a = cum; }
        else { cum += (int)c.w;
            if (cum + (int)c.z >= target) { b = 4 * lane + 2; a = cum; }
            else { cum += (int)c.z;
                if (cum + (int)c.y >= target) { b = 4 * lane + 1; a = cum; }
                else { cum += (int)c.y; b = 4 * lane; a = cum; } } }
    }
    const unsigned long long m = __ballot(here);
    const int src = m ? (int)__builtin_ctzll(m) : 0;
    B = __shfl(b, src); above = __shfl(a, src);
}

__device__ __forceinline__ int wave_incl_scan(int v, int lane) {
#pragma unroll
    for (int d = 1; d < 64; d <<= 1) { const int o = __shfl_up(v, d); if (lane >= d) v += o; }
    return v;
}

typedef short s16x2v __attribute__((ext_vector_type(2)));
__device__ __forceinline__ unsigned relu_pk_bf16(unsigned x) { return __builtin_bit_cast(unsigned, __builtin_elementwise_max(__builtin_bit_cast(s16x2v, x), (s16x2v){0, 0})); }

struct APre { s16x8 Aop[4][2]; f32x4v w0[2], w1[2]; u32x4v g[2][2]; };
__device__ __forceinline__ void dsa_pre(const Ctx& C, int b, int qt, APre& P) {
    const int lane = C.lane, wave = C.wave, fr = lane & 15, fq = lane >> 4;
    unsigned char* ws = C.ws;
    const u16* QIDX = (const u16*)(ws + WS_QIDX); const u16* KIDX = (const u16*)(ws + WS_KIDX); const float* WIDX = (const float*)(ws + WS_WIDX);
    const size_t tb = (size_t)b * SEQ; const int q0 = qt * 8, nt16 = (q0 + 8 + 15) >> 4;
#pragma unroll
    for (int m = 0; m < 4; ++m) { const u16* p = QIDX + (tb + q0 + 4 * (m >> 1) + (fr >> 2)) * 512 + (4 * (m & 1) + (fr & 3)) * 64 + 8 * fq;
#pragma unroll
        for (int ks = 0; ks < 2; ++ks) P.Aop[m][ks] = *(const s16x8*)(p + 32 * ks); }
#pragma unroll
    for (int qq = 0; qq < 2; ++qq) { const float* wp = WIDX + (tb + q0 + 4 * qq + fq) * 8; P.w0[qq] = *(const f32x4v*)wp; P.w1[qq] = *(const f32x4v*)(wp + 4); }
    const int lrow = lane >> 3, lpc = lane & 7;
    const u16* kbase = KIDX + (tb + lrow) * 64 + lpc * 8;
#pragma unroll
    for (int j = 0; j < 2; ++j) { const int t_ = wave + 8 * j < nt16 ? wave + 8 * j : (wave < nt16 ? wave : 0);
        P.g[j][0] = *(const u32x4v*)(kbase + (size_t)t_ * 1024); P.g[j][1] = *(const u32x4v*)(kbase + (size_t)t_ * 1024 + 512); }
}

__device__ __forceinline__ int dsa_item(const Ctx& C, int b, int qt, APre& P, int nxt) {
    const int tid = C.tid, lane = C.lane, wave = C.wave;
    unsigned char* ws = C.ws;
    const u16* QLAT = (const u16*)(ws + WS_QLAT); const u16* QIDX = (const u16*)(ws + WS_QIDX); const u16* CKV = (const u16*)(ws + WS_CKV); const u16* KIDX = (const u16*)(ws + WS_KIDX);
    const float* WIDX = (const float*)(ws + WS_WIDX); const float* SSQ = (const float*)(ws + WS_SSQ); u16* MIX = (u16*)(ws + WS_MIX);
    LAS _Float16* SC = (LAS _Float16*)(C.lds + DSA_SC); LAS u16* SCK = (LAS u16*)(C.lds + DSA_SC);
    LAS unsigned* H1 = (LAS unsigned*)(C.lds + DSA_H1);
    const size_t tb = (size_t)b * SEQ; const int q0 = qt * 8;
    { constexpr int repA = 0;
        const int fr = lane & 15, fq = lane >> 4;
        s16x8 Aop[4][2]; s16x8 Wop[2];
#pragma unroll
        for (int m = 0; m < 4; ++m) { Aop[m][0] = P.Aop[m][0]; Aop[m][1] = P.Aop[m][1]; }
#pragma unroll
        for (int qq = 0; qq < 2; ++qq) { const f32x4v w0 = P.w0[qq], w1 = P.w1[qq];
            const f32x4v zz = {0.f, 0.f, 0.f, 0.f}; const bool own = fr == 4 * fq + qq;
            Wop[qq] = pack8f(own ? w0 : zz, own ? w1 : zz); }
        const int nt16 = (q0 + 8 + 15) >> 4;
        LAS unsigned char* KST = C.lds + DSA_KST + wave * 2048;
        const int lrow = lane >> 3, lpc = lane & 7;
        const u16* kbase = KIDX + (tb + lrow) * 64 + lpc * 8;
        const unsigned wo0 = (unsigned)(lrow * 128 + ((lpc ^ (lrow & 7)) * 16)), wo1 = wo0 + 1024u;
        const unsigned ro0 = (unsigned)(fr * 128 + ((fq ^ (fr & 7)) * 16)), ro1 = (unsigned)(fr * 128 + (((4 + fq) ^ (fr & 7)) * 16));
        u32x4v g0a, g0b, g1a, g1b;
#define A_GLOAD(da, db, kt_) do { da = *(const u32x4v*)(kbase + (size_t)(kt_) * 1024); db = *(const u32x4v*)(kbase + (size_t)(kt_) * 1024 + 512); } while (0)
#define A_STAGE(da, db, B0_, B1_) do { *(LAS u32x4v*)(KST + wo0) = da; *(LAS u32x4v*)(KST + wo1) = db; LDS_FENCE(); B0_ = *(const LAS s16x8*)(KST + ro0); B1_ = *(const LAS s16x8*)(KST + ro1); } while (0)
#define A_MMA(acc_, B0_, B1_) do { _Pragma("unroll") for (int m = 0; m < 4; ++m) { acc_[m] = mfma16(Aop[m][0], B0_, (f32x4v){0.f, 0.f, 0.f, 0.f}); acc_[m] = mfma16(Aop[m][1], B1_, acc_[m]); } } while (0)
#define A_EPI1(acc_, d0_, d1_) do { if (((MK_REPEAT >> 17) & 1) && repA) { d0_ = acc_[0] + acc_[1] + acc_[2] + acc_[3]; break; } u32x4v pa_, pb_;                      \
            pa_.x = relu_pk_bf16(cvtpk(acc_[0][0], acc_[0][1])); pa_.y = relu_pk_bf16(cvtpk(acc_[0][2], acc_[0][3])); pa_.z = relu_pk_bf16(cvtpk(acc_[1][0], acc_[1][1])); pa_.w = relu_pk_bf16(cvtpk(acc_[1][2], acc_[1][3])); \
            pb_.x = relu_pk_bf16(cvtpk(acc_[2][0], acc_[2][1])); pb_.y = relu_pk_bf16(cvtpk(acc_[2][2], acc_[2][3])); pb_.z = relu_pk_bf16(cvtpk(acc_[3][0], acc_[3][1])); pb_.w = relu_pk_bf16(cvtpk(acc_[3][2], acc_[3][3])); \
            d0_ = mfma16(Wop[0], __builtin_bit_cast(s16x8, pa_), (f32x4v){0.f, 0.f, 0.f, 0.f}); \
            d0_ = mfma16(Wop[1], __builtin_bit_cast(s16x8, pb_), d0_); } while (0)
#define A_EPI2(d0_, d1_, kt_) do { if (((MK_REPEAT >> 16) & 1) && repA) { dummyA += d0_[0] + d0_[1]; break; } const int kpos = (kt_) * 16 + fr;     \
            const unsigned hh_ = __builtin_bit_cast(unsigned, __builtin_amdgcn_cvt_pkrtz(d0_[0], d0_[1])); \
            const unsigned kk_ = hh_ ^ (__builtin_bit_cast(unsigned, __builtin_bit_cast(s16x2v, hh_) >> 15) | 0x80008000u);      \
            SCK[fq * 8192 + kpos] = (u16)kk_; SCK[(4 + fq) * 8192 + kpos] = (u16)(kk_ >> 16); \
            if (repA == 0) { if (kpos <= q0 + fq) atomicAdd((unsigned*)(H1 + fq * 256 + ((kk_ >> 8) & 0xffu)), 1u); if (kpos <= q0 + 4 + fq) atomicAdd((unsigned*)(H1 + (4 + fq) * 256 + (kk_ >> 24)), 1u); } } while (0)
        float dummyA = 0.f;
#define A_WRITE(da, db) do { *(LAS u32x4v*)(KST + wo0) = da; *(LAS u32x4v*)(KST + wo1) = db; } while (0)
#define A_READ(B0_, B1_) do { LDS_FENCE(); B0_ = *(const LAS s16x8*)(KST + ro0); B1_ = *(const LAS s16x8*)(KST + ro1); } while (0)
        if (wave < nt16) {
            s16x8 bc0, bc1, bn0, bn1; f32x4v accA[4], accB[4], hd; u32x4v g2a, g2b, g3a, g3b;
#define A_TCL(t_) ((t_) < nt16 ? (t_) : wave)
            g0a = P.g[0][0]; g0b = P.g[0][1]; g1a = P.g[1][0]; g1b = P.g[1][1];
            A_GLOAD(g2a, g2b, A_TCL(wave + 16)); A_GLOAD(g3a, g3b, A_TCL(wave + 24));
            A_WRITE(g0a, g0b); A_READ(bc0, bc1);
            A_MMA(accA, bc0, bc1);
            A_GLOAD(g0a, g0b, A_TCL(wave + 32));
            A_WRITE(g1a, g1b); A_GLOAD(g1a, g1b, A_TCL(wave + 40));
            int kt = wave;
#define A_STEP(aX, aY, bx0, bx1, ga, gb) { A_READ(bx0, bx1); A_EPI1(aX, hd, hd); A_MMA(aY, bx0, bx1); A_EPI2(hd, hd, kt); if (kt + 8 >= nt16) break; \
                A_WRITE(ga, gb); A_GLOAD(ga, gb, (kt + 48 < nt16 ? kt + 48 : kt)); kt += 8; }
            for (;;) {
                A_STEP(accA, accB, bn0, bn1, g2a, g2b)
                A_STEP(accB, accA, bc0, bc1, g3a, g3b)
                A_STEP(accA, accB, bn0, bn1, g0a, g0b)
                A_STEP(accB, accA, bc0, bc1, g1a, g1b)
            }
#undef A_STEP
#undef A_TCL
        }
#undef A_WRITE
#undef A_READ
        if (dummyA == 12345.678f) SC[0] = (_Float16)0.f;
#undef A_GLOAD
#undef A_STAGE
#undef A_MMA
#undef A_EPI1
#undef A_EPI2
    }
    LAS int* itemw2 = (LAS int*)(C.lds + DSA_ITEM) + 1;
    if (tid == 0) *itemw2 = nxt;
    __syncthreads();
    const int nx = __builtin_amdgcn_readfirstlane(*itemw2);
    const int tq = q0 + wave, nk = tq + 1;
    LAS unsigned* h1 = H1 + wave * 256;
    LAS unsigned* hist = h1;
    LAS u16* idx = (LAS u16*)(C.lds + DSA_IDX) + wave * 256;
    LAS float* rsel = (LAS float*)(C.lds + DSA_KST + wave * 2048);
    const LAS u16* scq = (const LAS u16*)(C.lds + DSA_SC) + wave * 8192;
    s16x8 Bq[4];
    { const int fr = lane & 15, fq = lane >> 4;
#pragma unroll
      for (int ks = 0; ks < 4; ++ks) { Bq[ks] = (s16x8){0, 0, 0, 0, 0, 0, 0, 0}; if (fr < 8) Bq[ks] = *(const s16x8*)(QLAT + (tb + tq) * 1024 + fr * 128 + 32 * ks + 8 * fq); } }
    int cnt;
    const int frC = lane & 15, fqC = lane >> 4;
    const u16* ckb = CKV + tb * 128 + frC * 8;
    u32x4v gbuf[8]; f32x4v q4e = {0.f, 0.f, 0.f, 0.f}; bool early = false;
#define C_ISSUE(ch_) do { int kk_[8]; _Pragma("unroll") for (int i = 0; i < 8; ++i) { const int s_ = (ch_) * 32 + 4 * i + fqC; kk_[i] = (int)idx[s_ < cnt ? s_ : cnt - 1]; }     \
            _Pragma("unroll") for (int i = 0; i < 8; ++i) gbuf[i] = *(const u32x4v*)(ckb + (size_t)kk_[i] * 128); } while (0)
#define C_EARLY() do { LDS_FENCE(); C_ISSUE(0); q4e = *(const f32x4v*)(SSQ + (tb + idx[lane < cnt ? lane : cnt - 1]) * 4); } while (0)
    u32x4v h1save = (u32x4v){0u, 0u, 0u, 0u};
    if ((MK_REPEAT >> 9) & 1) h1save = *(const LAS u32x4v*)(h1 + 4 * lane);
    for (int repB = 0; repB < (((MK_REPEAT >> 9) & 1) ? 2 : 1); ++repB) { LDS_FENCE();
    if (repB) { *(LAS u32x4v*)(h1 + 4 * lane) = h1save; LDS_FENCE(); }
    if (nk <= TOPK) {
        cnt = nk;
#pragma unroll
        for (int i = 0; i < 4; ++i) idx[lane + 64 * i] = (u16)(lane + 64 * i);
    } else {
        cnt = TOPK;
        const int nit = (nk + 511) >> 9;
        int B1, above1; find_bin(h1, lane, TOPK, B1, above1);
        LDS_FENCE();
        *(LAS u32x4v*)(hist + 4 * lane) = (u32x4v){0u, 0u, 0u, 0u};
        LDS_FENCE();
#pragma unroll 2
        for (int it = 0; it < nit; ++it) { const int base = it * 512 + lane * 8;
            if ((it + 1) * 512 <= nk) {
                const u32x4v v = *(const LAS u32x4v*)(scq + base);
#pragma unroll
                for (int j = 0; j < 8; ++j) { const unsigned key = (v[j >> 1] >> ((j & 1) * 16)) & 0xffffu; if ((int)(key >> 8) == B1) atomicAdd((unsigned*)(hist + (key & 255u)), 1u); }
            } else if (base < nk) { const u32x4v v = *(const LAS u32x4v*)(scq + base);
#pragma unroll
                for (int j = 0; j < 8; ++j) { const unsigned key = (v[j >> 1] >> ((j & 1) * 16)) & 0xffffu; if (base + j < nk && (int)(key >> 8) == B1) atomicAdd((unsigned*)(hist + (key & 255u)), 1u); } } }
        LDS_FENCE();
        int B2, above2; find_bin(hist, lane, TOPK - above1, B2, above2);
        const unsigned T = ((unsigned)B1 << 8) | (unsigned)B2;
        const int ngt = above1 + above2, need_eq = TOPK - ngt;
        int pos_gt = 0, pos_eq = 0;
#pragma unroll 2
        for (int it = 0; it < nit; ++it) { const int base = it * 512 + lane * 8;
            u32x4v v = (u32x4v){0u, 0u, 0u, 0u};
            if (base < nk) v = *(const LAS u32x4v*)(scq + base);
            unsigned key[8];
#pragma unroll
            for (int j = 0; j < 8; ++j) key[j] = (v[j >> 1] >> ((j & 1) * 16)) & 0xffffu;
            if ((it + 1) * 512 > nk) {
#pragma unroll
                for (int j = 0; j < 8; ++j) if (base + j >= nk) key[j] = 0u; }
            unsigned mgt = 0u, meq = 0u;
#pragma unroll
            for (int j = 0; j < 8; ++j) { mgt |= (key[j] > T ? 1u : 0u) << j; meq |= (key[j] == T ? 1u : 0u) << j; }
            const int cgt = __builtin_popcount(mgt), ceq = __builtin_popcount(meq);
            const int packed = cgt | (ceq << 16);
            const int incl = wave_incl_scan_dpp(packed), excl = incl - packed, tot = __builtin_amdgcn_readlane(incl, 63);
            int og = pos_gt + (excl & 0xffff), oe = pos_eq + (excl >> 16);
            pos_gt += tot & 0xffff; pos_eq += tot >> 16;
            while (mgt) { const int j = __builtin_ctz(mgt); mgt &= mgt - 1u; idx[og] = (u16)(base + j); ++og; }
            while (meq) { const int j = __builtin_ctz(meq); meq &= meq - 1u; if (oe < need_eq) idx[ngt + oe] = (u16)(base + j); ++oe; }
            if (!early && pos_gt >= 64 && it + 1 < nit) { early = true; C_EARLY(); } }
    }
    }
    *(LAS u32x4v*)(h1 + 4 * lane) = (u32x4v){0u, 0u, 0u, 0u};
    LDS_FENCE();
    for (int repC = 0; repC < (((MK_REPEAT >> 10) & 1) ? 2 : 1); ++repC) {
        const int fr = lane & 15, fq = lane >> 4;
        const size_t tok = tb + tq;
        const int nch = (cnt + 31) >> 5;
        if (!early || repC) C_EARLY();
        { int kr[3]; f32x4v q4[4]; q4[0] = q4e;
#pragma unroll
          for (int i = 1; i < 4; ++i) { const int s = lane + 64 * i; kr[i - 1] = (int)idx[s < cnt ? s : cnt - 1]; }
#pragma unroll
          for (int i = 1; i < 4; ++i) q4[i] = *(const f32x4v*)(SSQ + (tb + kr[i - 1]) * 4);
#pragma unroll
          for (int i = 0; i < 4; ++i) { const int s = lane + 64 * i; rsel[s] = s < cnt ? __builtin_amdgcn_rsqf((q4[i][0] + q4[i][1] + q4[i][2] + q4[i][3]) * (1.f / 128.f) + EPS) : 0.f; } }
        f32x4v O[8];
#pragma unroll
        for (int ct = 0; ct < 8; ++ct) O[ct] = (f32x4v){0.f, 0.f, 0.f, 0.f};
        float mrun = -__builtin_inff(), lsum = 0.f;
        const int rho0 = 8 * (fr >> 2) + (fr & 3);
        const int tq_ = (lane & 15) >> 2, tp = lane & 3;
        LAS unsigned char* const CB = C.lds + DSA_SC + wave * 16384;
        auto c_chunk = [&](const int ch, LAS unsigned char* const CH) __attribute__((always_inline)) {
            f32x4v sacc[2];
#pragma unroll
            for (int T = 0; T < 2; ++T) { sacc[T] = (f32x4v){0.f, 0.f, 0.f, 0.f};
#pragma unroll
                for (int ks = 0; ks < 4; ++ks) { const s16x8 a = *(const LAS s16x8*)(CH + off_b(rho0 + 4 * T, 4 * ks + fq)); sacc[T] = mfma16(a, Bq[ks], sacc[T]); } }
            const f32x4v r0 = *(const LAS f32x4v*)(rsel + ch * 32 + 8 * fq), r1 = *(const LAS f32x4v*)(rsel + ch * 32 + 8 * fq + 4);
            float sv[8];
#pragma unroll
            for (int i = 0; i < 4; ++i) { sv[i] = sacc[0][i] * r0[i]; sv[4 + i] = sacc[1][i] * r1[i]; }
            if (ch * 32 + 32 > cnt) {
#pragma unroll
                for (int i = 0; i < 4; ++i) { const int s0 = ch * 32 + 8 * fq + i; if (s0 >= cnt) sv[i] = -__builtin_inff(); if (s0 + 4 >= cnt) sv[4 + i] = -__builtin_inff(); } }
            float cmax = fmaxf(fmaxf(fmaxf(sv[0], sv[1]), fmaxf(sv[2], sv[3])), fmaxf(fmaxf(sv[4], sv[5]), fmaxf(sv[6], sv[7])));
            cmax = fmaxf(cmax, __shfl_xor(cmax, 16)); cmax = fmaxf(cmax, __shfl_xor(cmax, 32));
            const bool need = cmax > mrun + 8.f;
            if (__any(need)) {
                const float mnew = need ? cmax : mrun;
                const float alpha = fast_exp(mrun - mnew);
                mrun = mnew; lsum *= alpha;
#pragma unroll
                for (int ct = 0; ct < 8; ++ct) O[ct] = O[ct] * alpha;
            }
            float p[8]; float ps = 0.f;
#pragma unroll
            for (int i = 0; i < 8; ++i) { p[i] = fast_exp(sv[i] - mrun); ps += p[i]; }
            lsum += ps;
            f32x4v pa, pb;
#pragma unroll
            for (int i = 0; i < 4; ++i) { pa[i] = p[i] * r0[i]; pb[i] = p[4 + i] * r1[i]; }
            const s16x8 pop = pack8f(pa, pb);
#pragma unroll
            for (int ct = 0; ct < 8; ++ct) {
                const s16x4 t0 = tr4((const LAS u16*)(CH + off_b(8 * fq + tq_, 2 * ct + (tp >> 1)) + 8 * (tp & 1)));
                const s16x4 t1 = tr4((const LAS u16*)(CH + off_b(8 * fq + 4 + tq_, 2 * ct + (tp >> 1)) + 8 * (tp & 1)));
                O[ct] = mfma16(cat4(t0, t1), pop, O[ct]);
            }
        };
#pragma unroll 1
        for (int ch = 0; ch < nch; ch += 2) {
#pragma unroll
            for (int i = 0; i < 8; ++i) *(LAS u32x4v*)(CB + off_b(4 * i + fq, fr)) = gbuf[i];
            if (ch + 1 < nch) C_ISSUE(ch + 1);
            LDS_FENCE();
            c_chunk(ch, CB);
            if (ch + 1 < nch) {
#pragma unroll
                for (int i = 0; i < 8; ++i) *(LAS u32x4v*)(CB + 8192 + off_b(4 * i + fq, fr)) = gbuf[i];
                if (ch + 2 < nch) C_ISSUE(ch + 2);
                LDS_FENCE();
                c_chunk(ch + 1, CB + 8192);
            }
        }
#undef C_ISSUE
#undef C_EARLY
        lsum += __shfl_xor(lsum, 16); lsum += __shfl_xor(lsum, 32);
        const float inv = 1.f / lsum;
        float am = 0.f;
#pragma unroll
        for (int ct = 0; ct < 8; ++ct) { O[ct] = O[ct] * inv; am = fmaxf(am, fmaxf(fmaxf(fabsf(O[ct][0]), fabsf(O[ct][1])), fmaxf(fabsf(O[ct][2]), fabsf(O[ct][3])))); }
        if (fr >= 8) am = 0.f;
        am = wave_max_f(am);
        const float qs = am > 0.f ? 127.f / am : 0.f;
        if (fr < 8) {
            unsigned char* mp = (unsigned char*)MIX + tok * MIXB + fr * 128 + 4 * fq;
#pragma unroll
            for (int ct = 0; ct < 8; ++ct) *(unsigned*)(mp + 16 * ct) = pack_i8(O[ct][0] * qs, O[ct][1] * qs, O[ct][2] * qs, O[ct][3] * qs);
        }
        if (lane == 0) ((float*)(ws + WS_MIXS))[tok] = am * (1.f / 127.f);
    }
    dsa_pre(C, b, (SEQ / 8 - 1) - (nx < SEQ / 8 ? nx : SEQ / 8 - 1), P);
    return nx;
}

__device__ __forceinline__ void p2_mixers(const Ctx& C, int cw = 0) {
    if (C.bid < 64) { hgrn_seq(C, C.bid); if ((MK_REPEAT >> 7) & 1) hgrn_seq(C, C.bid); }
    unsigned* qctr = (unsigned*)(C.ws + WS_CTL);
    for (int i = C.tid; i < 2048; i += NTHREADS) ((LAS unsigned*)(C.lds + DSA_H1))[i] = 0u;
    __syncthreads();
    LAS int* itemw = (LAS int*)(C.lds + DSA_ITEM);
    APre P;
    const int xcc = (int)(__builtin_amdgcn_s_getreg((3 << 11) | 20) & 0x7u);
    for (int k = 0; k < NB; ++k) { const int bq = (xcc + k) & 7;
        if (C.tid == 0) *itemw = (int)atomicAdd(qctr + 8 * cw + bq, 1u);
        __syncthreads();
        int item = *itemw;
        __syncthreads();
        if (item < SEQ / 8) dsa_pre(C, bq, (SEQ / 8 - 1) - item, P);
        while (item < SEQ / 8) {
            int nxt = 0;
            if (C.tid == 0) nxt = (int)atomicAdd(qctr + 8 * cw + bq, 1u);
            item = dsa_item(C, bq, (SEQ / 8 - 1) - item, P, nxt);
            __syncthreads();
        }
    }
}


__device__ __forceinline__ float wave_sum(float v) {
#pragma unroll
    for (int d = 1; d < 64; d <<= 1) v += __shfl_xor(v, d);
    return v;
}
__device__ __forceinline__ void p4_ln1(const Ctx& C) {
    const u16* Y1 = (const u16*)(C.ws + WS_Y1); u16* HB = (u16*)(C.ws + WS_HB); unsigned char* H8 = C.ws + WS_H8; float* HS = (float*)(C.ws + WS_HS);
    const float* g = C.in[I_LN1G]; const float* bb = C.in[I_LN1B];
    const int lane = C.lane, gw = C.bid * 8 + C.wave, nw = C.G * 8;
    f32x4v gv[4], bv[4];
#pragma unroll
    for (int c = 0; c < 4; ++c) { gv[c] = *(const f32x4v*)(g + lane * 16 + 4 * c); bv[c] = *(const f32x4v*)(bb + lane * 16 + 4 * c); }
    u32x4v yn0 = *(const u32x4v*)(Y1 + (size_t)gw * 1024 + lane * 16), yn1 = *(const u32x4v*)(Y1 + (size_t)gw * 1024 + lane * 16 + 8);
    for (int r = gw; r < MTOK; r += nw) {
        const u32x4v y0 = yn0, y1 = yn1;
        { const int rn = r + nw < MTOK ? r + nw : r; yn0 = *(const u32x4v*)(Y1 + (size_t)rn * 1024 + lane * 16); yn1 = *(const u32x4v*)(Y1 + (size_t)rn * 1024 + lane * 16 + 8); }
        float v[16]; float s = 0.f;
#pragma unroll
        for (int j = 0; j < 4; ++j) { v[2 * j] = bf_lo(y0[j]); v[2 * j + 1] = bf_hi(y0[j]); v[8 + 2 * j] = bf_lo(y1[j]); v[8 + 2 * j + 1] = bf_hi(y1[j]); }
#pragma unroll
        for (int j = 0; j < 16; ++j) s += v[j];
        const float mu = wave_sum_f(s) * (1.f / 1024.f);
        float q = 0.f;
#pragma unroll
        for (int j = 0; j < 16; ++j) { v[j] -= mu; q += v[j] * v[j]; }
        const float rstd = __builtin_amdgcn_rsqf(wave_sum_f(q) * (1.f / 1024.f) + EPS);
        float am = 0.f;
#pragma unroll
        for (int j = 0; j < 16; ++j) { v[j] = v[j] * rstd * gv[j >> 2][j & 3] + bv[j >> 2][j & 3]; am = fmaxf(am, fabsf(v[j])); }
        u32x4v w0, w1;
#pragma unroll
        for (int j = 0; j < 4; ++j) { w0[j] = cvtpk(v[2 * j], v[2 * j + 1]); w1[j] = cvtpk(v[8 + 2 * j], v[8 + 2 * j + 1]); }
        *(u32x4v*)(HB + (size_t)r * 1024 + lane * 16) = w0; *(u32x4v*)(HB + (size_t)r * 1024 + lane * 16 + 8) = w1;
        am = wave_max_f(am);
        const float qs = am > 0.f ? 127.f / am : 0.f;
        u32x4v w8;
#pragma unroll
        for (int j = 0; j < 4; ++j) w8[j] = pack_i8(v[4 * j] * qs, v[4 * j + 1] * qs, v[4 * j + 2] * qs, v[4 * j + 3] * qs);
        *(u32x4v*)(H8 + (size_t)r * 1024 + lane * 16) = w8;
        if (lane == 0) HS[r] = am * (1.f / 127.f);
    }
}

constexpr int SSROW = 136;
constexpr int PE_SS = 0, PE_TV = 0, PE_TI = 32768, PE_EU = 53248, PE_EID = 131072, PE_EG = 147456;

__device__ __forceinline__ void ins16(float (&tv)[16], int (&ti)[16], float v, int id) {
#pragma unroll
    for (int j = 15; j >= 0; --j) {
        const bool c = v > tv[j];
        const bool cp = (j > 0) ? (v > tv[j > 0 ? j - 1 : 0]) : false;
        const float nv = cp ? tv[j > 0 ? j - 1 : 0] : v; const int ni = cp ? ti[j > 0 ? j - 1 : 0] : id;
        tv[j] = c ? nv : tv[j]; ti[j] = c ? ni : ti[j];
    }
}

__device__ __forceinline__ float gelu_tanh(float x) {
    const float u = 0.7978845608028654f * (x + 0.044715f * x * x * x);
    const float e = fast_exp(2.f * u);
    const float th = 1.f - 2.f * __builtin_amdgcn_rcpf(e + 1.f);
    return 0.5f * x * (1.f + th);
}


#ifndef MK_PASSBAR
#define MK_PASSBAR 0
#endif
constexpr int PE_PD = 0, PE_STAT = 131072, PE_WSC = 133120;
constexpr size_t WS_GSID = WS_MIX, WS_GSG = WS_MIX + 32 * MiB, WS_GSU = WS_MIX + 64 * MiB;
constexpr int NSEG = 8, SEGB = 128;

__device__ __forceinline__ void p6_peer(const Ctx& C) {
    unsigned char* ws = C.ws;
    const u16* PQ = (const u16*)(ws + WS_PQ); const u16* HB = (const u16*)(ws + WS_HB); const u16* SKB = (const u16*)(ws + WS_SKB); const unsigned char* H8 = ws + WS_H8; const float* HS = (const float*)(ws + WS_HS);
    const unsigned char* U8 = ws + WS_UB; const unsigned char* V8 = ws + WS_VB; const float* USC = (const float*)(ws + WS_USC); const float* VSC = (const float*)(ws + WS_VSC);
    u16* YB = (u16*)(ws + WS_YB);
    unsigned* G_SID = (unsigned*)(ws + WS_GSID); float* G_SG = (float*)(ws + WS_GSG); float* G_SU = (float*)(ws + WS_GSU);
    const float* g2 = C.in[I_LN2G]; const float* b2 = C.in[I_LN2B];
    const int tid = C.tid, lane = C.lane, wave = C.wave, fr = lane & 15, fq = lane >> 4;
    LAS u16* SSK = (LAS u16*)(C.lds + PE_SS);
    LAS float* TV = (LAS float*)(C.lds + PE_TV); LAS u16* TI = (LAS u16*)(C.lds + PE_TI);
    LAS int* EID = (LAS int*)(C.lds + PE_EID); LAS float* EG = (LAS float*)(C.lds + PE_EG); LAS float* EU = (LAS float*)(C.lds + PE_EU);
    cg::grid_group grid = cg::this_grid();
    const int ntile = MTOK / 32, tiles_per_wg = (ntile + C.G - 1) / C.G, nsr = (tiles_per_wg + 7) / 8;
    for (int sr = 0; sr < nsr; ++sr) {
    for (int jj = 0; jj < 8; ++jj) { const int tile = C.bid + (8 * sr + jj) * C.G; if (tile >= ntile) break;
        const size_t t0 = (size_t)tile * 32;
        int tid_r = C.tid; asm volatile("" : "+v"(tid_r));
        const int lane_r = tid_r & 63, fr_r = lane_r & 15, fq_r = lane_r >> 4;
#define tid tid_r
#define lane lane_r
#define fr fr_r
#define fq fq_r
#define SK_KEYS(x_, y_) ({ const unsigned hh_ = __builtin_bit_cast(unsigned, __builtin_amdgcn_cvt_pkrtz(x_, y_)); hh_ ^ (__builtin_bit_cast(unsigned, __builtin_bit_cast(s16x2v, hh_) >> 15) | 0x80008000u); })
#define SK_LOAD(dst, hp_, k0_) do { _Pragma("unroll") for (int kk = 0; kk < 4; ++kk) _Pragma("unroll") for (int ks = 0; ks < 4; ++ks) \
            dst[kk][ks] = *(const s16x8*)(SKB + ((size_t)(hp_) * 128 + 16 * ((k0_) + kk) + fr) * 128 + 32 * ks + 8 * fq); } while (0)
#define PQ_LOAD(dst, hp_) do { _Pragma("unroll") for (int tt = 0; tt < 2; ++tt) _Pragma("unroll") for (int ks = 0; ks < 4; ++ks) dst[tt][ks] = *(const s16x8*)(PQ + (t0 + 16 * tt + fr) * NPQ + (hp_) * 128 + 32 * ks + 8 * fq); } while (0)
#define SK_COMP(src, Bq_, hp_, k0_) do { _Pragma("unroll") for (int kk = 0; kk < 4; ++kk) { const int kt = (k0_) + kk; f32x4v a0 = {0.f, 0.f, 0.f, 0.f}, a1 = a0; \
            _Pragma("unroll") for (int ks = 0; ks < 4; ++ks) { a0 = mfma16(src[kk][ks], Bq_[0][ks], a0); a1 = mfma16(src[kk][ks], Bq_[1][ks], a1); } \
              \
            u32x2v kwa_, kwb_; kwa_.x = SK_KEYS(a0[0], a0[1]); kwa_.y = SK_KEYS(a0[2], a0[3]); kwb_.x = SK_KEYS(a1[0], a1[1]); kwb_.y = SK_KEYS(a1[2], a1[3]); \
            *(LAS u32x2v*)(SSK + ((hp_) * 32 + fr) * SSROW + 16 * kt + 4 * fq) = kwa_; *(LAS u32x2v*)(SSK + ((hp_) * 32 + 16 + fr) * SSROW + 16 * kt + 4 * fq) = kwb_; } } while (0)
#pragma unroll 1
        for (int rep1 = 0; rep1 < (((MK_REPEAT >> 11) & 1) ? 2 : 1); ++rep1) {
            const int hp0 = 2 * wave, hp1 = hp0 + 1;
            s16x8 akA[4][4], akB[4][4], Bt0[2][4], Bt1[2][4];
            PQ_LOAD(Bt0, hp0); SK_LOAD(akA, hp0, 0); SK_LOAD(akB, hp0, 4); PQ_LOAD(Bt1, hp1);
            SK_COMP(akA, Bt0, hp0, 0); SK_LOAD(akA, hp1, 0);
            SK_COMP(akB, Bt0, hp0, 4); SK_LOAD(akB, hp1, 4);
            SK_COMP(akA, Bt1, hp1, 0);
            SK_COMP(akB, Bt1, hp1, 4);
        }
#undef SK_LOAD
#undef PQ_LOAD
#undef SK_COMP
#undef SK_KEYS
        __syncthreads();
        for (int repS = 0; repS < (((MK_REPEAT >> 12) & 1) ? 2 : 1); ++repS) {
            if (repS) __syncthreads();
            const int tok = tid & 31, hp = tid >> 5;
            float tk[16];
#pragma unroll
            for (int j = 0; j < 16; ++j) tk[j] = __builtin_bit_cast(float, 0x40000000u);
            const LAS u16* rowp = SSK + (hp * 32 + tok) * SSROW;
#pragma unroll 2
            for (int kb = 0; kb < 16; ++kb) {
                const u32x4v w = *(const LAS u32x4v*)(rowp + 8 * kb);
#pragma unroll
                for (int j = 0; j < 8; ++j) { const int k = 8 * kb + j; const unsigned k16 = (j & 1) ? (w[j >> 1] >> 16) : (w[j >> 1] & 0xffffu);
                    const float x = __builtin_bit_cast(float, (k16 << 7) | (0x40000000u | (unsigned)(127 - k)));
                    float nk[16];
                    nk[0] = __builtin_amdgcn_fmed3f(__builtin_inff(), x, tk[0]);
#pragma unroll
                    for (int jj = 1; jj < 16; ++jj) nk[jj] = __builtin_amdgcn_fmed3f(tk[jj - 1], x, tk[jj]);
#pragma unroll
                    for (int jj = 0; jj < 16; ++jj) tk[jj] = nk[jj]; }
            }
            if (repS + 1 < (((MK_REPEAT >> 12) & 1) ? 2 : 1)) continue;
            __syncthreads();
#pragma unroll
            for (int j = 0; j < 16; ++j) { const unsigned bits = __builtin_bit_cast(unsigned, tk[j]); const unsigned k16 = (bits >> 7) & 0xffffu;
                const unsigned hb = (k16 & 0x8000u) ? (k16 & 0x7fffu) : (~k16 & 0xffffu);
                TV[tid * 16 + j] = (float)__builtin_bit_cast(_Float16, (unsigned short)hb); TI[tid * 16 + j] = (u16)(127u - (bits & 0x7fu)); }
        }
        __syncthreads();
        for (int repK = 0; repK < (((MK_REPEAT >> 13) & 1) ? 2 : 1); ++repK) if (tid < 256) {
            int tid_o = tid; asm volatile("" : "+v"(tid_o));
            const int tok = tid_o & 31, h = tid_o >> 5;
            const int ra = ((2 * h) * 32 + tok) * 16, rb = ((2 * h + 1) * 32 + tok) * 16;
            float va[16], vb[16];
#pragma unroll
            for (int j = 0; j < 16; ++j) { va[j] = TV[ra + j]; vb[j] = TV[rb + j]; }
            float tk[16];
#pragma unroll
            for (int j = 0; j < 16; ++j) tk[j] = -__builtin_inff();
#pragma unroll
            for (int a = 0; a < 16; ++a)
#pragma unroll
                for (int b = 0; b < 16; ++b) if ((a + 1) * (b + 1) <= 16) {
                    const float x = __builtin_bit_cast(float, (__builtin_bit_cast(unsigned, va[a] + vb[b]) & 0xffffff00u) | (unsigned)(a * 16 + b));
                    float nk[16];
                    nk[0] = __builtin_amdgcn_fmed3f(__builtin_inff(), x, tk[0]);
#pragma unroll
                    for (int j = 1; j < 16; ++j) nk[j] = __builtin_amdgcn_fmed3f(tk[j - 1], x, tk[j]);
#pragma unroll
                    for (int j = 0; j < 16; ++j) tk[j] = nk[j];
                }
            float tv[16]; int ti[16];
#pragma unroll
            for (int j = 0; j < 16; ++j) { const unsigned bits = __builtin_bit_cast(unsigned, tk[j]); tv[j] = __builtin_bit_cast(float, bits & 0xffffff00u);
                ti[j] = (int)TI[ra + ((bits >> 4) & 15u)] * 128 + (int)TI[rb + (bits & 15u)]; }
            float mx = tv[0], sum = 0.f, e[16];
#pragma unroll
            for (int j = 0; j < 16; ++j) { e[j] = fast_exp(tv[j] - mx); sum += e[j]; }
            const float inv = __builtin_amdgcn_rcpf(sum);
#pragma unroll
            for (int j = 0; j < 16; ++j) { EID[tok * 128 + h * 16 + j] = ti[j]; EG[tok * 128 + h * 16 + j] = e[j] * inv * VSC[ti[j]]; EU[tok * 128 + h * 16 + j] = USC[ti[j]]; }
        }
        __syncthreads();
        { const u32x4v i0 = *(const LAS u32x4v*)(EID + tid * 8), i1 = *(const LAS u32x4v*)(EID + tid * 8 + 4);
          const f32x4v a0 = *(const LAS f32x4v*)(EG + tid * 8), a1 = *(const LAS f32x4v*)(EG + tid * 8 + 4), u0 = *(const LAS f32x4v*)(EU + tid * 8), u1 = *(const LAS f32x4v*)(EU + tid * 8 + 4);
          *(u32x4v*)(G_SID + t0 * 128 + tid * 8) = i0; *(u32x4v*)(G_SID + t0 * 128 + tid * 8 + 4) = i1;
          *(f32x4v*)(G_SG + t0 * 128 + tid * 8) = a0; *(f32x4v*)(G_SG + t0 * 128 + tid * 8 + 4) = a1;
          *(f32x4v*)(G_SU + t0 * 128 + tid * 8) = u0; *(f32x4v*)(G_SU + t0 * 128 + tid * 8 + 4) = u1; }
        __syncthreads();
#undef tid
#undef lane
#undef fr
#undef fq
    }
    __syncthreads();
    int lane_o = C.lane, wave_o = C.wave; asm volatile("" : "+v"(lane_o), "+s"(wave_o));
#define lane lane_o
#define wave wave_o
    LAS float* PD = (LAS float*)(C.lds + PE_PD) + wave * 4096;
    LAS float* STAT = (LAS float*)(C.lds + PE_STAT) + wave * 64;
    LAS float* WSC = (LAS float*)(C.lds + PE_WSC) + wave * 32;
    {
#pragma unroll
        for (int i = 0; i < 16; ++i) *(LAS f32x4v*)(PD + (i * 64 + lane) * 4) = (f32x4v){0.f, 0.f, 0.f, 0.f};
        STAT[lane] = 0.f;
        LDS_FENCE();
    }
#define ID_LOAD(kb_) (*(const u32x2v*)(sid + 16 * (kb_) + 2 * pc))
#define ROW_ISSUE(buf, idv, hb_, tbl) do { _Pragma("unroll") for (int jj_ = 0; jj_ < 8; ++jj_) { const int j_ = 8 * ((hb_) & 1) + jj_; \
            const unsigned id_ = (unsigned)__shfl((int)((j_ & 1) ? idv.y : idv.x), 8 * g + (j_ >> 1)); \
            buf[jj_] = *(const u32x4v*)((tbl) + ((id_ << 7) + (unsigned)(pc * 16))); } } while (0)
#define STREAM(tbl, CONSUME) do { \
        u32x2v idA_ = idP0, idB_ = idP1; u32x4v bA_[8], bB_[8];                       \
        idP0 = *(const u32x2v*)(sidn + 2 * pc); idP1 = *(const u32x2v*)(sidn + 16 + 2 * pc); \
        ROW_ISSUE(bA_, idA_, 0, tbl); ROW_ISSUE(bB_, idA_, 1, tbl); \
        _Pragma("unroll 1") for (int hb = 0; hb < 16; hb += 2) { \
            __builtin_amdgcn_sched_barrier(0); CONSUME(bA_, hb); __builtin_amdgcn_sched_barrier(0);        \
            if (hb + 2 < 16) ROW_ISSUE(bA_, idB_, hb + 2, tbl); \
            __builtin_amdgcn_sched_barrier(0); CONSUME(bB_, hb + 1); __builtin_amdgcn_sched_barrier(0); \
            if (hb + 2 < 16) { ROW_ISSUE(bB_, idB_, hb + 3, tbl); idA_ = idB_; if (hb + 4 < 16) idB_ = ID_LOAD((hb >> 1) + 2); } } } while (0)
#define R_TOKEN(r_) ({ const int q_ = 8 * (r_) + g; const int tl_ = C.bid + (8 * sr + (q_ >> 2)) * C.G; (tl_ < ntile ? (size_t)tl_ * 32 + 4 * wave + (q_ & 3) : (size_t)0); })
    asm volatile("" : "+v"(lane_o));
    { const int g = lane >> 3, pc = lane & 7;
    u32x2v idP0, idP1; { const unsigned* s0_ = G_SID + R_TOKEN(0) * 128; idP0 = *(const u32x2v*)(s0_ + 2 * pc); idP1 = *(const u32x2v*)(s0_ + 16 + 2 * pc); }
    for (int repU = 0; repU < (((MK_REPEAT >> 20) & 5) ? 2 : 1); ++repU)
#pragma unroll 1
    for (int seg = 0; seg < NSEG; ++seg) {
#if MK_PASSBAR == 1
        grid.sync();
#endif
        const unsigned char* tbl = U8 + (size_t)seg * (16384u * SEGB);
#pragma unroll 1
        for (int r = 0; r < 4; ++r) {
            const int q = 8 * r + g; const int tile = C.bid + (8 * sr + (q >> 2)) * C.G; const bool valid = tile < ntile;
            const size_t token = valid ? (size_t)tile * 32 + 4 * wave + (q & 3) : 0;
            const unsigned* sid = G_SID + token * 128; const unsigned* sidn = G_SID + R_TOKEN((r + 1) & 3) * 128;
            const u32x4v x8 = *(const u32x4v*)(H8 + token * 1024 + seg * SEGB + pc * 16);
            LAS int* pdq = (LAS int*)PD + q * 128;
#define U_CONSUME(buf, hb_) do { int pv_[8]; \
                _Pragma("unroll") for (int i = 0; i < 8; ++i) { int a_ = __builtin_amdgcn_sdot4((int)buf[i][0], (int)x8[0], 0, false); a_ = __builtin_amdgcn_sdot4((int)buf[i][1], (int)x8[1], a_, false);     \
                    a_ = __builtin_amdgcn_sdot4((int)buf[i][2], (int)x8[2], a_, false); pv_[i] = __builtin_amdgcn_sdot4((int)buf[i][3], (int)x8[3], a_, false); } \
                int r_[4], q_[2];                                               \
                _Pragma("unroll") for (int i = 0; i < 4; ++i) { const int snd_ = (pc & 4) ? pv_[i] : pv_[i + 4], kp_ = (pc & 4) ? pv_[i + 4] : pv_[i]; r_[i] = kp_ + dppi_xor4(snd_); } \
                _Pragma("unroll") for (int i = 0; i < 2; ++i) { const int snd_ = (pc & 2) ? r_[i] : r_[i + 2], kp_ = (pc & 2) ? r_[i + 2] : r_[i]; q_[i] = kp_ + dppi_xor2(snd_); } \
                const int z_ = ((pc & 1) ? q_[1] : q_[0]) + dppi_xor1((pc & 1) ? q_[0] : q_[1]); \
                if (valid && repU == 0) pdq[8 * (hb_) + pc] += z_; } while (0)
#ifndef MK_NOU
            STREAM(tbl, U_CONSUME);
#endif
#undef U_CONSUME
        }
    }
    }
    LDS_FENCE();
    asm volatile("" : "+v"(lane_o));
#define W_TOKEN(q_) ({ const int tl_ = C.bid + (8 * sr + ((q_) >> 2)) * C.G; (size_t)(tl_ < ntile ? tl_ : C.bid) * 32 + 4 * wave + ((q_) & 3); })
    float nsg0, nsg1, nsu0, nsu1, nhs;
    { const size_t tk_ = W_TOKEN(0); nsg0 = G_SG[tk_ * 128 + lane]; nsg1 = G_SG[tk_ * 128 + 64 + lane]; nsu0 = G_SU[tk_ * 128 + lane]; nsu1 = G_SU[tk_ * 128 + 64 + lane]; nhs = HS[tk_]; }
#pragma unroll 1
    for (int q = 0; q < 32; ++q) { const int tile = C.bid + (8 * sr + (q >> 2)) * C.G;
        const float sg0 = nsg0, sg1 = nsg1, su0 = nsu0, su1 = nsu1, hs = nhs;
        { const size_t tk_ = W_TOKEN(q + 1 < 32 ? q + 1 : q); nsg0 = G_SG[tk_ * 128 + lane]; nsg1 = G_SG[tk_ * 128 + 64 + lane]; nsu0 = G_SU[tk_ * 128 + lane]; nsu1 = G_SU[tk_ * 128 + 64 + lane]; nhs = HS[tk_]; }
        if (tile >= ntile) continue;
        const float w0 = sg0 * gelu_tanh((float)((LAS int*)PD)[q * 128 + lane] * (su0 * hs));
        const float w1 = sg1 * gelu_tanh((float)((LAS int*)PD)[q * 128 + 64 + lane] * (su1 * hs));
        float am = fmaxf(fabsf(w0), fabsf(w1));
        am = wave_max_f(am);
        const float qs = am > 0.f ? 127.f / am : 0.f;
        LAS signed char* w8 = (LAS signed char*)(PD + q * 128);
        w8[lane] = (signed char)(int)__builtin_rintf(w0 * qs); w8[64 + lane] = (signed char)(int)__builtin_rintf(w1 * qs);
        if (lane == 0) WSC[q] = am * (1.f / 127.f); }
#undef W_TOKEN
    LDS_FENCE();
    asm volatile("" : "+v"(lane_o));
    { const int g = lane >> 3, pc = lane & 7;
    const unsigned shb = 8u * (unsigned)(lane & 3), selb = 0x0c0c0c0cu & ~(0xffu << shb);
    u32x2v idP0, idP1; { const unsigned* s0_ = G_SID + R_TOKEN(0) * 128; idP0 = *(const u32x2v*)(s0_ + 2 * pc); idP1 = *(const u32x2v*)(s0_ + 16 + 2 * pc); }
#pragma unroll 1
    for (int seg = 0; seg < NSEG; ++seg) {
#if MK_PASSBAR == 1
        grid.sync();
#endif
        const unsigned char* tbl = V8 + (size_t)seg * (16384u * SEGB);
#pragma unroll 1
        for (int r = 0; r < 4; ++r) {
            const int q = 8 * r + g; const int tile = C.bid + (8 * sr + (q >> 2)) * C.G; const bool valid = tile < ntile;
            const size_t token = valid ? (size_t)tile * 32 + 4 * wave + (q & 3) : 0;
            const unsigned* sid = G_SID + token * 128; const unsigned* sidn = G_SID + R_TOKEN((r + 1) & 3) * 128;
            const LAS unsigned char* wq_ = (const LAS unsigned char*)(PD + q * 128);
            const u32x4v h0 = *(const u32x4v*)(HB + token * 1024 + seg * SEGB + pc * 16), h1 = *(const u32x4v*)(HB + token * 1024 + seg * SEGB + pc * 16 + 8);
            i32x4v accR[4];
#pragma unroll
            for (int j = 0; j < 4; ++j) accR[j] = (i32x4v){0, 0, 0, 0};
#define V_CONSUME(buf, hb_) do { const u32x2v w8_ = *(const LAS u32x2v*)(wq_ + 8 * (hb_)); \
                _Pragma("unroll") for (int i = 0; i < 8; ++i) { const int bop_ = (int)__builtin_amdgcn_perm(w8_.y, w8_.x, selb | ((unsigned)i << shb)); \
                    _Pragma("unroll") for (int r_ = 0; r_ < 4; ++r_) accR[r_] = __builtin_amdgcn_mfma_i32_4x4x4i8((int)buf[i][r_], bop_, accR[r_], 0, 0, 0); } } while (0)
#ifndef MK_NOV
            STREAM(tbl, V_CONSUME);
#endif
#undef V_CONSUME
#pragma unroll
            for (int r_ = 0; r_ < 4; ++r_) {
#pragma unroll
                for (int a = 0; a < 4; a += 2) { const int snd = (pc & 1) ? accR[r_][a] : accR[r_][a + 1]; const int rcv = dppi_xor1(snd); if (pc & 1) accR[r_][a] = rcv; else accR[r_][a + 1] = rcv; }
#pragma unroll
                for (int a = 0; a < 2; ++a) { const int snd = (pc & 2) ? accR[r_][a] : accR[r_][a + 2]; const int rcv = dppi_xor2(snd); if (pc & 2) accR[r_][a] = rcv; else accR[r_][a + 2] = rcv; }
            }
            const float wsq = WSC[q];
            float y[16]; float s1 = 0.f, s2 = 0.f;
#pragma unroll
            for (int j = 0; j < 4; ++j) { y[2 * j] = ALPHA * bf_lo(h0[j]) + (float)accR[j >> 1][2 * (j & 1)] * wsq; y[2 * j + 1] = ALPHA * bf_hi(h0[j]) + (float)accR[j >> 1][2 * (j & 1) + 1] * wsq;
                y[8 + 2 * j] = ALPHA * bf_lo(h1[j]) + (float)accR[2 + (j >> 1)][2 * (j & 1)] * wsq; y[8 + 2 * j + 1] = ALPHA * bf_hi(h1[j]) + (float)accR[2 + (j >> 1)][2 * (j & 1) + 1] * wsq; }
#pragma unroll
            for (int j = 0; j < 16; ++j) { s1 += y[j]; s2 += y[j] * y[j]; }
            s1 += dpp_xor1(s1); s2 += dpp_xor1(s2); s1 += dpp_xor2(s1); s2 += dpp_xor2(s2); s1 += dpp_xor4(s1); s2 += dpp_xor4(s2);
            if (valid) { u16* op = YB + token * 1024 + seg * SEGB + pc * 16;
                u32x4v w0, w1;
#pragma unroll
                for (int c = 0; c < 4; ++c) { w0[c] = cvtpk(y[2 * c], y[2 * c + 1]); w1[c] = cvtpk(y[8 + 2 * c], y[8 + 2 * c + 1]); }
                *(u32x4v*)op = w0; *(u32x4v*)(op + 8) = w1;
                if (pc == 0) { STAT[2 * q] += s1; STAT[2 * q + 1] += s2; } }
        }
    }
    }
    LDS_FENCE();
    asm volatile("" : "+v"(lane_o));
    __builtin_amdgcn_fence(__ATOMIC_RELEASE, "workgroup");
    asm volatile("s_waitcnt vmcnt(0)" ::: "memory");
#define L_TOKEN(q_) ({ const int tl_ = C.bid + (8 * sr + ((q_) >> 2)) * C.G; (size_t)(tl_ < ntile ? tl_ : C.bid) * 32 + 4 * wave + ((q_) & 3); })
    u32x4v yn0, yn1; { const size_t tk_ = L_TOKEN(0); yn0 = *(const u32x4v*)(YB + tk_ * 1024 + lane * 16); yn1 = *(const u32x4v*)(YB + tk_ * 1024 + lane * 16 + 8); }
    f32x4v ga4[4], ba4[4];
#pragma unroll
    for (int c = 0; c < 4; ++c) { ga4[c] = *(const f32x4v*)(g2 + lane * 16 + 4 * c); ba4[c] = *(const f32x4v*)(b2 + lane * 16 + 4 * c); }
#pragma unroll 1
    for (int q = 0; q < 32; ++q) { const int tile = C.bid + (8 * sr + (q >> 2)) * C.G;
        const u32x4v y0 = yn0, y1 = yn1;
        { const size_t tk_ = L_TOKEN(q + 1 < 32 ? q + 1 : q); yn0 = *(const u32x4v*)(YB + tk_ * 1024 + lane * 16); yn1 = *(const u32x4v*)(YB + tk_ * 1024 + lane * 16 + 8); }
        if (tile >= ntile) continue;
        const size_t token = (size_t)tile * 32 + 4 * wave + (q & 3);
        const float mu = STAT[2 * q] * (1.f / 1024.f), var = STAT[2 * q + 1] * (1.f / 1024.f) - mu * mu;
        const float rstd = __builtin_amdgcn_rsqf(fmaxf(var, 0.f) + EPS);
        float* op = C.out + token * 1024 + lane * 16;
#pragma unroll
        for (int c = 0; c < 4; ++c) { const u32x4v& yy = c < 2 ? y0 : y1; const f32x4v yv = {bf_lo(yy[2 * (c & 1)]), bf_hi(yy[2 * (c & 1)]), bf_lo(yy[2 * (c & 1) + 1]), bf_hi(yy[2 * (c & 1) + 1])};
            *(f32x4v*)(op + 4 * c) = (yv - mu) * rstd * ga4[c] + ba4[c]; } }
#undef L_TOKEN
#undef ID_LOAD
#undef R_TOKEN
#undef ROW_ISSUE
#undef STREAM
#undef lane
#undef wave
    __syncthreads();
    }
}


#ifndef MK_LAUNCHES
#define MK_LAUNCHES 1
#endif
constexpr int NPHASE = 7;
#define REP(k) for (int rep_ = 0; rep_ < (((MK_REPEAT >> (k)) & 1) ? 2 : 1); ++rep_, ((MK_REPEAT >> (k)) & 1) ? grid.sync() : (void)0)


__global__ void __launch_bounds__(NTHREADS, 2) hymba_fwd(Args args) {
    extern __shared__ __attribute__((aligned(16))) unsigned char lds_raw[];
    Ctx C;
    C.lds = (LAS unsigned char*)lds_raw;
    C.tid = threadIdx.x; C.lane = C.tid & 63; C.wave = __builtin_amdgcn_readfirstlane(C.tid >> 6);
    C.G = gridDim.x; C.bid = blockIdx.x;
#pragma unroll
    for (int i = 0; i < 16; ++i) C.in[i] = args.in[i];
    C.out = args.out; C.ws = args.ws;
    const int lo = args.ph_lo, hi = args.ph_hi;
    cg::grid_group grid = cg::this_grid();
#ifdef MK_ONLY
#define IN(k) ((k) == MK_ONLY)
#else
#define IN(k) (lo <= (k) && (k) < hi)
#endif
    unsigned bar_target = 0u;
#define SEAM(k) do { if (IN(k) && IN((k) + 1)) { if ((k) == 0 || MK_REPEAT || !MK_CUSTOM_BAR) grid.sync(); else grid_bar(C, bar_target); } } while (0)
    unsigned char* ws = C.ws;
    if (IN(0)) REP(0) p0_prologue(C);
    SEAM(0);
    if (IN(0)) p0b_quant(C);
    SEAM(0);
    if (IN(1)) REP(1) {
        pg8::Gemm g{(const pg8::bf16_t*)(ws + WS_XB), (const pg8::bf16_t*)(ws + WS_W1Q), MTOK, N1, DM / 2};
        pg8::StaticOrder S; S.init(MTOK, N1, C.G, C.bid);
        pg8::EpiProj E{(pg8::bf16_t*)(ws + WS_QLAT), (pg8::bf16_t*)(ws + WS_QIDX), (pg8::bf16_t*)(ws + WS_CKV), (pg8::bf16_t*)(ws + WS_KIDX), (float*)(ws + WS_WIDX), (float*)(ws + WS_SSQ),
                       (pg8::bf16_t*)(ws + WS_HQ), (float*)(ws + WS_HLF), (pg8::bf16_t*)(ws + WS_HV), (pg8::bf16_t*)(ws + WS_HG), (const float*)(ws + WS_LB), (const float*)(ws + WS_XS), (const float*)(ws + WS_W1S)};
        pg8::gemm_phase<pg8::EpiProj, pg8::StaticOrder, true, true, true>(C.lds, g, S, E);
    }
    SEAM(1);
    if (IN(2)) REP(2) p2_mixers(C, rep_);
    SEAM(2);
    if (IN(3)) REP(3) {
        pg8::Gemm g{(const pg8::bf16_t*)(ws + WS_MIX), (const pg8::bf16_t*)(ws + WS_W3M), MTOK, DM, MIXB / 2};
        pg8::StaticOrder S; S.init(MTOK, DM, C.G, C.bid);
        pg8::EpiY1 E{C.in[I_X], (pg8::bf16_t*)(ws + WS_Y1), ALPHA, (const float*)(ws + WS_MIXS), (const float*)(ws + WS_W3S)};
        pg8::gemm_phase<pg8::EpiY1, pg8::StaticOrder, true, true, false, 8>(C.lds, g, S, E);
    }
    SEAM(3);
    if (IN(4)) REP(4) p4_ln1(C);
    SEAM(4);
    if (IN(5)) REP(5) {
        pg8::Gemm g{(const pg8::bf16_t*)(ws + WS_H8), (const pg8::bf16_t*)(ws + WS_W5Q), MTOK, NPQ, DM / 2};
        pg8::StaticOrder S; S.init(MTOK, NPQ, C.G, C.bid);
        pg8::EpiPQ E{(pg8::bf16_t*)(ws + WS_PQ), NPQ, (const float*)(ws + WS_HS), (const float*)(ws + WS_W5S)};
        pg8::gemm_phase<pg8::EpiPQ, pg8::StaticOrder, true, true, true>(C.lds, g, S, E);
    }
    SEAM(5);
    if (IN(6)) REP(6) p6_peer(C);
#undef IN
#undef SEAM
}

extern "C" void kernel_launch(void* const* d_in, const int* in_sizes, int n_in, void* d_out, int out_size, void* d_ws, size_t ws_size, hipStream_t stream) {
    static int grid = 0;
    if (grid == 0) {
        if (n_in != 16 || out_size != MTOK * DM || ws_size < WS_END) { fprintf(stderr, "kernel_launch: unexpected shapes (n_in %d, out %d, ws %zu)\n", n_in, out_size, ws_size); grid = -1; return; }
        int dev = 0, cus = 0, per_cu = 0;
        if (hipGetDevice(&dev) != hipSuccess || hipDeviceGetAttribute(&cus, hipDeviceAttributeMultiprocessorCount, dev) != hipSuccess) { grid = -1; return; }
        if (hipFuncSetAttribute((const void*)hymba_fwd, hipFuncAttributeMaxDynamicSharedMemorySize, LDS_BYTES) != hipSuccess) { fprintf(stderr, "kernel_launch: hipFuncSetAttribute failed\n"); grid = -1; return; }
        if (hipOccupancyMaxActiveBlocksPerMultiprocessor(&per_cu, (const void*)hymba_fwd, NTHREADS, LDS_BYTES) != hipSuccess || per_cu < 1) { fprintf(stderr, "kernel_launch: occupancy query says %d blocks per CU\n", per_cu); (void)hipGetLastError(); grid = -1; return; }
        grid = cus;
    }
    if (grid < 0) return;
    Args a{};
    for (int i = 0; i < 16; ++i) a.in[i] = (const float*)d_in[i];
    a.out = (float*)d_out; a.ws = (unsigned char*)d_ws;
#if MK_LAUNCHES == 1
    a.ph_lo = 0; a.ph_hi = NPHASE;
    void* kargs[] = {&a};
    hipError_t e = hipLaunchCooperativeKernel((const void*)hymba_fwd, dim3(grid), dim3(NTHREADS), kargs, LDS_BYTES, stream);
    if (e != hipSuccess) fprintf(stderr, "kernel_launch: cooperative launch failed: %s (grid %d)\n", hipGetErrorString(e), grid);
#else
    for (int p = 0; p < NPHASE; ++p) { a.ph_lo = p; a.ph_hi = p + 1; hipLaunchKernelGGL(hymba_fwd, dim3(grid), dim3(NTHREADS), LDS_BYTES, stream, a); }
#endif
}
```

```cpp
#include <hip/hip_runtime.h>
#include <hip/hip_cooperative_groups.h>
#include <cstdio>
#include <cstdint>
namespace cg = cooperative_groups;

#define LAS __attribute__((address_space(3)))
typedef unsigned short u16;
typedef short s16x8 __attribute__((ext_vector_type(8)));
typedef short s16x4 __attribute__((ext_vector_type(4)));
typedef float f32x4v __attribute__((ext_vector_type(4)));
typedef float f32x16v __attribute__((ext_vector_type(16)));
typedef unsigned u32x4v __attribute__((ext_vector_type(4)));
typedef unsigned u32x2v __attribute__((ext_vector_type(2)));
typedef __bf16 bf16x2v __attribute__((ext_vector_type(2)));

constexpr int NB = 8, SEQ = 8192, DM = 1024, MTOK = NB * SEQ;
constexpr int DIN = 3272;
constexpr int N1 = 3840;
constexpr int K3 = 1536;
constexpr int NPQ = 2048;
constexpr float EPS = 1e-5f;
constexpr float ALPHA = 1.189207115002721f;
constexpr int TOPK = 256;

constexpr size_t MiB = 1u << 20;
constexpr size_t WS_CTL = 0, WS_LB = 4096, WS_USC = 65536, WS_VSC = 131072;
constexpr size_t WS_W1T = 1 * MiB, WS_W3T = 9 * MiB, WS_W5T = 12 * MiB, WS_SKB = 16 * MiB, WS_UB = 17 * MiB, WS_VB = 49 * MiB;
constexpr size_t WS_XB = 96 * MiB, WS_MIX = 96 * MiB;
constexpr size_t WS_H8 = WS_MIX + 96 * MiB, WS_HS = WS_MIX + 160 * MiB;
constexpr size_t WS_W1Q = 36 * MiB, WS_W1S = 272 * 1024, WS_XS = 40 * MiB;
constexpr size_t WS_W3M = 44 * MiB, WS_W3S = 288 * 1024, WS_MIXS = 41 * MiB;
constexpr int MIXB = 2048;
constexpr size_t WS_W5Q = 34 * MiB, WS_W5S = 256 * 1024;
constexpr size_t WS_R2 = 288 * MiB;
constexpr size_t WS_QLAT = WS_R2, WS_QIDX = WS_R2 + 128 * MiB, WS_CKV = WS_R2 + 192 * MiB, WS_KIDX = WS_R2 + 208 * MiB, WS_WIDX = WS_R2 + 216 * MiB, WS_SSQ = WS_R2 + 218 * MiB;
constexpr size_t WS_HQ = WS_R2 + 224 * MiB, WS_HLF = WS_R2 + 288 * MiB, WS_HV = WS_R2 + 416 * MiB, WS_HG = WS_R2 + 480 * MiB;
constexpr size_t WS_Y1 = WS_R2, WS_HB = WS_R2 + 256 * MiB, WS_PQ = WS_R2;
constexpr size_t WS_YB = WS_R2 + 384 * MiB;
constexpr size_t WS_END = WS_R2 + 544 * MiB;

#ifndef MK_REPEAT
#define MK_REPEAT 0
#endif
#ifndef MK_NOSORT
#define MK_NOSORT 0
#endif
constexpr int LDS_BYTES = 160 * 1024;
constexpr int NTHREADS = 512;

typedef float f32x2v __attribute__((ext_vector_type(2)));
__device__ __forceinline__ unsigned cvtpk(float lo, float hi) { const f32x2v v = {lo, hi}; const bf16x2v b = __builtin_convertvector(v, bf16x2v); return __builtin_bit_cast(unsigned, b); }
__device__ __forceinline__ float bf_lo(unsigned w) { return __builtin_bit_cast(float, w << 16); }
__device__ __forceinline__ float bf_hi(unsigned w) { return __builtin_bit_cast(float, w & 0xffff0000u); }
__device__ __forceinline__ float bf1(u16 w) { return __builtin_bit_cast(float, (unsigned)w << 16); }
__device__ __forceinline__ float fast_exp(float x) { return __builtin_amdgcn_exp2f(x * 1.4426950408889634f); }
__device__ __forceinline__ float sigmoidf_(float x) { return __builtin_amdgcn_rcpf(1.f + fast_exp(-x)); }
__device__ __forceinline__ float siluf_(float x) { return x * sigmoidf_(x); }
typedef int i32x4v __attribute__((ext_vector_type(4)));
__device__ __forceinline__ unsigned pack_i8(float a, float b, float c, float d) {
    const int ia = (int)__builtin_rintf(a), ib = (int)__builtin_rintf(b), ic = (int)__builtin_rintf(c), id = (int)__builtin_rintf(d);
    return ((unsigned)ia & 0xffu) | (((unsigned)ib & 0xffu) << 8) | (((unsigned)ic & 0xffu) << 16) | ((unsigned)id << 24);
}
__device__ __forceinline__ float dot2bf(unsigned a, unsigned b, float acc) { return __builtin_amdgcn_fdot2_f32_bf16(__builtin_bit_cast(bf16x2v, a), __builtin_bit_cast(bf16x2v, b), acc, false); }
__device__ __forceinline__ float dpp_xor1(float v) { return __builtin_bit_cast(float, __builtin_amdgcn_update_dpp(0, __builtin_bit_cast(int, v), 0xB1, 0xf, 0xf, true)); }
__device__ __forceinline__ float dpp_xor2(float v) { return __builtin_bit_cast(float, __builtin_amdgcn_update_dpp(0, __builtin_bit_cast(int, v), 0x4E, 0xf, 0xf, true)); }
__device__ __forceinline__ int dppi_xor1(int v) { return __builtin_amdgcn_update_dpp(0, v, 0xB1, 0xf, 0xf, true); }
__device__ __forceinline__ int dppi_xor2(int v) { return __builtin_amdgcn_update_dpp(0, v, 0x4E, 0xf, 0xf, true); }
__device__ __forceinline__ int dppi_xor4(int v) { return __builtin_amdgcn_update_dpp(0, __builtin_amdgcn_update_dpp(0, v, 0x141, 0xf, 0xf, true), 0x1B, 0xf, 0xf, true); }
__device__ __forceinline__ float dpp_xor4(float v) { const int t = __builtin_amdgcn_update_dpp(0, __builtin_bit_cast(int, v), 0x141, 0xf, 0xf, true); return __builtin_bit_cast(float, __builtin_amdgcn_update_dpp(0, t, 0x1B, 0xf, 0xf, true)); }
__device__ __forceinline__ float dpp_rowmirror(float v) { return __builtin_bit_cast(float, __builtin_amdgcn_update_dpp(0, __builtin_bit_cast(int, v), 0x140, 0xf, 0xf, true)); }
__device__ __forceinline__ float wave_max_f(float v) { v = fmaxf(v, dpp_xor1(v)); v = fmaxf(v, dpp_xor2(v)); v = fmaxf(v, dpp_xor4(v)); v = fmaxf(v, dpp_rowmirror(v)); v = fmaxf(v, __shfl_xor(v, 16)); return fmaxf(v, __shfl_xor(v, 32)); }
__device__ __forceinline__ float wave_sum_f(float v) { v += dpp_xor1(v); v += dpp_xor2(v); v += dpp_xor4(v); v += dpp_rowmirror(v); v += __shfl_xor(v, 16); return v + __shfl_xor(v, 32); }
#define LDS_FENCE() asm volatile("s_waitcnt lgkmcnt(0)" ::: "memory")

namespace pg8 {
#define PG8_LAS __attribute__((address_space(3)))
typedef unsigned short bf16_t;
typedef short bf16x8 __attribute__((ext_vector_type(8)));
typedef float f32x4 __attribute__((ext_vector_type(4)));
typedef unsigned u32x4 __attribute__((ext_vector_type(4)));
constexpr int BM = 256, BK = 64, HALF = 128, HTB = HALF * BK * 2  , STAGE_BYTES = 8 * HTB, NXCD = 8, WGM = 8;

__host__ __device__ __forceinline__ int lds_byte(int r, int c) { const int st = (r >> 4) * 2 + (c >> 5), rr = r & 15, cc = c & 31, ob = rr * 64 + cc * 2; return st * 1024 + (ob ^ (((ob >> 9) & 1) << 5)); }
__host__ __device__ __forceinline__ void stage_rc(int b, int& R, int& C) { const int st = b / 1024, sb = b % 1024, swz = sb ^ (((sb >> 9) & 1) << 5); R = (st >> 1) * 16 + swz / 64; C = (st & 1) * 32 + (swz % 64) / 2; }
__host__ __device__ __forceinline__ int perm32(int rho) { const int n = rho >> 4, i = rho & 15; return 8 * (i >> 2) + 4 * n + (i & 3); }

typedef int pg8_i32x4 __attribute__((ext_vector_type(4)));
struct Unit { int pm, pn; };
struct Gemm { const bf16_t* A; const bf16_t* Bt; int M, N, K; };

struct StaticOrder {
    int nM, nN, nwg, G, c;
    __host__ __device__ void init(int M, int N, int G_, int c_) { nM = M / BM; nN = N / BM; nwg = nM * nN; G = G_; c = c_; }
    __host__ __device__ bool next(int i, Unit& u) const {
        const long L = (long)i * G + c; if (L >= nwg) return false;
        int wgid = (int)L; { const int q = nwg / NXCD, r = nwg % NXCD, xcd = wgid % NXCD, off = wgid / NXCD; wgid = (xcd < r ? xcd * (q + 1) : r * (q + 1) + (xcd - r) * q) + off; }
        const int nig = WGM * nN, gid = wgid / nig, fm = gid * WGM, gsz = (nM - fm) < WGM ? (nM - fm) : WGM;
        u.pm = fm + ((wgid % nig) % gsz); u.pn = (wgid % nig) / gsz; return true;
    }
    __device__ __forceinline__ void a_ready(const Unit&) const {}
    __device__ __forceinline__ void done(const Unit&) const {}
};

__device__ __forceinline__ unsigned cvt_pk_bf16(float lo, float hi) { return cvtpk(lo, hi); }
typedef float f32x2 __attribute__((ext_vector_type(2)));

__device__ __forceinline__ u32x4 pack8(const f32x4& v0, const f32x4& v1) { u32x4 w; w.x = cvt_pk_bf16(v0[0], v0[1]); w.y = cvt_pk_bf16(v0[2], v0[3]); w.z = cvt_pk_bf16(v1[0], v1[1]); w.w = cvt_pk_bf16(v1[2], v1[3]); return w; }

struct EpiPlain {
    static constexpr bool PERM = true, AFTER_DRAIN = false;
    bf16_t* O; int ldc;
    __device__ __forceinline__ void operator()(const f32x4 (&acc)[2][2][4][2], const Unit& u, int wr, int wc, int fr, int fq) const {
        const int row0 = u.pm * BM + wr * 64 + fr, col0 = u.pn * BM + wc * 32 + 8 * fq;
#pragma unroll
        for (int ai = 0; ai < 2; ++ai)
#pragma unroll
            for (int m = 0; m < 4; ++m) { bf16_t* rowp = O + (size_t)(row0 + ai * HALF + m * 16) * ldc + col0;
#pragma unroll
                for (int bj = 0; bj < 2; ++bj) *(u32x4*)(rowp + bj * HALF) = pack8(acc[ai][bj][m][0], acc[ai][bj][m][1]); }
    }
};

struct EpiPQ {
    static constexpr bool PERM = true, AFTER_DRAIN = false;
    bf16_t* O; int ldc; const float* rs; const float* cs;
    __device__ __forceinline__ void operator()(const f32x4 (&acc)[2][2][4][2], const Unit& u, int wr, int wc, int fr, int fq) const {
        const int row0 = u.pm * BM + wr * 64 + fr, col0 = u.pn * BM + wc * 32 + 8 * fq;
        f32x4 c0[2], c1[2];
#pragma unroll
        for (int bj = 0; bj < 2; ++bj) { c0[bj] = *(const f32x4*)(cs + col0 + bj * HALF); c1[bj] = *(const f32x4*)(cs + col0 + bj * HALF + 4); }
#pragma unroll
        for (int ai = 0; ai < 2; ++ai)
#pragma unroll
            for (int m = 0; m < 4; ++m) { const int row = row0 + ai * HALF + m * 16; const float sr = rs[row]; bf16_t* rowp = O + (size_t)row * ldc + col0;
#pragma unroll
                for (int bj = 0; bj < 2; ++bj) {
                    const f32x4 v0 = __builtin_convertvector(__builtin_bit_cast(pg8_i32x4, acc[ai][bj][m][0]), f32x4) * sr * c0[bj], v1 = __builtin_convertvector(__builtin_bit_cast(pg8_i32x4, acc[ai][bj][m][1]), f32x4) * sr * c1[bj];
                    *(u32x4*)(rowp + bj * HALF) = pack8(v0, v1); } }
    }
};

struct EpiY1 {
    static constexpr bool PERM = true, AFTER_DRAIN = false;
    const float* X; bf16_t* Y; float alpha; const float* rs; const float* cs;
    __device__ __forceinline__ void to_float(f32x4 (&acc)[2][2][4][2], const Unit& u, int wr, int wc, int fr, int fq) const {
        const int row0 = u.pm * BM + wr * 64 + fr;
#pragma unroll
        for (int ai = 0; ai < 2; ++ai)
#pragma unroll
            for (int m = 0; m < 4; ++m) { const float sr = rs[row0 + ai * HALF + m * 16];
#pragma unroll
                for (int bj = 0; bj < 2; ++bj)
#pragma unroll
                    for (int n = 0; n < 2; ++n) acc[ai][bj][m][n] = __builtin_convertvector(__builtin_bit_cast(pg8_i32x4, acc[ai][bj][m][n]), f32x4) * sr; }
    }
    __device__ __forceinline__ void operator()(const f32x4 (&acc)[2][2][4][2], const Unit& u, int wr, int wc, int fr, int fq) const {
        const int row0 = u.pm * BM + wr * 64 + fr, col0 = u.pn * BM + wc * 32 + 8 * fq;
#pragma unroll
        for (int ai = 0; ai < 2; ++ai)
#pragma unroll
            for (int m = 0; m < 4; ++m) { const size_t o = (size_t)(row0 + ai * HALF + m * 16) * 1024 + col0;
#pragma unroll
                for (int bj = 0; bj < 2; ++bj) {
                    const f32x4 x0 = *(const f32x4*)(X + o + bj * HALF), x1 = *(const f32x4*)(X + o + bj * HALF + 4);
                    const f32x4 c0 = *(const f32x4*)(cs + col0 + bj * HALF), c1 = *(const f32x4*)(cs + col0 + bj * HALF + 4);
                    *(u32x4*)(Y + o + bj * HALF) = pack8(x0 * alpha + acc[ai][bj][m][0] * c0, x1 * alpha + acc[ai][bj][m][1] * c1); } }
    }
};

__device__ __forceinline__ float ep_exp(float x) { return __builtin_amdgcn_exp2f(x * 1.4426950408889634f); }
__device__ __forceinline__ float ep_sig(float x) { return __builtin_amdgcn_rcpf(1.f + ep_exp(-x)); }
__device__ __forceinline__ f32x4 silu4(const f32x4& v) { f32x4 r; r[0] = v[0] * ep_sig(v[0]); r[1] = v[1] * ep_sig(v[1]); r[2] = v[2] * ep_sig(v[2]); r[3] = v[3] * ep_sig(v[3]); return r; }

__device__ __forceinline__ unsigned pk_f16(float a, float b) { return (unsigned)__builtin_bit_cast(unsigned short, (_Float16)a) | ((unsigned)__builtin_bit_cast(unsigned short, (_Float16)b) << 16); }
struct EpiProj {
    static constexpr bool PERM = true, AFTER_DRAIN = false;
    bf16_t *QLAT, *QIDX, *CKV, *KIDX; float *WIDX, *SSQ; bf16_t* HQ; bf16_t* HLF; bf16_t *HV, *HG; const float* lb; const float* rs; const float* cs;
    __device__ __forceinline__ void operator()(const f32x4 (&acc)[2][2][4][2], const Unit& u, int wr, int wc, int fr, int fq) const {
        const int row0 = u.pm * BM + wr * 64 + fr, pn = u.pn;
        f32x4 cv[2][2];
#pragma unroll
        for (int bj = 0; bj < 2; ++bj)
#pragma unroll
            for (int n = 0; n < 2; ++n) cv[bj][n] = *(const f32x4*)(cs + pn * BM + bj * HALF + wc * 32 + 8 * fq + 4 * n);
#define PJ_A(ai, bj, m, n, sr) (__builtin_convertvector(__builtin_bit_cast(pg8_i32x4, acc[ai][bj][m][n]), f32x4) * (sr) * cv[bj][n])
        if (pn < 6) {
            bf16_t* base = pn < 4 ? QLAT : QIDX; const int ld = pn < 4 ? 1024 : 512; const int col0 = (pn < 4 ? pn : pn - 4) * BM + wc * 32 + 8 * fq;
#pragma unroll
            for (int ai = 0; ai < 2; ++ai)
#pragma unroll
                for (int m = 0; m < 4; ++m) { const int row = row0 + ai * HALF + m * 16; const float sr = rs[row]; bf16_t* rowp = base + (size_t)row * ld + col0;
#pragma unroll
                    for (int bj = 0; bj < 2; ++bj) *(u32x4*)(rowp + bj * HALF) = pack8(PJ_A(ai, bj, m, 0, sr), PJ_A(ai, bj, m, 1, sr)); }
        } else if (pn == 6) {
#pragma unroll
            for (int ai = 0; ai < 2; ++ai)
#pragma unroll
                for (int m = 0; m < 4; ++m) { const size_t r = (size_t)(row0 + ai * HALF + m * 16); const float sr = rs[r];
                    const f32x4 v0 = PJ_A(ai, 0, m, 0, sr), v1 = PJ_A(ai, 0, m, 1, sr);
                    *(u32x4*)(CKV + r * 128 + wc * 32 + 8 * fq) = pack8(v0, v1);
                    float ss = v0[0] * v0[0] + v0[1] * v0[1] + v0[2] * v0[2] + v0[3] * v0[3] + v1[0] * v1[0] + v1[1] * v1[1] + v1[2] * v1[2] + v1[3] * v1[3];
                    ss += __shfl_xor(ss, 16); ss += __shfl_xor(ss, 32);
                    if (fq == 0) SSQ[r * 4 + wc] = ss;
                    const f32x4 w0 = PJ_A(ai, 1, m, 0, sr), w1 = PJ_A(ai, 1, m, 1, sr);
                    if (wc < 2) *(u32x4*)(KIDX + r * 64 + wc * 32 + 8 * fq) = pack8(w0, w1);
                    else if (wc == 2 && fq == 0) { *(f32x4*)(WIDX + r * 8) = w0; *(f32x4*)(WIDX + r * 8 + 4) = w1; } }
        } else {
            const int h = pn - 7; const int e0 = (wc & 1) * 32 + 8 * fq;
            f32x4 l0 = {0.f, 0.f, 0.f, 0.f}, l1 = l0;
            if (wc >= 2) { l0 = *(const f32x4*)(lb + h * 64 + e0); l1 = *(const f32x4*)(lb + h * 64 + e0 + 4); }
#pragma unroll
            for (int ai = 0; ai < 2; ++ai)
#pragma unroll
                for (int m = 0; m < 4; ++m) { const int row = row0 + ai * HALF + m * 16; const float sr = rs[row]; const size_t o = (size_t)row * 512 + h * 64 + e0;
                    const f32x4 a0 = PJ_A(ai, 0, m, 0, sr), a1 = PJ_A(ai, 0, m, 1, sr), b0 = PJ_A(ai, 1, m, 0, sr), b1 = PJ_A(ai, 1, m, 1, sr);
                    if (wc < 2) {
                        *(u32x4*)(HQ + o) = pack8(silu4(a0), silu4(a1));
                        *(u32x4*)(HV + o) = pack8(b0, b1);
                    } else {
                        f32x4 f0, f1;
#pragma unroll
                        for (int j = 0; j < 4; ++j) { f0[j] = __builtin_amdgcn_logf(l0[j] + (1.f - l0[j]) * ep_sig(a0[j])); f1[j] = __builtin_amdgcn_logf(l1[j] + (1.f - l1[j]) * ep_sig(a1[j])); }
                        { u32x4 w; w.x = pk_f16(f0[0], f0[1]); w.y = pk_f16(f0[2], f0[3]); w.z = pk_f16(f1[0], f1[1]); w.w = pk_f16(f1[2], f1[3]); *(u32x4*)(HLF + o) = w; }
                        *(u32x4*)(HG + o) = pack8(silu4(b0), silu4(b1));
                    } }
        }
#undef PJ_A
    }
};
template <bool I8> __device__ __forceinline__ f32x4 mma_sel(const bf16x8& a, const bf16x8& b, const f32x4& c) {
    if constexpr (I8) return __builtin_bit_cast(f32x4, __builtin_amdgcn_mfma_i32_16x16x64_i8(__builtin_bit_cast(pg8_i32x4, a), __builtin_bit_cast(pg8_i32x4, b), __builtin_bit_cast(pg8_i32x4, c), 0, 0, 0));
    else return __builtin_amdgcn_mfma_f32_16x16x32_bf16(a, b, c, 0, 0, 0);
}
template <class Epi, class Sched, bool ALIGN_EPI = false, bool SP2 = false, bool I8 = false, int KSW = 0>
__device__ __forceinline__ void gemm_phase(PG8_LAS unsigned char* lds, const Gemm g, const Sched& S, const Epi& E) {
    const int tid = threadIdx.x, wid = __builtin_amdgcn_readfirstlane(tid >> 6), lane = tid & 63, wr = wid >> 2, wc = wid & 3, fr = lane & 15, fq = lane >> 4;
    const int K = g.K, nt = K / BK;
    unsigned voffA[2], voffB[2];
#pragma unroll
    for (int i = 0; i < 2; ++i) { int R, C; stage_rc(tid * 16 + i * 8192, R, C); const int Rb = Epi::PERM ? ((R & ~31) + perm32(R & 31)) : R;
        voffA[i] = (unsigned)(R * K + C) * 2u; voffB[i] = (unsigned)(Rb * K + C) * 2u; }
    const size_t kstep = (size_t)(BK * 2);
    const size_t hstep = (size_t)HALF * K * 2;
    const size_t tstep = 2 * hstep;
    const unsigned ldsw = (unsigned)wid * 1024u;
    const int aoff = lds_byte(wr * 64 + fr, fq * 8), boff = lds_byte(wc * 32 + fr, fq * 8);
#define PG8_SA(b, h) (((b) * 2 + (h)) * HTB)
#define PG8_SB(b, h) ((4 + (b) * 2 + (h)) * HTB)
#define PG8_STAGE(bufoff, gbase, voff) do { _Pragma("unroll") for (int _i = 0; _i < 2; ++_i) \
        __builtin_amdgcn_global_load_lds((const unsigned*)((const char*)(gbase) + (voff)[_i]), (PG8_LAS unsigned*)(lds + (bufoff) + ldsw + _i * 8192), 16, 0, 0); } while (0)
#define PG8_LDA(dst, b, h) do { _Pragma("unroll") for (int m = 0; m < 4; ++m) _Pragma("unroll") for (int k = 0; k < 2; ++k) dst[m][k] = *(const PG8_LAS bf16x8*)(lds + PG8_SA(b, h) + aoff + m * 2048 + k * 1024); } while (0)
#define PG8_LDB(dst, b, h) do { _Pragma("unroll") for (int n = 0; n < 2; ++n) _Pragma("unroll") for (int k = 0; k < 2; ++k) dst[n][k] = *(const PG8_LAS bf16x8*)(lds + PG8_SB(b, h) + boff + n * 2048 + k * 1024); } while (0)
#define PG8_MMA_LOOP(ai, bj, At, Bt, SEL) _Pragma("unroll") for (int m = 0; m < 4; ++m) _Pragma("unroll") for (int n = 0; n < 2; ++n) _Pragma("unroll") for (int k = 0; k < 2; ++k) \
        acc[ai][bj][m][n] = mma_sel<SEL>(Bt[n][k], At[m][k], acc[ai][bj][m][n]);
#define PG8_MMA(ai, bj, At, Bt) do { __builtin_amdgcn_s_setprio(1); \
        if constexpr (KSW > 0) { if (i8m) { PG8_MMA_LOOP(ai, bj, At, Bt, true) } else { PG8_MMA_LOOP(ai, bj, At, Bt, false) } } else { PG8_MMA_LOOP(ai, bj, At, Bt, I8) } \
        __builtin_amdgcn_s_setprio(0); } while (0)
#define PG8_WAIT_V(n) asm volatile("s_waitcnt vmcnt(" #n ")" ::: "memory")
#define PG8_WAIT_L(n) asm volatile("s_waitcnt lgkmcnt(" #n ")" ::: "memory")
#define PG8_BAR __builtin_amdgcn_s_barrier()
#define PG8_SCHED __builtin_amdgcn_sched_barrier(0)
    Unit cur, nxt; int ui = 0;
    if (!S.next(0, cur)) return;
    f32x4 acc[2][2][4][2];
#pragma unroll
    for (int a = 0; a < 2; ++a)
#pragma unroll
        for (int b = 0; b < 2; ++b)
#pragma unroll
            for (int m = 0; m < 4; ++m)
#pragma unroll
                for (int n = 0; n < 2; ++n) acc[a][b][m][n] = (f32x4){0.f, 0.f, 0.f, 0.f};
    bf16x8 At[4][2], B0[2][2], B1[2][2];
    const char* cA = (const char*)g.A + (size_t)cur.pm * tstep; const char* cB = (const char*)g.Bt + (size_t)cur.pn * tstep;
    S.a_ready(cur);
    if constexpr (SP2) {
        PG8_STAGE(PG8_SB(0, 0), cB, voffB); PG8_STAGE(PG8_SB(0, 1), cB + hstep, voffB); PG8_STAGE(PG8_SA(0, 0), cA, voffA); PG8_STAGE(PG8_SA(0, 1), cA + hstep, voffA);
        if (wr == 1) PG8_BAR;
        PG8_WAIT_V(2); PG8_BAR;
        PG8_STAGE(PG8_SB(1, 0), cB + kstep, voffB); PG8_STAGE(PG8_SA(1, 0), cA + kstep, voffA); PG8_STAGE(PG8_SB(1, 1), cB + hstep + kstep, voffB);
        PG8_WAIT_V(6); PG8_BAR;
    } else {
        PG8_STAGE(PG8_SB(0, 0), cB, voffB); PG8_STAGE(PG8_SA(0, 0), cA, voffA); PG8_STAGE(PG8_SB(0, 1), cB + hstep, voffB); PG8_STAGE(PG8_SA(0, 1), cA + hstep, voffA);
        if (wr == 1) PG8_BAR;
        PG8_WAIT_V(4); PG8_BAR;
        PG8_STAGE(PG8_SB(1, 0), cB + kstep, voffB); PG8_STAGE(PG8_SA(1, 0), cA + kstep, voffA); PG8_STAGE(PG8_SB(1, 1), cB + hstep + kstep, voffB);
        PG8_WAIT_V(6); PG8_BAR;
    }
    for (;;) {
        const bool has_next = S.next(ui + 1, nxt);
        const char* nA = has_next ? (const char*)g.A + (size_t)nxt.pm * tstep : cA; const char* nB = has_next ? (const char*)g.Bt + (size_t)nxt.pn * tstep : cB;
#pragma unroll
        for (int seg = 0; seg < (KSW > 0 ? 2 : 1); ++seg) {
        const bool i8m = (seg == 0); (void)i8m;
        if constexpr (KSW > 0) { if (seg == 1) E.to_float(acc, cur, wr, wc, fr, fq); }
        for (int t = (seg ? KSW : 0); t < ((KSW > 0 && seg == 0) ? KSW : nt); t += 2) {
            const bool last = (t == nt - 2);
            const char* a1 = cA + (size_t)(t + 1) * kstep;
            const char* a2 = last ? nA : cA + (size_t)(t + 2) * kstep; const char* b2 = last ? nB : cB + (size_t)(t + 2) * kstep;
            const char* a3 = a2 + kstep; const char* b3 = b2 + kstep;
            if (last && has_next) S.a_ready(nxt);
            if constexpr (SP2) {
            PG8_LDB(B0, 0, 0); PG8_LDB(B1, 0, 1); PG8_SCHED; PG8_LDA(At, 0, 0); PG8_STAGE(PG8_SA(1, 1), a1 + hstep, voffA);
            PG8_WAIT_V(8); PG8_WAIT_L(0); PG8_BAR; PG8_MMA(0, 0, At, B0); PG8_MMA(0, 1, At, B1); PG8_BAR; PG8_SCHED;
            PG8_LDA(At, 0, 1); PG8_STAGE(PG8_SB(0, 0), b2, voffB); PG8_STAGE(PG8_SB(0, 1), b2 + hstep, voffB); PG8_STAGE(PG8_SA(0, 0), a2, voffA);
            PG8_WAIT_V(8); PG8_WAIT_L(0); PG8_BAR; PG8_MMA(1, 0, At, B0); PG8_MMA(1, 1, At, B1); PG8_BAR; PG8_SCHED;
            PG8_LDB(B0, 1, 0); PG8_LDB(B1, 1, 1); PG8_SCHED; PG8_LDA(At, 1, 0); PG8_STAGE(PG8_SA(0, 1), a2 + hstep, voffA);
            PG8_WAIT_V(8); PG8_WAIT_L(0); PG8_BAR; PG8_MMA(0, 0, At, B0); PG8_MMA(0, 1, At, B1); PG8_BAR; PG8_SCHED;
            PG8_LDA(At, 1, 1); PG8_STAGE(PG8_SB(1, 0), b3, voffB); PG8_STAGE(PG8_SB(1, 1), b3 + hstep, voffB); PG8_STAGE(PG8_SA(1, 0), a3, voffA);
            PG8_WAIT_V(8); PG8_WAIT_L(0); PG8_BAR; PG8_MMA(1, 0, At, B0); PG8_MMA(1, 1, At, B1); PG8_BAR; PG8_SCHED;
            } else {
            PG8_LDB(B0, 0, 0); PG8_SCHED; PG8_LDA(At, 0, 0); PG8_STAGE(PG8_SA(1, 1), a1 + hstep, voffA);
            PG8_WAIT_L(8); PG8_BAR; PG8_WAIT_L(0); PG8_MMA(0, 0, At, B0); PG8_BAR; PG8_SCHED;
            PG8_LDB(B1, 0, 1); PG8_STAGE(PG8_SB(0, 0), b2, voffB);
            PG8_BAR; PG8_WAIT_L(0); PG8_MMA(0, 1, At, B1); PG8_BAR;
            PG8_LDA(At, 0, 1); PG8_STAGE(PG8_SA(0, 0), a2, voffA);
            PG8_BAR; PG8_WAIT_L(0); PG8_MMA(1, 0, At, B0); PG8_BAR; PG8_SCHED;
            PG8_STAGE(PG8_SB(0, 1), b2 + hstep, voffB);
            PG8_WAIT_V(6); PG8_BAR; PG8_MMA(1, 1, At, B1); PG8_BAR;
            PG8_LDB(B0, 1, 0); PG8_SCHED; PG8_LDA(At, 1, 0); PG8_STAGE(PG8_SA(0, 1), a2 + hstep, voffA);
            PG8_WAIT_L(8); PG8_BAR; PG8_WAIT_L(0); PG8_MMA(0, 0, At, B0); PG8_BAR; PG8_SCHED;
            PG8_LDB(B1, 1, 1); PG8_STAGE(PG8_SB(1, 0), b3, voffB);
            PG8_BAR; PG8_WAIT_L(0); PG8_MMA(0, 1, At, B1); PG8_BAR;
            PG8_LDA(At, 1, 1); PG8_STAGE(PG8_SA(1, 0), a3, voffA);
            PG8_BAR; PG8_WAIT_L(0); PG8_MMA(1, 0, At, B0); PG8_BAR; PG8_SCHED;
            PG8_STAGE(PG8_SB(1, 1), b3 + hstep, voffB);
            PG8_WAIT_V(6); PG8_BAR; PG8_MMA(1, 1, At, B1); PG8_BAR;
            }
        }
        }
        if constexpr (ALIGN_EPI) { if (wr == 0) PG8_BAR; }
        if constexpr (!Epi::AFTER_DRAIN) { E(acc, cur, wr, wc, fr, fq); S.done(cur); }
        if (!has_next) break;
#pragma unroll
        for (int a = 0; a < 2; ++a)
#pragma unroll
            for (int b = 0; b < 2; ++b)
#pragma unroll
                for (int m = 0; m < 4; ++m)
#pragma unroll
                    for (int n = 0; n < 2; ++n) acc[a][b][m][n] = (f32x4){0.f, 0.f, 0.f, 0.f};
        cur = nxt; cA = nA; cB = nB; ++ui;
        if constexpr (ALIGN_EPI) { if (wr == 1) PG8_BAR; }
    }
    PG8_WAIT_V(0);
    if constexpr (!ALIGN_EPI) { if (wr == 0) PG8_BAR; }
    PG8_BAR;
    if constexpr (Epi::AFTER_DRAIN) { E.fused(acc, cur, wr, wc, fr, fq, lds, wid, lane); S.done(cur); }
#undef PG8_SA
#undef PG8_SB
#undef PG8_STAGE
#undef PG8_LDA
#undef PG8_LDB
#undef PG8_MMA
#undef PG8_MMA_LOOP
#undef PG8_WAIT_V
#undef PG8_WAIT_L
#undef PG8_BAR
#undef PG8_SCHED
}
}

struct Args { const float* in[16]; float* out; unsigned char* ws; int ph_lo, ph_hi; };
enum { I_X = 0, I_WIN, I_KVG, I_WUK, I_WUV, I_LBL, I_HGN, I_WOUT, I_LN1G, I_LN1B, I_PWQ, I_PSK, I_PU, I_PV, I_LN2G, I_LN2B };

struct Ctx {
    LAS unsigned char* lds; int tid, lane, wave; int G, bid;
    const float* in[16]; float* out; unsigned char* ws;
};

template <class ColMap>
__device__ __forceinline__ void tr_tile(const Ctx& C, const float* src, int ld_src, int k0, int n0, const ColMap& cm, u16* dst, int ld_dst, int koff) {
    LAS float* T = (LAS float*)C.lds;
    const int nn = C.tid & 63, kq = C.tid >> 6;
    const int col = cm(n0 + nn);
#pragma unroll
    for (int i = 0; i < 8; ++i) { const int kk = kq + 8 * i; T[kk * 65 + nn] = col >= 0 ? src[(size_t)(k0 + kk) * ld_src + col] : 0.f; }
    __syncthreads();
    const int kk2 = C.tid & 63, nq = C.tid >> 6;
#pragma unroll
    for (int i = 0; i < 8; ++i) { const int n2 = nq + 8 * i; const float v = T[kk2 * 65 + n2];
        dst[(size_t)(n0 + n2) * ld_dst + koff + k0 + kk2] = (u16)(cvtpk(v, 0.f) & 0xffffu); }
    __syncthreads();
}

__device__ __forceinline__ int w1_col(int n) {
    if (n < 1536) return 640 + (n - 1024);
    if (n < 1792) { const int j = n - 1536; return j < 128 ? 512 + j : (j < 192 ? 1152 + (j - 128) : (j < 200 ? 1216 + (j - 192) : -1)); }
    const int j = n - 1792, h = j >> 8, part = (j & 255) >> 6, e = j & 63;
    return 1224 + part * 512 + h * 64 + e;
}

__device__ __forceinline__ void cvt_copy(const Ctx& C, const float* src, u16* dst, size_t n8) {
    const size_t stride = (size_t)C.G * NTHREADS;
    for (size_t i = (size_t)C.bid * NTHREADS + C.tid; i < n8; i += stride) {
        const f32x4v a = *(const f32x4v*)(src + i * 8), b = *(const f32x4v*)(src + i * 8 + 4);
        u32x4v w; w.x = cvtpk(a[0], a[1]); w.y = cvtpk(a[2], a[3]); w.z = cvtpk(b[0], b[1]); w.w = cvtpk(b[2], b[3]);
        *(u32x4v*)(dst + i * 8) = w;
    }
}

__device__ __forceinline__ void quant_rows_fp8(const Ctx& C, const float* src, unsigned char* dst, float* inv, int nrows) {
    const int lane = C.lane, gw = C.bid * 8 + C.wave, nw = C.G * 8;
    for (int r = gw; r < nrows; r += nw) {
        f32x4v v[4];
#pragma unroll
        for (int i = 0; i < 4; ++i) v[i] = *(const f32x4v*)(src + (size_t)r * 1024 + lane * 16 + 4 * i);
        float am = 0.f;
#pragma unroll
        for (int i = 0; i < 4; ++i) am = fmaxf(am, fmaxf(fmaxf(fabsf(v[i][0]), fabsf(v[i][1])), fmaxf(fabsf(v[i][2]), fabsf(v[i][3]))));
        am = wave_max_f(am);
        const int e = (int)((__builtin_bit_cast(unsigned, am) >> 23) & 0xffu) - 126;
        int k = 8 - e; k = k > 100 ? 100 : (k < -100 ? -100 : k); if (am == 0.f) k = 0;
        const float s = __builtin_bit_cast(float, (unsigned)(127 + k) << 23), si = __builtin_bit_cast(float, (unsigned)(127 - k) << 23);
        u32x4v w;
#pragma unroll
        for (int i = 0; i < 4; ++i) { int t = 0; t = __builtin_amdgcn_cvt_pk_fp8_f32(v[i][0] * s, v[i][1] * s, t, false); t = __builtin_amdgcn_cvt_pk_fp8_f32(v[i][2] * s, v[i][3] * s, t, true); w[i] = (unsigned)t; }
        *(u32x4v*)(dst + ((size_t)(lane >> 3) * nrows + r) * 128 + (lane & 7) * 16) = w;
        if (lane == 0) inv[r] = si;
    }
}

template <bool SLICED = true>
__device__ __forceinline__ void quant_rows_i8(const Ctx& C, const float* src, unsigned char* dst, float* inv, int nrows) {
    const int lane = C.lane, gw = C.bid * 8 + C.wave, nw = C.G * 8;
    f32x4v vn[4];
    if (gw < nrows) {
#pragma unroll
        for (int i = 0; i < 4; ++i) vn[i] = *(const f32x4v*)(src + (size_t)gw * 1024 + lane * 16 + 4 * i); }
    for (int r = gw; r < nrows; r += nw) {
        f32x4v v[4];
#pragma unroll
        for (int i = 0; i < 4; ++i) v[i] = vn[i];
        { const int rn = r + nw < nrows ? r + nw : r;
#pragma unroll
          for (int i = 0; i < 4; ++i) vn[i] = *(const f32x4v*)(src + (size_t)rn * 1024 + lane * 16 + 4 * i); }
        float am = 0.f;
#pragma unroll
        for (int i = 0; i < 4; ++i) am = fmaxf(am, fmaxf(fmaxf(fabsf(v[i][0]), fabsf(v[i][1])), fmaxf(fabsf(v[i][2]), fabsf(v[i][3]))));
        am = wave_max_f(am);
        const float s = am > 0.f ? 127.f / am : 0.f;
        u32x4v w;
#pragma unroll
        for (int i = 0; i < 4; ++i) w[i] = pack_i8(v[i][0] * s, v[i][1] * s, v[i][2] * s, v[i][3] * s);
        if constexpr (SLICED) *(u32x4v*)(dst + ((size_t)(lane >> 3) * nrows + r) * 128 + (lane & 7) * 16) = w;
        else *(u32x4v*)(dst + (size_t)r * 1024 + lane * 16) = w;
        if (lane == 0) inv[r] = am * (1.f / 127.f);
    }
}

__device__ __forceinline__ void quant_wrows_i8(const Ctx& C, const u16* src, unsigned char* dst, float* sc, int nrows) {
    const int lane = C.lane, gw = C.bid * 8 + C.wave, nw = C.G * 8;
    for (int r = gw; r < nrows; r += nw) {
        const u32x4v y0 = *(const u32x4v*)(src + (size_t)r * 1024 + lane * 16), y1 = *(const u32x4v*)(src + (size_t)r * 1024 + lane * 16 + 8);
        float v[16]; float am = 0.f;
#pragma unroll
        for (int j = 0; j < 4; ++j) { v[2 * j] = bf_lo(y0[j]); v[2 * j + 1] = bf_hi(y0[j]); v[8 + 2 * j] = bf_lo(y1[j]); v[8 + 2 * j + 1] = bf_hi(y1[j]); }
#pragma unroll
        for (int j = 0; j < 16; ++j) am = fmaxf(am, fabsf(v[j]));
        am = wave_max_f(am);
        const float s = am > 0.f ? 127.f / am : 0.f;
        u32x4v w;
#pragma unroll
        for (int i = 0; i < 4; ++i) w[i] = pack_i8(v[4 * i] * s, v[4 * i + 1] * s, v[4 * i + 2] * s, v[4 * i + 3] * s);
        *(u32x4v*)(dst + (size_t)r * 1024 + lane * 16) = w;
        if (lane == 0) sc[r] = am * (1.f / 127.f);
    }
}
__device__ __forceinline__ void quant_w3_mixed(const Ctx& C) {
    const u16* src = (const u16*)(C.ws + WS_W3T); unsigned char* dst = C.ws + WS_W3M; float* sc = (float*)(C.ws + WS_W3S);
    const int lane = C.lane, gw = C.bid * 8 + C.wave, nw = C.G * 8;
    for (int r = gw; r < DM; r += nw) {
        const u32x4v y0 = *(const u32x4v*)(src + (size_t)r * K3 + lane * 16), y1 = *(const u32x4v*)(src + (size_t)r * K3 + lane * 16 + 8);
        const u32x4v hb = *(const u32x4v*)(src + (size_t)r * K3 + 1024 + lane * 8);
        float v[16]; float am = 0.f;
#pragma unroll
        for (int j = 0; j < 4; ++j) { v[2 * j] = bf_lo(y0[j]); v[2 * j + 1] = bf_hi(y0[j]); v[8 + 2 * j] = bf_lo(y1[j]); v[8 + 2 * j + 1] = bf_hi(y1[j]); }
#pragma unroll
        for (int j = 0; j < 16; ++j) am = fmaxf(am, fabsf(v[j]));
        am = wave_max_f(am);
        if (am == 0.f) am = 127.f;
        const float s = 127.f / am;
        u32x4v w, hs;
#pragma unroll
        for (int i = 0; i < 4; ++i) { w[i] = pack_i8(v[4 * i] * s, v[4 * i + 1] * s, v[4 * i + 2] * s, v[4 * i + 3] * s); hs[i] = cvtpk(bf_lo(hb[i]) * s, bf_hi(hb[i]) * s); }
        *(u32x4v*)(dst + (size_t)r * MIXB + lane * 16) = w;
        *(u32x4v*)(dst + (size_t)r * MIXB + 1024 + lane * 16) = hs;
        if (lane == 0) sc[r] = am * (1.f / 127.f);
    }
}
__device__ __forceinline__ void p0b_quant(const Ctx& C) {
    quant_w3_mixed(C);
    quant_wrows_i8(C, (const u16*)(C.ws + WS_W5T), C.ws + WS_W5Q, (float*)(C.ws + WS_W5S), NPQ);
    quant_wrows_i8(C, (const u16*)(C.ws + WS_W1T), C.ws + WS_W1Q, (float*)(C.ws + WS_W1S), N1);
}

__device__ __forceinline__ void p0_prologue(const Ctx& C) {
    unsigned char* ws = C.ws;
    if (C.bid == 0 && C.tid < 64) ((unsigned*)(ws + WS_CTL))[C.tid] = 0u;
    if (C.bid == 0) {
        const float* l = C.in[I_LBL]; float* lb = (float*)(ws + WS_LB);
        const float a = l[C.tid], b = l[512 + C.tid]; lb[C.tid] = 1.f / (1.f + expf(b - a));
    }
    quant_rows_i8<false>(C, C.in[I_X], ws + WS_XB, (float*)(ws + WS_XS), MTOK);
    quant_rows_i8(C, C.in[I_PU], ws + WS_UB, (float*)(ws + WS_USC), 16384);
    quant_rows_i8(C, C.in[I_PV], ws + WS_VB, (float*)(ws + WS_VSC), 16384);
    cvt_copy(C, C.in[I_PSK], (u16*)(ws + WS_SKB), (size_t)8 * 2 * 128 * 128 / 8);
    const float* w_in = C.in[I_WIN]; const float* w_out = C.in[I_WOUT]; const float* wq = C.in[I_PWQ];
    const float* kvg = C.in[I_KVG]; const float* wuk = C.in[I_WUK]; const float* wuv = C.in[I_WUV];
    u16* W1T = (u16*)(ws + WS_W1T); u16* W3T = (u16*)(ws + WS_W3T); u16* W5T = (u16*)(ws + WS_W5T);
    constexpr int T_W1F = 256, T_W1P = 44 * 16, T_W3F = 256, T_W3P = 16 * 8, T_W5 = 32 * 16, T_ALL = T_W1F + T_W1P + T_W3F + T_W3P + T_W5;
    LAS float* TA = (LAS float*)C.lds;
    LAS float* TB = TA + 64 * 65;
    for (int task = C.bid; task < T_ALL; task += C.G) {
        int t = task;
        if (t < T_W1F) {
            const int h = t >> 5, cb = (t >> 4) & 1, kb = t & 15, c0 = cb * 64, k0 = kb * 64;
            { const int d = C.tid & 63, q = C.tid >> 6;
#pragma unroll
              for (int i = 0; i < 8; ++i) { const int r = q + 8 * i; TA[r * 65 + d] = w_in[(size_t)(k0 + r) * DIN + h * 64 + d]; TB[r * 65 + d] = wuk[(size_t)(h * 128 + c0 + r) * 64 + d]; } }
            __syncthreads();
            { const int kk = C.tid & 63, q = C.tid >> 6;
#pragma unroll
              for (int i = 0; i < 8; ++i) { const int cc = q + 8 * i; float s = 0.f;
#pragma unroll 8
                  for (int d = 0; d < 64; ++d) s += TA[kk * 65 + d] * TB[cc * 65 + d];
                  s *= kvg[c0 + cc] * 0.125f;
                  W1T[(size_t)(h * 128 + c0 + cc) * 1024 + k0 + kk] = (u16)(cvtpk(s, 0.f) & 0xffffu); } }
            __syncthreads();
            continue;
        }
        t -= T_W1F;
        if (t < T_W1P) { const int nb = t >> 4, kb = t & 15; tr_tile(C, w_in, DIN, kb * 64, 1024 + nb * 64, [](int n) { return w1_col(n); }, W1T, 1024, 0); continue; }
        t -= T_W1P;
        if (t < T_W3F) {
            const int h = t >> 5, cb = (t >> 4) & 1, nb = t & 15, c0 = cb * 64, n0 = nb * 64;
            { const int x = C.tid & 63, q = C.tid >> 6;
#pragma unroll
              for (int i = 0; i < 8; ++i) { const int r = q + 8 * i; TA[r * 65 + x] = w_out[(size_t)(h * 64 + r) * 1024 + n0 + x]; TB[r * 65 + x] = wuv[(size_t)(h * 128 + c0 + r) * 64 + x]; } }
            __syncthreads();
            { const int cc = C.tid & 63, q = C.tid >> 6;
#pragma unroll
              for (int i = 0; i < 8; ++i) { const int nn = q + 8 * i; float s = 0.f;
#pragma unroll 8
                  for (int d = 0; d < 64; ++d) s += TB[cc * 65 + d] * TA[d * 65 + nn];
                  s *= kvg[c0 + cc];
                  W3T[(size_t)(n0 + nn) * K3 + h * 128 + c0 + cc] = (u16)(cvtpk(s, 0.f) & 0xffffu); } }
            __syncthreads();
            continue;
        }
        t -= T_W3F;
        if (t < T_W3P) { const int nb = t >> 3, kb = t & 7; tr_tile(C, w_out + (size_t)512 * 1024, 1024, kb * 64, nb * 64, [](int n) { return n; }, W3T, K3, 1024); continue; }
        t -= T_W3P;
        { const int nb = t >> 4, kb = t & 15; tr_tile(C, wq, NPQ, kb * 64, nb * 64, [](int n) { return n; }, W5T, 1024, 0); }
    }
}

#ifndef MK_CUSTOM_BAR
#define MK_CUSTOM_BAR 0
#endif
__device__ __forceinline__ void grid_bar(const Ctx& C, unsigned& target, int word = 24) {
    __syncthreads();
    if (C.tid == 0) {
        unsigned* ctr = (unsigned*)(C.ws + WS_CTL) + word;
        __builtin_amdgcn_fence(__ATOMIC_RELEASE, "agent");
        asm volatile("s_waitcnt vmcnt(0)" ::: "memory");
        __hip_atomic_fetch_add(ctr, 1u, __ATOMIC_RELAXED, __HIP_MEMORY_SCOPE_AGENT);
        target += (unsigned)C.G;
        for (unsigned spin = 0; spin < (1u << 24); ++spin) { if (__hip_atomic_load(ctr, __ATOMIC_RELAXED, __HIP_MEMORY_SCOPE_AGENT) >= target) break; __builtin_amdgcn_s_sleep(1); }
        __builtin_amdgcn_fence(__ATOMIC_ACQUIRE, "agent");
        asm volatile("s_waitcnt vmcnt(0)" ::: "memory");
    }
    __syncthreads();
}


__device__ __forceinline__ f32x4v mfma16(s16x8 a, s16x8 b, f32x4v c) { return __builtin_amdgcn_mfma_f32_16x16x32_bf16(a, b, c, 0, 0, 0); }
__device__ __forceinline__ f32x16v mfma32(s16x8 a, s16x8 b, f32x16v c) { return __builtin_amdgcn_mfma_f32_32x32x16_bf16(a, b, c, 0, 0, 0); }
__device__ __forceinline__ s16x4 tr4(const LAS u16* p) { return __builtin_bit_cast(s16x4, __builtin_amdgcn_ds_read_tr16_b64_v4i16((LAS s16x4*)p)); }
__device__ __forceinline__ s16x8 cat4(s16x4 a, s16x4 b) { s16x8 r; r[0] = a[0]; r[1] = a[1]; r[2] = a[2]; r[3] = a[3]; r[4] = b[0]; r[5] = b[1]; r[6] = b[2]; r[7] = b[3]; return r; }
__device__ __forceinline__ s16x8 pack8f(const f32x4v& a, const f32x4v& b) { u32x4v w; w.x = cvtpk(a[0], a[1]); w.y = cvtpk(a[2], a[3]); w.z = cvtpk(b[0], b[1]); w.w = cvtpk(b[2], b[3]); return __builtin_bit_cast(s16x8, w); }

__device__ __forceinline__ float scan32_incl(float v) {
    v += __builtin_bit_cast(float, __builtin_amdgcn_update_dpp(0, __builtin_bit_cast(int, v), 0x111, 0xf, 0xf, true));
    v += __builtin_bit_cast(float, __builtin_amdgcn_update_dpp(0, __builtin_bit_cast(int, v), 0x112, 0xf, 0xf, true));
    v += __builtin_bit_cast(float, __builtin_amdgcn_update_dpp(0, __builtin_bit_cast(int, v), 0x114, 0xf, 0xf, true));
    v += __builtin_bit_cast(float, __builtin_amdgcn_update_dpp(0, __builtin_bit_cast(int, v), 0x118, 0xf, 0xf, true));
    v += __builtin_bit_cast(float, __builtin_amdgcn_update_dpp(0, __builtin_bit_cast(int, v), 0x142, 0xa, 0xf, false));
    return v;
}
constexpr int HG_SET = 16640, HG_OI = 2 * HG_SET, HG_SSQ = HG_OI + 2 * 8192;

__device__ __forceinline__ void hgrn_seq(const Ctx& C, int bh) {
    const int b = bh >> 3, h = bh & 7;
    const int tid = C.tid, lane = C.lane, wave = C.wave, fr = lane & 15, fq = lane >> 4;
    unsigned char* ws = C.ws;
    const u16* HQ = (const u16*)(ws + WS_HQ); const u16* HLF = (const u16*)(ws + WS_HLF); const u16* HV = (const u16*)(ws + WS_HV); const u16* HG = (const u16*)(ws + WS_HG);
    u16* MIX = (u16*)(ws + WS_MIX);
    const size_t rowbase = (size_t)b * SEQ;
    constexpr int NCH = SEQ / 32;
    LAS float* SSQ = (LAS float*)(C.lds + HG_SSQ);
    if (wave >= 4) {
        const int t = lane & 31, cg = (tid - 256) >> 5;
        f32x4v gn0 = *(const f32x4v*)(C.in[I_HGN] + 8 * cg), gn1 = *(const f32x4v*)(C.in[I_HGN] + 8 * cg + 4);
        u32x4v lfh[4]  ; u32x4v qv[4], vv[4], gg[4]; u32x4v gp1 = {0u, 0u, 0u, 0u}, gp2 = gp1;
#define HG_LOAD(k_, n_) do { const int nc_ = (n_) < NCH ? (n_) : NCH - 1; const size_t o_ = (rowbase + (size_t)nc_ * 32 + t) * 512 + h * 64 + 8 * cg; lfh[k_] = *(const u32x4v*)(HLF + o_); \
            qv[k_] = *(const u32x4v*)(HQ + o_); vv[k_] = *(const u32x4v*)(HV + o_); gg[k_] = *(const u32x4v*)(HG + o_); } while (0)
        HG_LOAD(0, 0); HG_LOAD(1, 1); HG_LOAD(2, 2); HG_LOAD(3, 3);
#define S_BODY(n, k) { \
              \
            if ((n) >= 1) { \
                const LAS float* OI = (const LAS float*)(C.lds + HG_OI) + (((n) - 1) & 1) * 2048; \
                const LAS float* sq = SSQ + (((n) - 1) & 1) * 128; \
                const float rstd = __builtin_amdgcn_rsqf(((sq[t] + sq[32 + t]) + (sq[64 + t] + sq[96 + t])) * (1.f / 64.f) + EPS); \
                float o[8]; \
                _Pragma("unroll") for (int j = 0; j < 8; ++j) o[j] = OI[(8 * cg + j) * 32 + t] * rstd; \
                u32x4v w; \
                w.x = cvtpk(o[0] * gn0[0] * bf_lo(gp2.x), o[1] * gn0[1] * bf_hi(gp2.x)); w.y = cvtpk(o[2] * gn0[2] * bf_lo(gp2.y), o[3] * gn0[3] * bf_hi(gp2.y)); \
                w.z = cvtpk(o[4] * gn1[0] * bf_lo(gp2.z), o[5] * gn1[1] * bf_hi(gp2.z)); w.w = cvtpk(o[6] * gn1[2] * bf_lo(gp2.w), o[7] * gn1[3] * bf_hi(gp2.w)); \
                *(u32x4v*)(MIX + (rowbase + (size_t)((n) - 1) * 32 + t) * (MIXB / 2) + 512 + h * 64 + 8 * cg) = w;     \
            } \
              \
            if ((n) + 1 < NCH) { \
                LAS unsigned char* S_ = C.lds + (((n) + 1) & 1) * HG_SET; \
                LAS u16* QT = (LAS u16*)S_; LAS u16* KT = QT + 2048; LAS u16* KDT = KT + 2048; LAS u16* VS = KDT + 2048; LAS float* DEC = (LAS float*)(VS + 2048); \
                float lf[8], qf[8]; \
                _Pragma("unroll") for (int j = 0; j < 4; ++j) { const unsigned w_ = lfh[k][j]; lf[2 * j] = (float)__builtin_bit_cast(_Float16, (unsigned short)(w_ & 0xffffu)); lf[2 * j + 1] = (float)__builtin_bit_cast(_Float16, (unsigned short)(w_ >> 16)); \
                    qf[2 * j] = bf_lo(qv[k][j]); qf[2 * j + 1] = bf_hi(qv[k][j]); } \
                float qt[8], kt[8], kd[8], dc[8]; \
                _Pragma("unroll") for (int j = 0; j < 8; ++j) { \
                    const float bcum = scan32_incl(lf[j]); \
                    const float bl31 = __builtin_bit_cast(float, __builtin_amdgcn_readlane(__builtin_bit_cast(int, bcum), 31)), bl63 = __builtin_bit_cast(float, __builtin_amdgcn_readlane(__builtin_bit_cast(int, bcum), 63)); \
                    const float bl = lane < 32 ? bl31 : bl63; \
                    const float kk = 1.f - __builtin_amdgcn_exp2f(lf[j]);                      \
                    qt[j] = qf[j] * __builtin_amdgcn_exp2f(bcum); kt[j] = kk * __builtin_amdgcn_exp2f(-bcum); kd[j] = kk * __builtin_amdgcn_exp2f(bl - bcum); dc[j] = __builtin_amdgcn_exp2f(bl); \
                } \
                { u32x4v w; w.x = cvtpk(qt[0], qt[1]); w.y = cvtpk(qt[2], qt[3]); w.z = cvtpk(qt[4], qt[5]); w.w = cvtpk(qt[6], qt[7]); *(LAS u32x4v*)(QT + t * 64 + 8 * cg) = w; \
                  w.x = cvtpk(kt[0], kt[1]); w.y = cvtpk(kt[2], kt[3]); w.z = cvtpk(kt[4], kt[5]); w.w = cvtpk(kt[6], kt[7]); *(LAS u32x4v*)(KT + t * 64 + 8 * cg) = w; \
                  *(LAS u32x4v*)(VS + t * 64 + 8 * cg) = vv[k]; \
                  _Pragma("unroll") for (int j = 0; j < 8; ++j) KDT[(8 * cg + j) * 32 + t] = (u16)(cvtpk(kd[j], 0.f) & 0xffffu); \
                  if (t == 0) { *(LAS f32x4v*)(DEC + 8 * cg) = (f32x4v){dc[0], dc[1], dc[2], dc[3]}; *(LAS f32x4v*)(DEC + 8 * cg + 4) = (f32x4v){dc[4], dc[5], dc[6], dc[7]}; } } \
                gp2 = gp1; gp1 = gg[k]; \
            } else { gp2 = gp1; } \
            HG_LOAD(k, (n) + 5);                                             \
            __syncthreads(); }
        for (int n0 = -1; ; n0 += 4) {
            S_BODY(n0, 0) S_BODY(n0 + 1, 1)
            if (n0 + 1 >= NCH) break;
            S_BODY(n0 + 2, 2) S_BODY(n0 + 3, 3)
        }
#undef S_BODY
#undef HG_LOAD
    } else {
        const int et = wave;
        f32x4v Sst[4];
#pragma unroll
        for (int i = 0; i < 4; ++i) Sst[i] = (f32x4v){0.f, 0.f, 0.f, 0.f};
        const int q = (lane & 15) >> 2, p = lane & 3;
        for (int n = -1; n <= NCH; ++n) {
            if (n >= 0 && n < NCH) {
                LAS unsigned char* S_ = C.lds + (n & 1) * HG_SET;
                const LAS u16* QT = (const LAS u16*)S_; const LAS u16* KT = QT + 2048; const LAS u16* KDT = KT + 2048; const LAS u16* VS = KDT + 2048; const LAS float* DEC = (const LAS float*)(VS + 2048);
                LAS float* OI = (LAS float*)(C.lds + HG_OI) + (n & 1) * 2048;
                f32x4v oi[2] = {{0.f, 0.f, 0.f, 0.f}, {0.f, 0.f, 0.f, 0.f}};
#pragma unroll
                for (int ks = 0; ks < 2; ++ks) {
                    const s16x8 sa = pack8f(Sst[2 * ks], Sst[2 * ks + 1]);
#pragma unroll
                    for (int tt = 0; tt < 2; ++tt) {
                        const s16x4 lo = *(const LAS s16x4*)(QT + (16 * tt + fr) * 64 + 32 * ks + 4 * fq), hi = *(const LAS s16x4*)(QT + (16 * tt + fr) * 64 + 32 * ks + 16 + 4 * fq);
                        oi[tt] = mfma16(sa, cat4(lo, hi), oi[tt]);
                    }
                }
                f32x4v a00 = {0.f, 0.f, 0.f, 0.f}, a10 = a00, a11 = a00;
#pragma unroll
                for (int ks = 0; ks < 2; ++ks) {
                    const s16x8 k0 = *(const LAS s16x8*)(KT + fr * 64 + 32 * ks + 8 * fq), k1 = *(const LAS s16x8*)(KT + (16 + fr) * 64 + 32 * ks + 8 * fq);
                    const s16x8 q0 = *(const LAS s16x8*)(QT + fr * 64 + 32 * ks + 8 * fq), q1 = *(const LAS s16x8*)(QT + (16 + fr) * 64 + 32 * ks + 8 * fq);
                    a00 = mfma16(k0, q0, a00); a10 = mfma16(k0, q1, a10); a11 = mfma16(k1, q1, a11);
                }
#pragma unroll
                for (int i = 0; i < 4; ++i) { const bool keep = (4 * fq + i) <= fr; a00[i] = keep ? a00[i] : 0.f; a11[i] = keep ? a11[i] : 0.f; }
                const f32x4v z = {0.f, 0.f, 0.f, 0.f};
                const s16x8 pb0 = pack8f(a00, z), pb1 = pack8f(a10, a11);
                const s16x8 va = cat4(tr4(VS + (4 * fq + q) * 64 + 16 * et + 4 * p), tr4(VS + (16 + 4 * fq + q) * 64 + 16 * et + 4 * p));
                oi[0] = mfma16(va, pb0, oi[0]); oi[1] = mfma16(va, pb1, oi[1]);
                const s16x8 vb = cat4(tr4(VS + (8 * fq + q) * 64 + 16 * et + 4 * p), tr4(VS + (8 * fq + 4 + q) * 64 + 16 * et + 4 * p));
#pragma unroll
                for (int dt = 0; dt < 4; ++dt) {
                    const s16x8 ka = *(const LAS s16x8*)(KDT + (16 * dt + fr) * 32 + 8 * fq);
                    const f32x4v ds = mfma16(ka, vb, z);
                    const f32x4v dc = *(const LAS f32x4v*)(DEC + 16 * dt + 4 * fq);
                    Sst[dt] = Sst[dt] * dc + ds;
                }
                LAS float* sq = SSQ + (n & 1) * 128 + et * 32;
#pragma unroll
                for (int tt = 0; tt < 2; ++tt) { float s = 0.f;
#pragma unroll
                    for (int i = 0; i < 4; ++i) { OI[(16 * et + 4 * fq + i) * 32 + 16 * tt + fr] = oi[tt][i]; s += oi[tt][i] * oi[tt][i]; }
                    s += __shfl_xor(s, 16); s += __shfl_xor(s, 32);
                    if (fq == 0) sq[16 * tt + fr] = s; }
            }
            __syncthreads();
        }
    }
    __syncthreads();
}

constexpr int DSA_SC = 0, DSA_H1 = 131072, DSA_IDX = 139264, DSA_KST = 143360, DSA_ITEM = 159744;
__device__ __forceinline__ unsigned off_b(unsigned row, unsigned ch) { return 256u * row + 16u * (ch ^ (((row & 3) << 2) | ((row >> 2) & 3))); }
__device__ __forceinline__ unsigned mono16(unsigned h) { return (h & 0x8000u) ? (~h & 0xffffu) : (h | 0x8000u); }

__device__ __forceinline__ int wave_incl_scan_dpp(int v) {
    v += __builtin_amdgcn_update_dpp(0, v, 0x111, 0xf, 0xf, true);
    v += __builtin_amdgcn_update_dpp(0, v, 0x112, 0xf, 0xf, true);
    v += __builtin_amdgcn_update_dpp(0, v, 0x114, 0xf, 0xf, true);
    v += __builtin_amdgcn_update_dpp(0, v, 0x118, 0xf, 0xf, true);
    v += __builtin_amdgcn_update_dpp(0, v, 0x142, 0xa, 0xf, false);
    v += __builtin_amdgcn_update_dpp(0, v, 0x143, 0xc, 0xf, false);
    return v;
}
__device__ __forceinline__ void find_bin(const LAS unsigned* hist, int lane, int target, int& B, int& above) {
    const u32x4v c = *(const LAS u32x4v*)(hist + 4 * lane);
    const int tot = (int)(c.x + c.y + c.z + c.w);
    const int pre = wave_incl_scan_dpp(tot);
    const int all = __builtin_amdgcn_readlane(pre, 63);
    const int suf = all - pre + tot;
    const int ab = suf - tot;
    const bool here = (ab < target) && (suf >= target);
    int b = -1, a = 0;
    if (here) {
        int cum = ab;
        if (cum + (int)c.w >= target) { b = 4 * lane + 3; a = cum; }
        else { cum += (int)c.w;
            if (cum + (int)c.z >= target) { b = 4 * lane + 2; a = cum; }
            else { cum += (int)c.z;
                if (cum + (int)c.y >= target) { b = 4 * lane + 1; a = cum; }
                else { cum += (int)c.y; b = 4 * lane; a = cum; } } }
    }
    const unsigned long long m = __ballot(here);
    const int src = m ? (int)__builtin_ctzll(m) : 0;
    B = __shfl(b, src); above = __shfl(a, src);
}

__device__ __forceinline__ int wave_incl_scan(int v, int lane) {
#pragma unroll
    for (int d = 1; d < 64; d <<= 1) { const int o = __shfl_up(v, d); if (lane >= d) v += o; }
    return v;
}

typedef short s16x2v __attribute__((ext_vector_type(2)));
__device__ __forceinline__ unsigned relu_pk_bf16(unsigned x) { return __builtin_bit_cast(unsigned, __builtin_elementwise_max(__builtin_bit_cast(s16x2v, x), (s16x2v){0, 0})); }

struct APre { s16x8 Aop[4][2]; f32x4v w0[2], w1[2]; u32x4v g[2][2]; };
__device__ __forceinline__ void dsa_pre(const Ctx& C, int b, int qt, APre& P) {
    const int lane = C.lane, wave = C.wave, fr = lane & 15, fq = lane >> 4;
    unsigned char* ws = C.ws;
    const u16* QIDX = (const u16*)(ws + WS_QIDX); const u16* KIDX = (const u16*)(ws + WS_KIDX); const float* WIDX = (const float*)(ws + WS_WIDX);
    const size_t tb = (size_t)b * SEQ; const int q0 = qt * 8, nt16 = (q0 + 8 + 15) >> 4;
#pragma unroll
    for (int m = 0; m < 4; ++m) { const u16* p = QIDX + (tb + q0 + 4 * (m >> 1) + (fr >> 2)) * 512 + (4 * (m & 1) + (fr & 3)) * 64 + 8 * fq;
#pragma unroll
        for (int ks = 0; ks < 2; ++ks) P.Aop[m][ks] = *(const s16x8*)(p + 32 * ks); }
#pragma unroll
    for (int qq = 0; qq < 2; ++qq) { const float* wp = WIDX + (tb + q0 + 4 * qq + fq) * 8; P.w0[qq] = *(const f32x4v*)wp; P.w1[qq] = *(const f32x4v*)(wp + 4); }
    const int lrow = lane >> 3, lpc = lane & 7;
    const u16* kbase = KIDX + (tb + lrow) * 64 + lpc * 8;
#pragma unroll
    for (int j = 0; j < 2; ++j) { const int t_ = wave + 8 * j < nt16 ? wave + 8 * j : (wave < nt16 ? wave : 0);
        P.g[j][0] = *(const u32x4v*)(kbase + (size_t)t_ * 1024); P.g[j][1] = *(const u32x4v*)(kbase + (size_t)t_ * 1024 + 512); }
}

__device__ __forceinline__ int dsa_item(const Ctx& C, int b, int qt, APre& P, int nxt) {
    const int tid = C.tid, lane = C.lane, wave = C.wave;
    unsigned char* ws = C.ws;
    const u16* QLAT = (const u16*)(ws + WS_QLAT); const u16* QIDX = (const u16*)(ws + WS_QIDX); const u16* CKV = (const u16*)(ws + WS_CKV); const u16* KIDX = (const u16*)(ws + WS_KIDX);
    const float* WIDX = (const float*)(ws + WS_WIDX); const float* SSQ = (const float*)(ws + WS_SSQ); u16* MIX = (u16*)(ws + WS_MIX);
    LAS _Float16* SC = (LAS _Float16*)(C.lds + DSA_SC); LAS u16* SCK = (LAS u16*)(C.lds + DSA_SC);
    LAS unsigned* H1 = (LAS unsigned*)(C.lds + DSA_H1);
    const size_t tb = (size_t)b * SEQ; const int q0 = qt * 8;
    { constexpr int repA = 0;
        const int fr = lane & 15, fq = lane >> 4;
        s16x8 Aop[4][2]; s16x8 Wop[2];
#pragma unroll
        for (int m = 0; m < 4; ++m) { Aop[m][0] = P.Aop[m][0]; Aop[m][1] = P.Aop[m][1]; }
#pragma unroll
        for (int qq = 0; qq < 2; ++qq) { const f32x4v w0 = P.w0[qq], w1 = P.w1[qq];
            const f32x4v zz = {0.f, 0.f, 0.f, 0.f}; const bool own = fr == 4 * fq + qq;
            Wop[qq] = pack8f(own ? w0 : zz, own ? w1 : zz); }
        const int nt16 = (q0 + 8 + 15) >> 4;
        LAS unsigned char* KST = C.lds + DSA_KST + wave * 2048;
        const int lrow = lane >> 3, lpc = lane & 7;
        const u16* kbase = KIDX + (tb + lrow) * 64 + lpc * 8;
        const unsigned wo0 = (unsigned)(lrow * 128 + ((lpc ^ (lrow & 7)) * 16)), wo1 = wo0 + 1024u;
        const unsigned ro0 = (unsigned)(fr * 128 + ((fq ^ (fr & 7)) * 16)), ro1 = (unsigned)(fr * 128 + (((4 + fq) ^ (fr & 7)) * 16));
        u32x4v g0a, g0b, g1a, g1b;
#define A_GLOAD(da, db, kt_) do { da = *(const u32x4v*)(kbase + (size_t)(kt_) * 1024); db = *(const u32x4v*)(kbase + (size_t)(kt_) * 1024 + 512); } while (0)
#define A_STAGE(da, db, B0_, B1_) do { *(LAS u32x4v*)(KST + wo0) = da; *(LAS u32x4v*)(KST + wo1) = db; LDS_FENCE(); B0_ = *(const LAS s16x8*)(KST + ro0); B1_ = *(const LAS s16x8*)(KST + ro1); } while (0)
#define A_MMA(acc_, B0_, B1_) do { _Pragma("unroll") for (int m = 0; m < 4; ++m) { acc_[m] = mfma16(Aop[m][0], B0_, (f32x4v){0.f, 0.f, 0.f, 0.f}); acc_[m] = mfma16(Aop[m][1], B1_, acc_[m]); } } while (0)
#define A_EPI1(acc_, d0_, d1_) do { if (((MK_REPEAT >> 17) & 1) && repA) { d0_ = acc_[0] + acc_[1] + acc_[2] + acc_[3]; break; } u32x4v pa_, pb_;                      \
            pa_.x = relu_pk_bf16(cvtpk(acc_[0][0], acc_[0][1])); pa_.y = relu_pk_bf16(cvtpk(acc_[0][2], acc_[0][3])); pa_.z = relu_pk_bf16(cvtpk(acc_[1][0], acc_[1][1])); pa_.w = relu_pk_bf16(cvtpk(acc_[1][2], acc_[1][3])); \
            pb_.x = relu_pk_bf16(cvtpk(acc_[2][0], acc_[2][1])); pb_.y = relu_pk_bf16(cvtpk(acc_[2][2], acc_[2][3])); pb_.z = relu_pk_bf16(cvtpk(acc_[3][0], acc_[3][1])); pb_.w = relu_pk_bf16(cvtpk(acc_[3][2], acc_[3][3])); \
            d0_ = mfma16(Wop[0], __builtin_bit_cast(s16x8, pa_), (f32x4v){0.f, 0.f, 0.f, 0.f}); \
            d0_ = mfma16(Wop[1], __builtin_bit_cast(s16x8, pb_), d0_); } while (0)
#define A_EPI2(d0_, d1_, kt_) do { if (((MK_REPEAT >> 16) & 1) && repA) { dummyA += d0_[0] + d0_[1]; break; } const int kpos = (kt_) * 16 + fr;     \
            const unsigned hh_ = __builtin_bit_cast(unsigned, __builtin_amdgcn_cvt_pkrtz(d0_[0], d0_[1])); \
            const unsigned kk_ = hh_ ^ (__builtin_bit_cast(unsigned, __builtin_bit_cast(s16x2v, hh_) >> 15) | 0x80008000u);      \
            SCK[fq * 8192 + kpos] = (u16)kk_; SCK[(4 + fq) * 8192 + kpos] = (u16)(kk_ >> 16); \
            if (repA == 0) { if (kpos <= q0 + fq) atomicAdd((unsigned*)(H1 + fq * 256 + ((kk_ >> 8) & 0xffu)), 1u); if (kpos <= q0 + 4 + fq) atomicAdd((unsigned*)(H1 + (4 + fq) * 256 + (kk_ >> 24)), 1u); } } while (0)
        float dummyA = 0.f;
#define A_WRITE(da, db) do { *(LAS u32x4v*)(KST + wo0) = da; *(LAS u32x4v*)(KST + wo1) = db; } while (0)
#define A_READ(B0_, B1_) do { LDS_FENCE(); B0_ = *(const LAS s16x8*)(KST + ro0); B1_ = *(const LAS s16x8*)(KST + ro1); } while (0)
        if (wave < nt16) {
            s16x8 bc0, bc1, bn0, bn1; f32x4v accA[4], accB[4], hd; u32x4v g2a, g2b, g3a, g3b;
#define A_TCL(t_) ((t_) < nt16 ? (t_) : wave)
            g0a = P.g[0][0]; g0b = P.g[0][1]; g1a = P.g[1][0]; g1b = P.g[1][1];
            A_GLOAD(g2a, g2b, A_TCL(wave + 16)); A_GLOAD(g3a, g3b, A_TCL(wave + 24));
            A_WRITE(g0a, g0b); A_READ(bc0, bc1);
            A_MMA(accA, bc0, bc1);
            A_GLOAD(g0a, g0b, A_TCL(wave + 32));
            A_WRITE(g1a, g1b); A_GLOAD(g1a, g1b, A_TCL(wave + 40));
            int kt = wave;
#define A_STEP(aX, aY, bx0, bx1, ga, gb) { A_READ(bx0, bx1); A_EPI1(aX, hd, hd); A_MMA(aY, bx0, bx1); A_EPI2(hd, hd, kt); if (kt + 8 >= nt16) break; \
                A_WRITE(ga, gb); A_GLOAD(ga, gb, (kt + 48 < nt16 ? kt + 48 : kt)); kt += 8; }
            for (;;) {
                A_STEP(accA, accB, bn0, bn1, g2a, g2b)
                A_STEP(accB, accA, bc0, bc1, g3a, g3b)
                A_STEP(accA, accB, bn0, bn1, g0a, g0b)
                A_STEP(accB, accA, bc0, bc1, g1a, g1b)
            }
#undef A_STEP
#undef A_TCL
        }
#undef A_WRITE
#undef A_READ
        if (dummyA == 12345.678f) SC[0] = (_Float16)0.f;
#undef A_GLOAD
#undef A_STAGE
#undef A_MMA
#undef A_EPI1
#undef A_EPI2
    }
    LAS int* itemw2 = (LAS int*)(C.lds + DSA_ITEM) + 1;
    if (tid == 0) *itemw2 = nxt;
    __syncthreads();
    const int nx = __builtin_amdgcn_readfirstlane(*itemw2);
    const int tq = q0 + wave, nk = tq + 1;
    LAS unsigned* h1 = H1 + wave * 256;
    LAS unsigned* hist = h1;
    LAS u16* idx = (LAS u16*)(C.lds + DSA_IDX) + wave * 256;
    LAS float* rsel = (LAS float*)(C.lds + DSA_KST + wave * 2048);
    const LAS u16* scq = (const LAS u16*)(C.lds + DSA_SC) + wave * 8192;
    s16x8 Bq[4];
    { const int fr = lane & 15, fq = lane >> 4;
#pragma unroll
      for (int ks = 0; ks < 4; ++ks) { Bq[ks] = (s16x8){0, 0, 0, 0, 0, 0, 0, 0}; if (fr < 8) Bq[ks] = *(const s16x8*)(QLAT + (tb + tq) * 1024 + fr * 128 + 32 * ks + 8 * fq); } }
    int cnt;
    const int frC = lane & 15, fqC = lane >> 4;
    const u16* ckb = CKV + tb * 128 + frC * 8;
    u32x4v gbuf[8]; f32x4v q4e = {0.f, 0.f, 0.f, 0.f}; bool early = false;
#define C_ISSUE(ch_) do { int kk_[8]; _Pragma("unroll") for (int i = 0; i < 8; ++i) { const int s_ = (ch_) * 32 + 4 * i + fqC; kk_[i] = (int)idx[s_ < cnt ? s_ : cnt - 1]; }     \
            _Pragma("unroll") for (int i = 0; i < 8; ++i) gbuf[i] = *(const u32x4v*)(ckb + (size_t)kk_[i] * 128); } while (0)
#define C_EARLY() do { LDS_FENCE(); C_ISSUE(0); q4e = *(const f32x4v*)(SSQ + (tb + idx[lane < cnt ? lane : cnt - 1]) * 4); } while (0)
    u32x4v h1save = (u32x4v){0u, 0u, 0u, 0u};
    if ((MK_REPEAT >> 9) & 1) h1save = *(const LAS u32x4v*)(h1 + 4 * lane);
    for (int repB = 0; repB < (((MK_REPEAT >> 9) & 1) ? 2 : 1); ++repB) { LDS_FENCE();
    if (repB) { *(LAS u32x4v*)(h1 + 4 * lane) = h1save; LDS_FENCE(); }
    if (nk <= TOPK) {
        cnt = nk;
#pragma unroll
        for (int i = 0; i < 4; ++i) idx[lane + 64 * i] = (u16)(lane + 64 * i);
    } else {
        cnt = TOPK;
        const int nit = (nk + 511) >> 9;
        int B1, above1; find_bin(h1, lane, TOPK, B1, above1);
        LDS_FENCE();
        *(LAS u32x4v*)(hist + 4 * lane) = (u32x4v){0u, 0u, 0u, 0u};
        LDS_FENCE();
#pragma unroll 2
        for (int it = 0; it < nit; ++it) { const int base = it * 512 + lane * 8;
            if ((it + 1) * 512 <= nk) {
                const u32x4v v = *(const LAS u32x4v*)(scq + base);
#pragma unroll
                for (int j = 0; j < 8; ++j) { const unsigned key = (v[j >> 1] >> ((j & 1) * 16)) & 0xffffu; if ((int)(key >> 8) == B1) atomicAdd((unsigned*)(hist + (key & 255u)), 1u); }
            } else if (base < nk) { const u32x4v v = *(const LAS u32x4v*)(scq + base);
#pragma unroll
                for (int j = 0; j < 8; ++j) { const unsigned key = (v[j >> 1] >> ((j & 1) * 16)) & 0xffffu; if (base + j < nk && (int)(key >> 8) == B1) atomicAdd((unsigned*)(hist + (key & 255u)), 1u); } } }
        LDS_FENCE();
        int B2, above2; find_bin(hist, lane, TOPK - above1, B2, above2);
        const unsigned T = ((unsigned)B1 << 8) | (unsigned)B2;
        const int ngt = above1 + above2, need_eq = TOPK - ngt;
        int pos_gt = 0, pos_eq = 0;
#pragma unroll 2
        for (int it = 0; it < nit; ++it) { const int base = it * 512 + lane * 8;
            u32x4v v = (u32x4v){0u, 0u, 0u, 0u};
            if (base < nk) v = *(const LAS u32x4v*)(scq + base);
            unsigned key[8];
#pragma unroll
            for (int j = 0; j < 8; ++j) key[j] = (v[j >> 1] >> ((j & 1) * 16)) & 0xffffu;
            if ((it + 1) * 512 > nk) {
#pragma unroll
                for (int j = 0; j < 8; ++j) if (base + j >= nk) key[j] = 0u; }
            unsigned mgt = 0u, meq = 0u;
#pragma unroll
            for (int j = 0; j < 8; ++j) { mgt |= (key[j] > T ? 1u : 0u) << j; meq |= (key[j] == T ? 1u : 0u) << j; }
            const int cgt = __builtin_popcount(mgt), ceq = __builtin_popcount(meq);
            const int packed = cgt | (ceq << 16);
            const int incl = wave_incl_scan_dpp(packed), excl = incl - packed, tot = __builtin_amdgcn_readlane(incl, 63);
            int og = pos_gt + (excl & 0xffff), oe = pos_eq + (excl >> 16);
            pos_gt += tot & 0xffff; pos_eq += tot >> 16;
            while (mgt) { const int j = __builtin_ctz(mgt); mgt &= mgt - 1u; idx[og] = (u16)(base + j); ++og; }
            while (meq) { const int j = __builtin_ctz(meq); meq &= meq - 1u; if (oe < need_eq) idx[ngt + oe] = (u16)(base + j); ++oe; }
            if (!early && pos_gt >= 64 && it + 1 < nit) { early = true; C_EARLY(); } }
    }
    }
    *(LAS u32x4v*)(h1 + 4 * lane) = (u32x4v){0u, 0u, 0u, 0u};
    LDS_FENCE();
    for (int repC = 0; repC < (((MK_REPEAT >> 10) & 1) ? 2 : 1); ++repC) {
        const int fr = lane & 15, fq = lane >> 4;
        const size_t tok = tb + tq;
        const int nch = (cnt + 31) >> 5;
        if (!early || repC) C_EARLY();
        { int kr[3]; f32x4v q4[4]; q4[0] = q4e;
#pragma unroll
          for (int i = 1; i < 4; ++i) { const int s = lane + 64 * i; kr[i - 1] = (int)idx[s < cnt ? s : cnt - 1]; }
#pragma unroll
          for (int i = 1; i < 4; ++i) q4[i] = *(const f32x4v*)(SSQ + (tb + kr[i - 1]) * 4);
#pragma unroll
          for (int i = 0; i < 4; ++i) { const int s = lane + 64 * i; rsel[s] = s < cnt ? __builtin_amdgcn_rsqf((q4[i][0] + q4[i][1] + q4[i][2] + q4[i][3]) * (1.f / 128.f) + EPS) : 0.f; } }
        f32x4v O[8];
#pragma unroll
        for (int ct = 0; ct < 8; ++ct) O[ct] = (f32x4v){0.f, 0.f, 0.f, 0.f};
        float mrun = -__builtin_inff(), lsum = 0.f;
        const int rho0 = 8 * (fr >> 2) + (fr & 3);
        const int tq_ = (lane & 15) >> 2, tp = lane & 3;
        LAS unsigned char* const CB = C.lds + DSA_SC + wave * 16384;
        auto c_chunk = [&](const int ch, LAS unsigned char* const CH) __attribute__((always_inline)) {
            f32x4v sacc[2];
#pragma unroll
            for (int T = 0; T < 2; ++T) { sacc[T] = (f32x4v){0.f, 0.f, 0.f, 0.f};
#pragma unroll
                for (int ks = 0; ks < 4; ++ks) { const s16x8 a = *(const LAS s16x8*)(CH + off_b(rho0 + 4 * T, 4 * ks + fq)); sacc[T] = mfma16(a, Bq[ks], sacc[T]); } }
            const f32x4v r0 = *(const LAS f32x4v*)(rsel + ch * 32 + 8 * fq), r1 = *(const LAS f32x4v*)(rsel + ch * 32 + 8 * fq + 4);
            float sv[8];
#pragma unroll
            for (int i = 0; i < 4; ++i) { sv[i] = sacc[0][i] * r0[i]; sv[4 + i] = sacc[1][i] * r1[i]; }
            if (ch * 32 + 32 > cnt) {
#pragma unroll
                for (int i = 0; i < 4; ++i) { const int s0 = ch * 32 + 8 * fq + i; if (s0 >= cnt) sv[i] = -__builtin_inff(); if (s0 + 4 >= cnt) sv[4 + i] = -__builtin_inff(); } }
            float cmax = fmaxf(fmaxf(fmaxf(sv[0], sv[1]), fmaxf(sv[2], sv[3])), fmaxf(fmaxf(sv[4], sv[5]), fmaxf(sv[6], sv[7])));
            cmax = fmaxf(cmax, __shfl_xor(cmax, 16)); cmax = fmaxf(cmax, __shfl_xor(cmax, 32));
            const bool need = cmax > mrun + 8.f;
            if (__any(need)) {
                const float mnew = need ? cmax : mrun;
                const float alpha = fast_exp(mrun - mnew);
                mrun = mnew; lsum *= alpha;
#pragma unroll
                for (int ct = 0; ct < 8; ++ct) O[ct] = O[ct] * alpha;
            }
            float p[8]; float ps = 0.f;
#pragma unroll
            for (int i = 0; i < 8; ++i) { p[i] = fast_exp(sv[i] - mrun); ps += p[i]; }
            lsum += ps;
            f32x4v pa, pb;
#pragma unroll
            for (int i = 0; i < 4; ++i) { pa[i] = p[i] * r0[i]; pb[i] = p[4 + i] * r1[i]; }
            const s16x8 pop = pack8f(pa, pb);
#pragma unroll
            for (int ct = 0; ct < 8; ++ct) {
                const s16x4 t0 = tr4((const LAS u16*)(CH + off_b(8 * fq + tq_, 2 * ct + (tp >> 1)) + 8 * (tp & 1)));
                const s16x4 t1 = tr4((const LAS u16*)(CH + off_b(8 * fq + 4 + tq_, 2 * ct + (tp >> 1)) + 8 * (tp & 1)));
                O[ct] = mfma16(cat4(t0, t1), pop, O[ct]);
            }
        };
#pragma unroll 1
        for (int ch = 0; ch < nch; ch += 2) {
#pragma unroll
            for (int i = 0; i < 8; ++i) *(LAS u32x4v*)(CB + off_b(4 * i + fq, fr)) = gbuf[i];
            if (ch + 1 < nch) C_ISSUE(ch + 1);
            LDS_FENCE();
            c_chunk(ch, CB);
            if (ch + 1 < nch) {
#pragma unroll
                for (int i = 0; i < 8; ++i) *(LAS u32x4v*)(CB + 8192 + off_b(4 * i + fq, fr)) = gbuf[i];
                if (ch + 2 < nch) C_ISSUE(ch + 2);
                LDS_FENCE();
                c_chunk(ch + 1, CB + 8192);
            }
        }
#undef C_ISSUE
#undef C_EARLY
        lsum += __shfl_xor(lsum, 16); lsum += __shfl_xor(lsum, 32);
        const float inv = 1.f / lsum;
        float am = 0.f;
#pragma unroll
        for (int ct = 0; ct < 8; ++ct) { O[ct] = O[ct] * inv; am = fmaxf(am, fmaxf(fmaxf(fabsf(O[ct][0]), fabsf(O[ct][1])), fmaxf(fabsf(O[ct][2]), fabsf(O[ct][3])))); }
        if (fr >= 8) am = 0.f;
        am = wave_max_f(am);
        const float qs = am > 0.f ? 127.f / am : 0.f;
        if (fr < 8) {
            unsigned char* mp = (unsigned char*)MIX + tok * MIXB + fr * 128 + 4 * fq;
#pragma unroll
            for (int ct = 0; ct < 8; ++ct) *(unsigned*)(mp + 16 * ct) = pack_i8(O[ct][0] * qs, O[ct][1] * qs, O[ct][2] * qs, O[ct][3] * qs);
        }
        if (lane == 0) ((float*)(ws + WS_MIXS))[tok] = am * (1.f / 127.f);
    }
    dsa_pre(C, b, (SEQ / 8 - 1) - (nx < SEQ / 8 ? nx : SEQ / 8 - 1), P);
    return nx;
}

__device__ __forceinline__ void p2_mixers(const Ctx& C, int cw = 0) {
    if (C.bid < 64) { hgrn_seq(C, C.bid); if ((MK_REPEAT >> 7) & 1) hgrn_seq(C, C.bid); }
    unsigned* qctr = (unsigned*)(C.ws + WS_CTL);
    for (int i = C.tid; i < 2048; i += NTHREADS) ((LAS unsigned*)(C.lds + DSA_H1))[i] = 0u;
    __syncthreads();
    LAS int* itemw = (LAS int*)(C.lds + DSA_ITEM);
    APre P;
    const int xcc = (int)(__builtin_amdgcn_s_getreg((3 << 11) | 20) & 0x7u);
    for (int k = 0; k < NB; ++k) { const int bq = (xcc + k) & 7;
        if (C.tid == 0) *itemw = (int)atomicAdd(qctr + 8 * cw + bq, 1u);
        __syncthreads();
        int item = *itemw;
        __syncthreads();
        if (item < SEQ / 8) dsa_pre(C, bq, (SEQ / 8 - 1) - item, P);
        while (item < SEQ / 8) {
            int nxt = 0;
            if (C.tid == 0) nxt = (int)atomicAdd(qctr + 8 * cw + bq, 1u);
            item = dsa_item(C, bq, (SEQ / 8 - 1) - item, P, nxt);
            __syncthreads();
        }
    }
}


__device__ __forceinline__ float wave_sum(float v) {
#pragma unroll
    for (int d = 1; d < 64; d <<= 1) v += __shfl_xor(v, d);
    return v;
}
__device__ __forceinline__ void p4_ln1(const Ctx& C) {
    const u16* Y1 = (const u16*)(C.ws + WS_Y1); u16* HB = (u16*)(C.ws + WS_HB); unsigned char* H8 = C.ws + WS_H8; float* HS = (float*)(C.ws + WS_HS);
    const float* g = C.in[I_LN1G]; const float* bb = C.in[I_LN1B];
    const int lane = C.lane, gw = C.bid * 8 + C.wave, nw = C.G * 8;
    f32x4v gv[4], bv[4];
#pragma unroll
    for (int c = 0; c < 4; ++c) { gv[c] = *(const f32x4v*)(g + lane * 16 + 4 * c); bv[c] = *(const f32x4v*)(bb + lane * 16 + 4 * c); }
    u32x4v yn0 = *(const u32x4v*)(Y1 + (size_t)gw * 1024 + lane * 16), yn1 = *(const u32x4v*)(Y1 + (size_t)gw * 1024 + lane * 16 + 8);
    for (int r = gw; r < MTOK; r += nw) {
        const u32x4v y0 = yn0, y1 = yn1;
        { const int rn = r + nw < MTOK ? r + nw : r; yn0 = *(const u32x4v*)(Y1 + (size_t)rn * 1024 + lane * 16); yn1 = *(const u32x4v*)(Y1 + (size_t)rn * 1024 + lane * 16 + 8); }
        float v[16]; float s = 0.f;
#pragma unroll
        for (int j = 0; j < 4; ++j) { v[2 * j] = bf_lo(y0[j]); v[2 * j + 1] = bf_hi(y0[j]); v[8 + 2 * j] = bf_lo(y1[j]); v[8 + 2 * j + 1] = bf_hi(y1[j]); }
#pragma unroll
        for (int j = 0; j < 16; ++j) s += v[j];
        const float mu = wave_sum_f(s) * (1.f / 1024.f);
        float q = 0.f;
#pragma unroll
        for (int j = 0; j < 16; ++j) { v[j] -= mu; q += v[j] * v[j]; }
        const float rstd = __builtin_amdgcn_rsqf(wave_sum_f(q) * (1.f / 1024.f) + EPS);
        float am = 0.f;
#pragma unroll
        for (int j = 0; j < 16; ++j) { v[j] = v[j] * rstd * gv[j >> 2][j & 3] + bv[j >> 2][j & 3]; am = fmaxf(am, fabsf(v[j])); }
        u32x4v w0, w1;
#pragma unroll
        for (int j = 0; j < 4; ++j) { w0[j] = cvtpk(v[2 * j], v[2 * j + 1]); w1[j] = cvtpk(v[8 + 2 * j], v[8 + 2 * j + 1]); }
        *(u32x4v*)(HB + (size_t)r * 1024 + lane * 16) = w0; *(u32x4v*)(HB + (size_t)r * 1024 + lane * 16 + 8) = w1;
        am = wave_max_f(am);
        const float qs = am > 0.f ? 127.f / am : 0.f;
        u32x4v w8;
#pragma unroll
        for (int j = 0; j < 4; ++j) w8[j] = pack_i8(v[4 * j] * qs, v[4 * j + 1] * qs, v[4 * j + 2] * qs, v[4 * j + 3] * qs);
        *(u32x4v*)(H8 + (size_t)r * 1024 + lane * 16) = w8;
        if (lane == 0) HS[r] = am * (1.f / 127.f);
    }
}

constexpr int SSROW = 136;
constexpr int PE_SS = 0, PE_TV = 0, PE_TI = 32768, PE_EU = 53248, PE_EID = 131072, PE_EG = 147456;

__device__ __forceinline__ void ins16(float (&tv)[16], int (&ti)[16], float v, int id) {
#pragma unroll
    for (int j = 15; j >= 0; --j) {
        const bool c = v > tv[j];
        const bool cp = (j > 0) ? (v > tv[j > 0 ? j - 1 : 0]) : false;
        const float nv = cp ? tv[j > 0 ? j - 1 : 0] : v; const int ni = cp ? ti[j > 0 ? j - 1 : 0] : id;
        tv[j] = c ? nv : tv[j]; ti[j] = c ? ni : ti[j];
    }
}

__device__ __forceinline__ float gelu_tanh(float x) {
    const float u = 0.7978845608028654f * (x + 0.044715f * x * x * x);
    const float e = fast_exp(2.f * u);
    const float th = 1.f - 2.f * __builtin_amdgcn_rcpf(e + 1.f);
    return 0.5f * x * (1.f + th);
}


#ifndef MK_PASSBAR
#define MK_PASSBAR 0
#endif
constexpr int PE_PD = 0, PE_STAT = 131072, PE_WSC = 133120;
constexpr size_t WS_GSID = WS_MIX, WS_GSG = WS_MIX + 32 * MiB, WS_GSU = WS_MIX + 64 * MiB;
constexpr int NSEG = 8, SEGB = 128;

__device__ __forceinline__ void p6_peer(const Ctx& C) {
    unsigned char* ws = C.ws;
    const u16* PQ = (const u16*)(ws + WS_PQ); const u16* HB = (const u16*)(ws + WS_HB); const u16* SKB = (const u16*)(ws + WS_SKB); const unsigned char* H8 = ws + WS_H8; const float* HS = (const float*)(ws + WS_HS);
    const unsigned char* U8 = ws + WS_UB; const unsigned char* V8 = ws + WS_VB; const float* USC = (const float*)(ws + WS_USC); const float* VSC = (const float*)(ws + WS_VSC);
    u16* YB = (u16*)(ws + WS_YB);
    unsigned* G_SID = (unsigned*)(ws + WS_GSID); float* G_SG = (float*)(ws + WS_GSG); float* G_SU = (float*)(ws + WS_GSU);
    const float* g2 = C.in[I_LN2G]; const float* b2 = C.in[I_LN2B];
    const int tid = C.tid, lane = C.lane, wave = C.wave, fr = lane & 15, fq = lane >> 4;
    LAS u16* SSK = (LAS u16*)(C.lds + PE_SS);
    LAS float* TV = (LAS float*)(C.lds + PE_TV); LAS u16* TI = (LAS u16*)(C.lds + PE_TI);
    LAS int* EID = (LAS int*)(C.lds + PE_EID); LAS float* EG = (LAS float*)(C.lds + PE_EG); LAS float* EU = (LAS float*)(C.lds + PE_EU);
    cg::grid_group grid = cg::this_grid();
    const int ntile = MTOK / 32, tiles_per_wg = (ntile + C.G - 1) / C.G, nsr = (tiles_per_wg + 7) / 8;
    for (int sr = 0; sr < nsr; ++sr) {
    for (int jj = 0; jj < 8; ++jj) { const int tile = C.bid + (8 * sr + jj) * C.G; if (tile >= ntile) break;
        const size_t t0 = (size_t)tile * 32;
        int tid_r = C.tid; asm volatile("" : "+v"(tid_r));
        const int lane_r = tid_r & 63, fr_r = lane_r & 15, fq_r = lane_r >> 4;
#define tid tid_r
#define lane lane_r
#define fr fr_r
#define fq fq_r
#define SK_KEYS(x_, y_) ({ const unsigned hh_ = __builtin_bit_cast(unsigned, __builtin_amdgcn_cvt_pkrtz(x_, y_)); hh_ ^ (__builtin_bit_cast(unsigned, __builtin_bit_cast(s16x2v, hh_) >> 15) | 0x80008000u); })
#define SK_LOAD(dst, hp_, k0_) do { _Pragma("unroll") for (int kk = 0; kk < 4; ++kk) _Pragma("unroll") for (int ks = 0; ks < 4; ++ks) \
            dst[kk][ks] = *(const s16x8*)(SKB + ((size_t)(hp_) * 128 + 16 * ((k0_) + kk) + fr) * 128 + 32 * ks + 8 * fq); } while (0)
#define PQ_LOAD(dst, hp_) do { _Pragma("unroll") for (int tt = 0; tt < 2; ++tt) _Pragma("unroll") for (int ks = 0; ks < 4; ++ks) dst[tt][ks] = *(const s16x8*)(PQ + (t0 + 16 * tt + fr) * NPQ + (hp_) * 128 + 32 * ks + 8 * fq); } while (0)
#define SK_COMP(src, Bq_, hp_, k0_) do { _Pragma("unroll") for (int kk = 0; kk < 4; ++kk) { const int kt = (k0_) + kk; f32x4v a0 = {0.f, 0.f, 0.f, 0.f}, a1 = a0; \
            _Pragma("unroll") for (int ks = 0; ks < 4; ++ks) { a0 = mfma16(src[kk][ks], Bq_[0][ks], a0); a1 = mfma16(src[kk][ks], Bq_[1][ks], a1); } \
              \
            u32x2v kwa_, kwb_; kwa_.x = SK_KEYS(a0[0], a0[1]); kwa_.y = SK_KEYS(a0[2], a0[3]); kwb_.x = SK_KEYS(a1[0], a1[1]); kwb_.y = SK_KEYS(a1[2], a1[3]); \
            *(LAS u32x2v*)(SSK + ((hp_) * 32 + fr) * SSROW + 16 * kt + 4 * fq) = kwa_; *(LAS u32x2v*)(SSK + ((hp_) * 32 + 16 + fr) * SSROW + 16 * kt + 4 * fq) = kwb_; } } while (0)
#pragma unroll 1
        for (int rep1 = 0; rep1 < (((MK_REPEAT >> 11) & 1) ? 2 : 1); ++rep1) {
            const int hp0 = 2 * wave, hp1 = hp0 + 1;
            s16x8 akA[4][4], akB[4][4], Bt0[2][4], Bt1[2][4];
            PQ_LOAD(Bt0, hp0); SK_LOAD(akA, hp0, 0); SK_LOAD(akB, hp0, 4); PQ_LOAD(Bt1, hp1);
            SK_COMP(akA, Bt0, hp0, 0); SK_LOAD(akA, hp1, 0);
            SK_COMP(akB, Bt0, hp0, 4); SK_LOAD(akB, hp1, 4);
            SK_COMP(akA, Bt1, hp1, 0);
            SK_COMP(akB, Bt1, hp1, 4);
        }
#undef SK_LOAD
#undef PQ_LOAD
#undef SK_COMP
#undef SK_KEYS
        __syncthreads();
        for (int repS = 0; repS < (((MK_REPEAT >> 12) & 1) ? 2 : 1); ++repS) {
            if (repS) __syncthreads();
            const int tok = tid & 31, hp = tid >> 5;
            float tk[16];
#pragma unroll
            for (int j = 0; j < 16; ++j) tk[j] = __builtin_bit_cast(float, 0x40000000u);
            const LAS u16* rowp = SSK + (hp * 32 + tok) * SSROW;
#pragma unroll 2
            for (int kb = 0; kb < 16; ++kb) {
                const u32x4v w = *(const LAS u32x4v*)(rowp + 8 * kb);
#pragma unroll
                for (int j = 0; j < 8; ++j) { const int k = 8 * kb + j; const unsigned k16 = (j & 1) ? (w[j >> 1] >> 16) : (w[j >> 1] & 0xffffu);
                    const float x = __builtin_bit_cast(float, (k16 << 7) | (0x40000000u | (unsigned)(127 - k)));
                    float nk[16];
                    nk[0] = __builtin_amdgcn_fmed3f(__builtin_inff(), x, tk[0]);
#pragma unroll
                    for (int jj = 1; jj < 16; ++jj) nk[jj] = __builtin_amdgcn_fmed3f(tk[jj - 1], x, tk[jj]);
#pragma unroll
                    for (int jj = 0; jj < 16; ++jj) tk[jj] = nk[jj]; }
            }
            if (repS + 1 < (((MK_REPEAT >> 12) & 1) ? 2 : 1)) continue;
            __syncthreads();
#pragma unroll
            for (int j = 0; j < 16; ++j) { const unsigned bits = __builtin_bit_cast(unsigned, tk[j]); const unsigned k16 = (bits >> 7) & 0xffffu;
                const unsigned hb = (k16 & 0x8000u) ? (k16 & 0x7fffu) : (~k16 & 0xffffu);
                TV[tid * 16 + j] = (float)__builtin_bit_cast(_Float16, (unsigned short)hb); TI[tid * 16 + j] = (u16)(127u - (bits & 0x7fu)); }
        }
        __syncthreads();
        for (int repK = 0; repK < (((MK_REPEAT >> 13) & 1) ? 2 : 1); ++repK) if (tid < 256) {
            int tid_o = tid; asm volatile("" : "+v"(tid_o));
            const int tok = tid_o & 31, h = tid_o >> 5;
            const int ra = ((2 * h) * 32 + tok) * 16, rb = ((2 * h + 1) * 32 + tok) * 16;
            float va[16], vb[16];
#pragma unroll
            for (int j = 0; j < 16; ++j) { va[j] = TV[ra + j]; vb[j] = TV[rb + j]; }
            float tk[16];
#pragma unroll
            for (int j = 0; j < 16; ++j) tk[j] = -__builtin_inff();
#pragma unroll
            for (int a = 0; a < 16; ++a)
#pragma unroll
                for (int b = 0; b < 16; ++b) if ((a + 1) * (b + 1) <= 16) {
                    const float x = __builtin_bit_cast(float, (__builtin_bit_cast(unsigned, va[a] + vb[b]) & 0xffffff00u) | (unsigned)(a * 16 + b));
                    float nk[16];
                    nk[0] = __builtin_amdgcn_fmed3f(__builtin_inff(), x, tk[0]);
#pragma unroll
                    for (int j = 1; j < 16; ++j) nk[j] = __builtin_amdgcn_fmed3f(tk[j - 1], x, tk[j]);
#pragma unroll
                    for (int j = 0; j < 16; ++j) tk[j] = nk[j];
                }
            float tv[16]; int ti[16];
#pragma unroll
            for (int j = 0; j < 16; ++j) { const unsigned bits = __builtin_bit_cast(unsigned, tk[j]); tv[j] = __builtin_bit_cast(float, bits & 0xffffff00u);
                ti[j] = (int)TI[ra + ((bits >> 4) & 15u)] * 128 + (int)TI[rb + (bits & 15u)]; }
            float mx = tv[0], sum = 0.f, e[16];
#pragma unroll
            for (int j = 0; j < 16; ++j) { e[j] = fast_exp(tv[j] - mx); sum += e[j]; }
            const float inv = __builtin_amdgcn_rcpf(sum);
#pragma unroll
            for (int j = 0; j < 16; ++j) { EID[tok * 128 + h * 16 + j] = ti[j]; EG[tok * 128 + h * 16 + j] = e[j] * inv * VSC[ti[j]]; EU[tok * 128 + h * 16 + j] = USC[ti[j]]; }
        }
        __syncthreads();
        { const u32x4v i0 = *(const LAS u32x4v*)(EID + tid * 8), i1 = *(const LAS u32x4v*)(EID + tid * 8 + 4);
          const f32x4v a0 = *(const LAS f32x4v*)(EG + tid * 8), a1 = *(const LAS f32x4v*)(EG + tid * 8 + 4), u0 = *(const LAS f32x4v*)(EU + tid * 8), u1 = *(const LAS f32x4v*)(EU + tid * 8 + 4);
          *(u32x4v*)(G_SID + t0 * 128 + tid * 8) = i0; *(u32x4v*)(G_SID + t0 * 128 + tid * 8 + 4) = i1;
          *(f32x4v*)(G_SG + t0 * 128 + tid * 8) = a0; *(f32x4v*)(G_SG + t0 * 128 + tid * 8 + 4) = a1;
          *(f32x4v*)(G_SU + t0 * 128 + tid * 8) = u0; *(f32x4v*)(G_SU + t0 * 128 + tid * 8 + 4) = u1; }
        __syncthreads();
#undef tid
#undef lane
#undef fr
#undef fq
    }
    __syncthreads();
    int lane_o = C.lane, wave_o = C.wave; asm volatile("" : "+v"(lane_o), "+s"(wave_o));
#define lane lane_o
#define wave wave_o
    LAS float* PD = (LAS float*)(C.lds + PE_PD) + wave * 4096;
    LAS float* STAT = (LAS float*)(C.lds + PE_STAT) + wave * 64;
    LAS float* WSC = (LAS float*)(C.lds + PE_WSC) + wave * 32;
    {
#pragma unroll
        for (int i = 0; i < 16; ++i) *(LAS f32x4v*)(PD + (i * 64 + lane) * 4) = (f32x4v){0.f, 0.f, 0.f, 0.f};
        STAT[lane] = 0.f;
        LDS_FENCE();
    }
#define ID_LOAD(kb_) (*(const u32x2v*)(sid + 16 * (kb_) + 2 * pc))
#define ROW_ISSUE(buf, idv, hb_, tbl) do { _Pragma("unroll") for (int jj_ = 0; jj_ < 8; ++jj_) { const int j_ = 8 * ((hb_) & 1) + jj_; \
            const unsigned id_ = (unsigned)__shfl((int)((j_ & 1) ? idv.y : idv.x), 8 * g + (j_ >> 1)); \
            buf[jj_] = *(const u32x4v*)((tbl) + ((id_ << 7) + (unsigned)(pc * 16))); } } while (0)
#define STREAM(tbl, CONSUME) do { \
        u32x2v idA_ = idP0, idB_ = idP1; u32x4v bA_[8], bB_[8];                       \
        idP0 = *(const u32x2v*)(sidn + 2 * pc); idP1 = *(const u32x2v*)(sidn + 16 + 2 * pc); \
        ROW_ISSUE(bA_, idA_, 0, tbl); ROW_ISSUE(bB_, idA_, 1, tbl); \
        _Pragma("unroll 1") for (int hb = 0; hb < 16; hb += 2) { \
            __builtin_amdgcn_sched_barrier(0); CONSUME(bA_, hb); __builtin_amdgcn_sched_barrier(0);        \
            if (hb + 2 < 16) ROW_ISSUE(bA_, idB_, hb + 2, tbl); \
            __builtin_amdgcn_sched_barrier(0); CONSUME(bB_, hb + 1); __builtin_amdgcn_sched_barrier(0); \
            if (hb + 2 < 16) { ROW_ISSUE(bB_, idB_, hb + 3, tbl); idA_ = idB_; if (hb + 4 < 16) idB_ = ID_LOAD((hb >> 1) + 2); } } } while (0)
#define R_TOKEN(r_) ({ const int q_ = 8 * (r_) + g; const int tl_ = C.bid + (8 * sr + (q_ >> 2)) * C.G; (tl_ < ntile ? (size_t)tl_ * 32 + 4 * wave + (q_ & 3) : (size_t)0); })
    asm volatile("" : "+v"(lane_o));
    { const int g = lane >> 3, pc = lane & 7;
    u32x2v idP0, idP1; { const unsigned* s0_ = G_SID + R_TOKEN(0) * 128; idP0 = *(const u32x2v*)(s0_ + 2 * pc); idP1 = *(const u32x2v*)(s0_ + 16 + 2 * pc); }
    for (int repU = 0; repU < (((MK_REPEAT >> 20) & 5) ? 2 : 1); ++repU)
#pragma unroll 1
    for (int seg = 0; seg < NSEG; ++seg) {
#if MK_PASSBAR == 1
        grid.sync();
#endif
        const unsigned char* tbl = U8 + (size_t)seg * (16384u * SEGB);
#pragma unroll 1
        for (int r = 0; r < 4; ++r) {
            const int q = 8 * r + g; const int tile = C.bid + (8 * sr + (q >> 2)) * C.G; const bool valid = tile < ntile;
            const size_t token = valid ? (size_t)tile * 32 + 4 * wave + (q & 3) : 0;
            const unsigned* sid = G_SID + token * 128; const unsigned* sidn = G_SID + R_TOKEN((r + 1) & 3) * 128;
            const u32x4v x8 = *(const u32x4v*)(H8 + token * 1024 + seg * SEGB + pc * 16);
            LAS int* pdq = (LAS int*)PD + q * 128;
#define U_CONSUME(buf, hb_) do { int pv_[8]; \
                _Pragma("unroll") for (int i = 0; i < 8; ++i) { int a_ = __builtin_amdgcn_sdot4((int)buf[i][0], (int)x8[0], 0, false); a_ = __builtin_amdgcn_sdot4((int)buf[i][1], (int)x8[1], a_, false);     \
                    a_ = __builtin_amdgcn_sdot4((int)buf[i][2], (int)x8[2], a_, false); pv_[i] = __builtin_amdgcn_sdot4((int)buf[i][3], (int)x8[3], a_, false); } \
                int r_[4], q_[2];                                               \
                _Pragma("unroll") for (int i = 0; i < 4; ++i) { const int snd_ = (pc & 4) ? pv_[i] : pv_[i + 4], kp_ = (pc & 4) ? pv_[i + 4] : pv_[i]; r_[i] = kp_ + dppi_xor4(snd_); } \
                _Pragma("unroll") for (int i = 0; i < 2; ++i) { const int snd_ = (pc & 2) ? r_[i] : r_[i + 2], kp_ = (pc & 2) ? r_[i + 2] : r_[i]; q_[i] = kp_ + dppi_xor2(snd_); } \
                const int z_ = ((pc & 1) ? q_[1] : q_[0]) + dppi_xor1((pc & 1) ? q_[0] : q_[1]); \
                if (valid && repU == 0) pdq[8 * (hb_) + pc] += z_; } while (0)
#ifndef MK_NOU
            STREAM(tbl, U_CONSUME);
#endif
#undef U_CONSUME
        }
    }
    }
    LDS_FENCE();
    asm volatile("" : "+v"(lane_o));
#define W_TOKEN(q_) ({ const int tl_ = C.bid + (8 * sr + ((q_) >> 2)) * C.G; (size_t)(tl_ < ntile ? tl_ : C.bid) * 32 + 4 * wave + ((q_) & 3); })
    float nsg0, nsg1, nsu0, nsu1, nhs;
    { const size_t tk_ = W_TOKEN(0); nsg0 = G_SG[tk_ * 128 + lane]; nsg1 = G_SG[tk_ * 128 + 64 + lane]; nsu0 = G_SU[tk_ * 128 + lane]; nsu1 = G_SU[tk_ * 128 + 64 + lane]; nhs = HS[tk_]; }
#pragma unroll 1
    for (int q = 0; q < 32; ++q) { const int tile = C.bid + (8 * sr + (q >> 2)) * C.G;
        const float sg0 = nsg0, sg1 = nsg1, su0 = nsu0, su1 = nsu1, hs = nhs;
        { const size_t tk_ = W_TOKEN(q + 1 < 32 ? q + 1 : q); nsg0 = G_SG[tk_ * 128 + lane]; nsg1 = G_SG[tk_ * 128 + 64 + lane]; nsu0 = G_SU[tk_ * 128 + lane]; nsu1 = G_SU[tk_ * 128 + 64 + lane]; nhs = HS[tk_]; }
        if (tile >= ntile) continue;
        const float w0 = sg0 * gelu_tanh((float)((LAS int*)PD)[q * 128 + lane] * (su0 * hs));
        const float w1 = sg1 * gelu_tanh((float)((LAS int*)PD)[q * 128 + 64 + lane] * (su1 * hs));
        float am = fmaxf(fabsf(w0), fabsf(w1));
        am = wave_max_f(am);
        const float qs = am > 0.f ? 127.f / am : 0.f;
        LAS signed char* w8 = (LAS signed char*)(PD + q * 128);
        w8[lane] = (signed char)(int)__builtin_rintf(w0 * qs); w8[64 + lane] = (signed char)(int)__builtin_rintf(w1 * qs);
        if (lane == 0) WSC[q] = am * (1.f / 127.f); }
#undef W_TOKEN
    LDS_FENCE();
    asm volatile("" : "+v"(lane_o));
    { const int g = lane >> 3, pc = lane & 7;
    const unsigned shb = 8u * (unsigned)(lane & 3), selb = 0x0c0c0c0cu & ~(0xffu << shb);
    u32x2v idP0, idP1; { const unsigned* s0_ = G_SID + R_TOKEN(0) * 128; idP0 = *(const u32x2v*)(s0_ + 2 * pc); idP1 = *(const u32x2v*)(s0_ + 16 + 2 * pc); }
#pragma unroll 1
    for (int seg = 0; seg < NSEG; ++seg) {
#if MK_PASSBAR == 1
        grid.sync();
#endif
        const unsigned char* tbl = V8 + (size_t)seg * (16384u * SEGB);
#pragma unroll 1
        for (int r = 0; r < 4; ++r) {
            const int q = 8 * r + g; const int tile = C.bid + (8 * sr + (q >> 2)) * C.G; const bool valid = tile < ntile;
            const size_t token = valid ? (size_t)tile * 32 + 4 * wave + (q & 3) : 0;
            const unsigned* sid = G_SID + token * 128; const unsigned* sidn = G_SID + R_TOKEN((r + 1) & 3) * 128;
            const LAS unsigned char* wq_ = (const LAS unsigned char*)(PD + q * 128);
            const u32x4v h0 = *(const u32x4v*)(HB + token * 1024 + seg * SEGB + pc * 16), h1 = *(const u32x4v*)(HB + token * 1024 + seg * SEGB + pc * 16 + 8);
            i32x4v accR[4];
#pragma unroll
            for (int j = 0; j < 4; ++j) accR[j] = (i32x4v){0, 0, 0, 0};
#define V_CONSUME(buf, hb_) do { const u32x2v w8_ = *(const LAS u32x2v*)(wq_ + 8 * (hb_)); \
                _Pragma("unroll") for (int i = 0; i < 8; ++i) { const int bop_ = (int)__builtin_amdgcn_perm(w8_.y, w8_.x, selb | ((unsigned)i << shb)); \
                    _Pragma("unroll") for (int r_ = 0; r_ < 4; ++r_) accR[r_] = __builtin_amdgcn_mfma_i32_4x4x4i8((int)buf[i][r_], bop_, accR[r_], 0, 0, 0); } } while (0)
#ifndef MK_NOV
            STREAM(tbl, V_CONSUME);
#endif
#undef V_CONSUME
#pragma unroll
            for (int r_ = 0; r_ < 4; ++r_) {
#pragma unroll
                for (int a = 0; a < 4; a += 2) { const int snd = (pc & 1) ? accR[r_][a] : accR[r_][a + 1]; const int rcv = dppi_xor1(snd); if (pc & 1) accR[r_][a] = rcv; else accR[r_][a + 1] = rcv; }
#pragma unroll
                for (int a = 0; a < 2; ++a) { const int snd = (pc & 2) ? accR[r_][a] : accR[r_][a + 2]; const int rcv = dppi_xor2(snd); if (pc & 2) accR[r_][a] = rcv; else accR[r_][a + 2] = rcv; }
            }
            const float wsq = WSC[q];
            float y[16]; float s1 = 0.f, s2 = 0.f;
#pragma unroll
            for (int j = 0; j < 4; ++j) { y[2 * j] = ALPHA * bf_lo(h0[j]) + (float)accR[j >> 1][2 * (j & 1)] * wsq; y[2 * j + 1] = ALPHA * bf_hi(h0[j]) + (float)accR[j >> 1][2 * (j & 1) + 1] * wsq;
                y[8 + 2 * j] = ALPHA * bf_lo(h1[j]) + (float)accR[2 + (j >> 1)][2 * (j & 1)] * wsq; y[8 + 2 * j + 1] = ALPHA * bf_hi(h1[j]) + (float)accR[2 + (j >> 1)][2 * (j & 1) + 1] * wsq; }
#pragma unroll
            for (int j = 0; j < 16; ++j) { s1 += y[j]; s2 += y[j] * y[j]; }
            s1 += dpp_xor1(s1); s2 += dpp_xor1(s2); s1 += dpp_xor2(s1); s2 += dpp_xor2(s2); s1 += dpp_xor4(s1); s2 += dpp_xor4(s2);
            if (valid) { u16* op = YB + token * 1024 + seg * SEGB + pc * 16;
                u32x4v w0, w1;
#pragma unroll
                for (int c = 0; c < 4; ++c) { w0[c] = cvtpk(y[2 * c], y[2 * c + 1]); w1[c] = cvtpk(y[8 + 2 * c], y[8 + 2 * c + 1]); }
                *(u32x4v*)op = w0; *(u32x4v*)(op + 8) = w1;
                if (pc == 0) { STAT[2 * q] += s1; STAT[2 * q + 1] += s2; } }
        }
    }
    }
    LDS_FENCE();
    asm volatile("" : "+v"(lane_o));
    __builtin_amdgcn_fence(__ATOMIC_RELEASE, "workgroup");
    asm volatile("s_waitcnt vmcnt(0)" ::: "memory");
#define L_TOKEN(q_) ({ const int tl_ = C.bid + (8 * sr + ((q_) >> 2)) * C.G; (size_t)(tl_ < ntile ? tl_ : C.bid) * 32 + 4 * wave + ((q_) & 3); })
    u32x4v yn0, yn1; { const size_t tk_ = L_TOKEN(0); yn0 = *(const u32x4v*)(YB + tk_ * 1024 + lane * 16); yn1 = *(const u32x4v*)(YB + tk_ * 1024 + lane * 16 + 8); }
    f32x4v ga4[4], ba4[4];
#pragma unroll
    for (int c = 0; c < 4; ++c) { ga4[c] = *(const f32x4v*)(g2 + lane * 16 + 4 * c); ba4[c] = *(const f32x4v*)(b2 + lane * 16 + 4 * c); }
#pragma unroll 1
    for (int q = 0; q < 32; ++q) { const int tile = C.bid + (8 * sr + (q >> 2)) * C.G;
        const u32x4v y0 = yn0, y1 = yn1;
        { const size_t tk_ = L_TOKEN(q + 1 < 32 ? q + 1 : q); yn0 = *(const u32x4v*)(YB + tk_ * 1024 + lane * 16); yn1 = *(const u32x4v*)(YB + tk_ * 1024 + lane * 16 + 8); }
        if (tile >= ntile) continue;
        const size_t token = (size_t)tile * 32 + 4 * wave + (q & 3);
        const float mu = STAT[2 * q] * (1.f / 1024.f), var = STAT[2 * q + 1] * (1.f / 1024.f) - mu * mu;
        const float rstd = __builtin_amdgcn_rsqf(fmaxf(var, 0.f) + EPS);
        float* op = C.out + token * 1024 + lane * 16;
#pragma unroll
        for (int c = 0; c < 4; ++c) { const u32x4v& yy = c < 2 ? y0 : y1; const f32x4v yv = {bf_lo(yy[2 * (c & 1)]), bf_hi(yy[2 * (c & 1)]), bf_lo(yy[2 * (c & 1) + 1]), bf_hi(yy[2 * (c & 1) + 1])};
            *(f32x4v*)(op + 4 * c) = (yv - mu) * rstd * ga4[c] + ba4[c]; } }
#undef L_TOKEN
#undef ID_LOAD
#undef R_TOKEN
#undef ROW_ISSUE
#undef STREAM
#undef lane
#undef wave
    __syncthreads();
    }
}


#ifndef MK_LAUNCHES
#define MK_LAUNCHES 1
#endif
constexpr int NPHASE = 7;
#define REP(k) for (int rep_ = 0; rep_ < (((MK_REPEAT >> (k)) & 1) ? 2 : 1); ++rep_, ((MK_REPEAT >> (k)) & 1) ? grid.sync() : (void)0)


__global__ void __launch_bounds__(NTHREADS, 2) hymba_fwd(Args args) {
    extern __shared__ __attribute__((aligned(16))) unsigned char lds_raw[];
    Ctx C;
    C.lds = (LAS unsigned char*)lds_raw;
    C.tid = threadIdx.x; C.lane = C.tid & 63; C.wave = __builtin_amdgcn_readfirstlane(C.tid >> 6);
    C.G = gridDim.x; C.bid = blockIdx.x;
#pragma unroll
    for (int i = 0; i < 16; ++i) C.in[i] = args.in[i];
    C.out = args.out; C.ws = args.ws;
    const int lo = args.ph_lo, hi = args.ph_hi;
    cg::grid_group grid = cg::this_grid();
#ifdef MK_ONLY
#define IN(k) ((k) == MK_ONLY)
#else
#define IN(k) (lo <= (k) && (k) < hi)
#endif
    unsigned bar_target = 0u;
#define SEAM(k) do { if (IN(k) && IN((k) + 1)) { if ((k) == 0 || MK_REPEAT || !MK_CUSTOM_BAR) grid.sync(); else grid_bar(C, bar_target); } } while (0)
    unsigned char* ws = C.ws;
    if (IN(0)) REP(0) p0_prologue(C);
    SEAM(0);
    if (IN(0)) p0b_quant(C);
    SEAM(0);
    if (IN(1)) REP(1) {
        pg8::Gemm g{(const pg8::bf16_t*)(ws + WS_XB), (const pg8::bf16_t*)(ws + WS_W1Q), MTOK, N1, DM / 2};
        pg8::StaticOrder S; S.init(MTOK, N1, C.G, C.bid);
        pg8::EpiProj E{(pg8::bf16_t*)(ws + WS_QLAT), (pg8::bf16_t*)(ws + WS_QIDX), (pg8::bf16_t*)(ws + WS_CKV), (pg8::bf16_t*)(ws + WS_KIDX), (float*)(ws + WS_WIDX), (float*)(ws + WS_SSQ),
                       (pg8::bf16_t*)(ws + WS_HQ), (pg8::bf16_t*)(ws + WS_HLF), (pg8::bf16_t*)(ws + WS_HV), (pg8::bf16_t*)(ws + WS_HG), (const float*)(ws + WS_LB), (const float*)(ws + WS_XS), (const float*)(ws + WS_W1S)};
        pg8::gemm_phase<pg8::EpiProj, pg8::StaticOrder, true, true, true>(C.lds, g, S, E);
    }
    SEAM(1);
    if (IN(2)) REP(2) p2_mixers(C, rep_);
    SEAM(2);
    if (IN(3)) REP(3) {
        pg8::Gemm g{(const pg8::bf16_t*)(ws + WS_MIX), (const pg8::bf16_t*)(ws + WS_W3M), MTOK, DM, MIXB / 2};
        pg8::StaticOrder S; S.init(MTOK, DM, C.G, C.bid);
        pg8::EpiY1 E{C.in[I_X], (pg8::bf16_t*)(ws + WS_Y1), ALPHA, (const float*)(ws + WS_MIXS), (const float*)(ws + WS_W3S)};
        pg8::gemm_phase<pg8::EpiY1, pg8::StaticOrder, true, true, false, 8>(C.lds, g, S, E);
    }
    SEAM(3);
    if (IN(4)) REP(4) p4_ln1(C);
    SEAM(4);
    if (IN(5)) REP(5) {
        pg8::Gemm g{(const pg8::bf16_t*)(ws + WS_H8), (const pg8::bf16_t*)(ws + WS_W5Q), MTOK, NPQ, DM / 2};
        pg8::StaticOrder S; S.init(MTOK, NPQ, C.G, C.bid);
        pg8::EpiPQ E{(pg8::bf16_t*)(ws + WS_PQ), NPQ, (const float*)(ws + WS_HS), (const float*)(ws + WS_W5S)};
        pg8::gemm_phase<pg8::EpiPQ, pg8::StaticOrder, true, true, true>(C.lds, g, S, E);
    }
    SEAM(5);
    if (IN(6)) REP(6) p6_peer(C);
#undef IN
#undef SEAM
}

extern "C" void kernel_launch(void* const* d_in, const int* in_sizes, int n_in, void* d_out, int out_size, void* d_ws, size_t ws_size, hipStream_t stream) {
    static int grid = 0;
    if (grid == 0) {
        if (n_in != 16 || out_size != MTOK * DM || ws_size < WS_END) { fprintf(stderr, "kernel_launch: unexpected shapes (n_in %d, out %d, ws %zu)\n", n_in, out_size, ws_size); grid = -1; return; }
        int dev = 0, cus = 0, per_cu = 0;
        if (hipGetDevice(&dev) != hipSuccess || hipDeviceGetAttribute(&cus, hipDeviceAttributeMultiprocessorCount, dev) != hipSuccess) { grid = -1; return; }
        if (hipFuncSetAttribute((const void*)hymba_fwd, hipFuncAttributeMaxDynamicSharedMemorySize, LDS_BYTES) != hipSuccess) { fprintf(stderr, "kernel_launch: hipFuncSetAttribute failed\n"); grid = -1; return; }
        if (hipOccupancyMaxActiveBlocksPerMultiprocessor(&per_cu, (const void*)hymba_fwd, NTHREADS, LDS_BYTES) != hipSuccess || per_cu < 1) { fprintf(stderr, "kernel_launch: occupancy query says %d blocks per CU\n", per_cu); (void)hipGetLastError(); grid = -1; return; }
        grid = cus;
    }
    if (grid < 0) return;
    Args a{};
    for (int i = 0; i < 16; ++i) a.in[i] = (const float*)d_in[i];
    a.out = (float*)d_out; a.ws = (unsigned char*)d_ws;
#if MK_LAUNCHES == 1
    a.ph_lo = 0; a.ph_hi = NPHASE;
    void* kargs[] = {&a};
    hipError_t e = hipLaunchCooperativeKernel((const void*)hymba_fwd, dim3(grid), dim3(NTHREADS), kargs, LDS_BYTES, stream);
    if (e != hipSuccess) fprintf(stderr, "kernel_launch: cooperative launch failed: %s (grid %d)\n", hipGetErrorString(e), grid);
#else
    for (int p = 0; p < NPHASE; ++p) { a.ph_lo = p; a.ph_hi = p + 1; hipLaunchKernelGGL(hymba_fwd, dim3(grid), dim3(NTHREADS), LDS_BYTES, stream, a); }
#endif
}
```

```cpp
#include <hip/hip_runtime.h>
#include <hip/hip_cooperative_groups.h>
#include <cstdio>
#include <cstdint>
namespace cg = cooperative_groups;

#define LAS __attribute__((address_space(3)))
typedef unsigned short u16;
typedef short s16x8 __attribute__((ext_vector_type(8)));
typedef short s16x4 __attribute__((ext_vector_type(4)));
typedef float f32x4v __attribute__((ext_vector_type(4)));
typedef float f32x16v __attribute__((ext_vector_type(16)));
typedef unsigned u32x4v __attribute__((ext_vector_type(4)));
typedef unsigned u32x2v __attribute__((ext_vector_type(2)));
typedef __bf16 bf16x2v __attribute__((ext_vector_type(2)));

constexpr int NB = 8, SEQ = 8192, DM = 1024, MTOK = NB * SEQ;
constexpr int DIN = 3272;
constexpr int N1 = 3840;
constexpr int K3 = 1536;
constexpr int NPQ = 2048;
constexpr float EPS = 1e-5f;
constexpr float ALPHA = 1.189207115002721f;
constexpr int TOPK = 256;

constexpr size_t MiB = 1u << 20;
constexpr size_t WS_CTL = 0, WS_LB = 4096, WS_USC = 65536, WS_VSC = 131072;
constexpr size_t WS_W1T = 1 * MiB, WS_W3T = 9 * MiB, WS_W5T = 12 * MiB, WS_SKB = 16 * MiB, WS_UB = 17 * MiB, WS_VB = 49 * MiB;
constexpr size_t WS_XB = 96 * MiB, WS_MIX = 96 * MiB;
constexpr size_t WS_H8 = WS_MIX + 96 * MiB, WS_HS = WS_MIX + 160 * MiB;
constexpr size_t WS_W1Q = 36 * MiB, WS_W1S = 272 * 1024, WS_XS = 40 * MiB;
constexpr size_t WS_W3M = 44 * MiB, WS_W3S = 288 * 1024, WS_MIXS = 41 * MiB;
constexpr int MIXB = 2048;
constexpr size_t WS_W5Q = 34 * MiB, WS_W5S = 256 * 1024;
constexpr size_t WS_R2 = 288 * MiB;
constexpr size_t WS_QLAT = WS_R2, WS_QIDX = WS_R2 + 128 * MiB, WS_CKV = WS_R2 + 192 * MiB, WS_KIDX = WS_R2 + 208 * MiB, WS_WIDX = WS_R2 + 216 * MiB, WS_SSQ = WS_R2 + 218 * MiB;
constexpr size_t WS_HQ = WS_R2 + 224 * MiB, WS_HLF = WS_R2 + 288 * MiB, WS_HV = WS_R2 + 416 * MiB, WS_HG = WS_R2 + 480 * MiB;
constexpr size_t WS_Y1 = WS_R2, WS_HB = WS_R2 + 256 * MiB, WS_PQ = WS_R2;
constexpr size_t WS_YB = WS_R2 + 384 * MiB;
constexpr size_t WS_END = WS_R2 + 544 * MiB;

#ifndef MK_REPEAT
#define MK_REPEAT 0
#endif
#ifndef MK_NOSORT
#define MK_NOSORT 0
#endif
constexpr int LDS_BYTES = 160 * 1024;
constexpr int NTHREADS = 512;

typedef float f32x2v __attribute__((ext_vector_type(2)));
__device__ __forceinline__ unsigned cvtpk(float lo, float hi) { const f32x2v v = {lo, hi}; const bf16x2v b = __builtin_convertvector(v, bf16x2v); return __builtin_bit_cast(unsigned, b); }
__device__ __forceinline__ float bf_lo(unsigned w) { return __builtin_bit_cast(float, w << 16); }
__device__ __forceinline__ float bf_hi(unsigned w) { return __builtin_bit_cast(float, w & 0xffff0000u); }
__device__ __forceinline__ float bf1(u16 w) { return __builtin_bit_cast(float, (unsigned)w << 16); }
__device__ __forceinline__ float fast_exp(float x) { return __builtin_amdgcn_exp2f(x * 1.4426950408889634f); }
__device__ __forceinline__ float sigmoidf_(float x) { return __builtin_amdgcn_rcpf(1.f + fast_exp(-x)); }
__device__ __forceinline__ float siluf_(float x) { return x * sigmoidf_(x); }
typedef int i32x4v __attribute__((ext_vector_type(4)));
__device__ __forceinline__ unsigned pack_i8(float a, float b, float c, float d) {
    const int ia = (int)__builtin_rintf(a), ib = (int)__builtin_rintf(b), ic = (int)__builtin_rintf(c), id = (int)__builtin_rintf(d);
    return ((unsigned)ia & 0xffu) | (((unsigned)ib & 0xffu) << 8) | (((unsigned)ic & 0xffu) << 16) | ((unsigned)id << 24);
}
__device__ __forceinline__ float dot2bf(unsigned a, unsigned b, float acc) { return __builtin_amdgcn_fdot2_f32_bf16(__builtin_bit_cast(bf16x2v, a), __builtin_bit_cast(bf16x2v, b), acc, false); }
__device__ __forceinline__ float dpp_xor1(float v) { return __builtin_bit_cast(float, __builtin_amdgcn_update_dpp(0, __builtin_bit_cast(int, v), 0xB1, 0xf, 0xf, true)); }
__device__ __forceinline__ float dpp_xor2(float v) { return __builtin_bit_cast(float, __builtin_amdgcn_update_dpp(0, __builtin_bit_cast(int, v), 0x4E, 0xf, 0xf, true)); }
__device__ __forceinline__ int dppi_xor1(int v) { return __builtin_amdgcn_update_dpp(0, v, 0xB1, 0xf, 0xf, true); }
__device__ __forceinline__ int dppi_xor2(int v) { return __builtin_amdgcn_update_dpp(0, v, 0x4E, 0xf, 0xf, true); }
__device__ __forceinline__ int dppi_xor4(int v) { return __builtin_amdgcn_update_dpp(0, __builtin_amdgcn_update_dpp(0, v, 0x141, 0xf, 0xf, true), 0x1B, 0xf, 0xf, true); }
__device__ __forceinline__ float dpp_xor4(float v) { const int t = __builtin_amdgcn_update_dpp(0, __builtin_bit_cast(int, v), 0x141, 0xf, 0xf, true); return __builtin_bit_cast(float, __builtin_amdgcn_update_dpp(0, t, 0x1B, 0xf, 0xf, true)); }
__device__ __forceinline__ float dpp_rowmirror(float v) { return __builtin_bit_cast(float, __builtin_amdgcn_update_dpp(0, __builtin_bit_cast(int, v), 0x140, 0xf, 0xf, true)); }
__device__ __forceinline__ float wave_max_f(float v) { v = fmaxf(v, dpp_xor1(v)); v = fmaxf(v, dpp_xor2(v)); v = fmaxf(v, dpp_xor4(v)); v = fmaxf(v, dpp_rowmirror(v)); v = fmaxf(v, __shfl_xor(v, 16)); return fmaxf(v, __shfl_xor(v, 32)); }
__device__ __forceinline__ float wave_sum_f(float v) { v += dpp_xor1(v); v += dpp_xor2(v); v += dpp_xor4(v); v += dpp_rowmirror(v); v += __shfl_xor(v, 16); return v + __shfl_xor(v, 32); }
#define LDS_FENCE() asm volatile("s_waitcnt lgkmcnt(0)" ::: "memory")

namespace pg8 {
#define PG8_LAS __attribute__((address_space(3)))
typedef unsigned short bf16_t;
typedef short bf16x8 __attribute__((ext_vector_type(8)));
typedef float f32x4 __attribute__((ext_vector_type(4)));
typedef unsigned u32x4 __attribute__((ext_vector_type(4)));
constexpr int BM = 256, BK = 64, HALF = 128, HTB = HALF * BK * 2  , STAGE_BYTES = 8 * HTB, NXCD = 8, WGM = 8;

__host__ __device__ __forceinline__ int lds_byte(int r, int c) { const int st = (r >> 4) * 2 + (c >> 5), rr = r & 15, cc = c & 31, ob = rr * 64 + cc * 2; return st * 1024 + (ob ^ (((ob >> 9) & 1) << 5)); }
__host__ __device__ __forceinline__ void stage_rc(int b, int& R, int& C) { const int st = b / 1024, sb = b % 1024, swz = sb ^ (((sb >> 9) & 1) << 5); R = (st >> 1) * 16 + swz / 64; C = (st & 1) * 32 + (swz % 64) / 2; }
__host__ __device__ __forceinline__ int perm32(int rho) { const int n = rho >> 4, i = rho & 15; return 8 * (i >> 2) + 4 * n + (i & 3); }

typedef int pg8_i32x4 __attribute__((ext_vector_type(4)));
struct Unit { int pm, pn; };
struct Gemm { const bf16_t* A; const bf16_t* Bt; int M, N, K; };

struct StaticOrder {
    int nM, nN, nwg, G, c;
    __host__ __device__ void init(int M, int N, int G_, int c_) { nM = M / BM; nN = N / BM; nwg = nM * nN; G = G_; c = c_; }
    __host__ __device__ bool next(int i, Unit& u) const {
        const long L = (long)i * G + c; if (L >= nwg) return false;
        int wgid = (int)L; { const int q = nwg / NXCD, r = nwg % NXCD, xcd = wgid % NXCD, off = wgid / NXCD; wgid = (xcd < r ? xcd * (q + 1) : r * (q + 1) + (xcd - r) * q) + off; }
        const int nig = WGM * nN, gid = wgid / nig, fm = gid * WGM, gsz = (nM - fm) < WGM ? (nM - fm) : WGM;
        u.pm = fm + ((wgid % nig) % gsz); u.pn = (wgid % nig) / gsz; return true;
    }
    __device__ __forceinline__ void a_ready(const Unit&) const {}
    __device__ __forceinline__ void done(const Unit&) const {}
};

__device__ __forceinline__ unsigned cvt_pk_bf16(float lo, float hi) { return cvtpk(lo, hi); }
typedef float f32x2 __attribute__((ext_vector_type(2)));

__device__ __forceinline__ u32x4 pack8(const f32x4& v0, const f32x4& v1) { u32x4 w; w.x = cvt_pk_bf16(v0[0], v0[1]); w.y = cvt_pk_bf16(v0[2], v0[3]); w.z = cvt_pk_bf16(v1[0], v1[1]); w.w = cvt_pk_bf16(v1[2], v1[3]); return w; }

struct EpiPlain {
    static constexpr bool PERM = true, AFTER_DRAIN = false;
    bf16_t* O; int ldc;
    __device__ __forceinline__ void operator()(const f32x4 (&acc)[2][2][4][2], const Unit& u, int wr, int wc, int fr, int fq) const {
        const int row0 = u.pm * BM + wr * 64 + fr, col0 = u.pn * BM + wc * 32 + 8 * fq;
#pragma unroll
        for (int ai = 0; ai < 2; ++ai)
#pragma unroll
            for (int m = 0; m < 4; ++m) { bf16_t* rowp = O + (size_t)(row0 + ai * HALF + m * 16) * ldc + col0;
#pragma unroll
                for (int bj = 0; bj < 2; ++bj) *(u32x4*)(rowp + bj * HALF) = pack8(acc[ai][bj][m][0], acc[ai][bj][m][1]); }
    }
};

struct EpiPQ {
    static constexpr bool PERM = true, AFTER_DRAIN = false;
    bf16_t* O; int ldc; const float* rs; const float* cs;
    __device__ __forceinline__ void operator()(const f32x4 (&acc)[2][2][4][2], const Unit& u, int wr, int wc, int fr, int fq) const {
        const int row0 = u.pm * BM + wr * 64 + fr, col0 = u.pn * BM + wc * 32 + 8 * fq;
        f32x4 c0[2], c1[2];
#pragma unroll
        for (int bj = 0; bj < 2; ++bj) { c0[bj] = *(const f32x4*)(cs + col0 + bj * HALF); c1[bj] = *(const f32x4*)(cs + col0 + bj * HALF + 4); }
#pragma unroll
        for (int ai = 0; ai < 2; ++ai)
#pragma unroll
            for (int m = 0; m < 4; ++m) { const int row = row0 + ai * HALF + m * 16; const float sr = rs[row]; bf16_t* rowp = O + (size_t)row * ldc + col0;
#pragma unroll
                for (int bj = 0; bj < 2; ++bj) {
                    const f32x4 v0 = __builtin_convertvector(__builtin_bit_cast(pg8_i32x4, acc[ai][bj][m][0]), f32x4) * sr * c0[bj], v1 = __builtin_convertvector(__builtin_bit_cast(pg8_i32x4, acc[ai][bj][m][1]), f32x4) * sr * c1[bj];
                    *(u32x4*)(rowp + bj * HALF) = pack8(v0, v1); } }
    }
};

struct EpiY1 {
    static constexpr bool PERM = true, AFTER_DRAIN = false;
    const float* X; bf16_t* Y; float alpha; const float* rs; const float* cs;
    __device__ __forceinline__ void to_float(f32x4 (&acc)[2][2][4][2], const Unit& u, int wr, int wc, int fr, int fq) const {
        const int row0 = u.pm * BM + wr * 64 + fr;
#pragma unroll
        for (int ai = 0; ai < 2; ++ai)
#pragma unroll
            for (int m = 0; m < 4; ++m) { const float sr = rs[row0 + ai * HALF + m * 16];
#pragma unroll
                for (int bj = 0; bj < 2; ++bj)
#pragma unroll
                    for (int n = 0; n < 2; ++n) acc[ai][bj][m][n] = __builtin_convertvector(__builtin_bit_cast(pg8_i32x4, acc[ai][bj][m][n]), f32x4) * sr; }
    }
    __device__ __forceinline__ void operator()(const f32x4 (&acc)[2][2][4][2], const Unit& u, int wr, int wc, int fr, int fq) const {
        const int row0 = u.pm * BM + wr * 64 + fr, col0 = u.pn * BM + wc * 32 + 8 * fq;
#pragma unroll
        for (int ai = 0; ai < 2; ++ai)
#pragma unroll
            for (int m = 0; m < 4; ++m) { const size_t o = (size_t)(row0 + ai * HALF + m * 16) * 1024 + col0;
#pragma unroll
                for (int bj = 0; bj < 2; ++bj) {
                    const f32x4 x0 = *(const f32x4*)(X + o + bj * HALF), x1 = *(const f32x4*)(X + o + bj * HALF + 4);
                    const f32x4 c0 = *(const f32x4*)(cs + col0 + bj * HALF), c1 = *(const f32x4*)(cs + col0 + bj * HALF + 4);
                    *(u32x4*)(Y + o + bj * HALF) = pack8(x0 * alpha + acc[ai][bj][m][0] * c0, x1 * alpha + acc[ai][bj][m][1] * c1); } }
    }
};

__device__ __forceinline__ float ep_exp(float x) { return __builtin_amdgcn_exp2f(x * 1.4426950408889634f); }
__device__ __forceinline__ float ep_sig(float x) { return __builtin_amdgcn_rcpf(1.f + ep_exp(-x)); }
__device__ __forceinline__ f32x4 silu4(const f32x4& v) { f32x4 r; r[0] = v[0] * ep_sig(v[0]); r[1] = v[1] * ep_sig(v[1]); r[2] = v[2] * ep_sig(v[2]); r[3] = v[3] * ep_sig(v[3]); return r; }

struct EpiProj {
    static constexpr bool PERM = true, AFTER_DRAIN = false;
    bf16_t *QLAT, *QIDX, *CKV, *KIDX; float *WIDX, *SSQ; bf16_t* HQ; float* HLF; bf16_t *HV, *HG; const float* lb; const float* rs; const float* cs;
    __device__ __forceinline__ void operator()(const f32x4 (&acc)[2][2][4][2], const Unit& u, int wr, int wc, int fr, int fq) const {
        const int row0 = u.pm * BM + wr * 64 + fr, pn = u.pn;
        f32x4 cv[2][2];
#pragma unroll
        for (int bj = 0; bj < 2; ++bj)
#pragma unroll
            for (int n = 0; n < 2; ++n) cv[bj][n] = *(const f32x4*)(cs + pn * BM + bj * HALF + wc * 32 + 8 * fq + 4 * n);
#define PJ_A(ai, bj, m, n, sr) (__builtin_convertvector(__builtin_bit_cast(pg8_i32x4, acc[ai][bj][m][n]), f32x4) * (sr) * cv[bj][n])
        if (pn < 6) {
            bf16_t* base = pn < 4 ? QLAT : QIDX; const int ld = pn < 4 ? 1024 : 512; const int col0 = (pn < 4 ? pn : pn - 4) * BM + wc * 32 + 8 * fq;
#pragma unroll
            for (int ai = 0; ai < 2; ++ai)
#pragma unroll
                for (int m = 0; m < 4; ++m) { const int row = row0 + ai * HALF + m * 16; const float sr = rs[row]; bf16_t* rowp = base + (size_t)row * ld + col0;
#pragma unroll
                    for (int bj = 0; bj < 2; ++bj) *(u32x4*)(rowp + bj * HALF) = pack8(PJ_A(ai, bj, m, 0, sr), PJ_A(ai, bj, m, 1, sr)); }
        } else if (pn == 6) {
#pragma unroll
            for (int ai = 0; ai < 2; ++ai)
#pragma unroll
                for (int m = 0; m < 4; ++m) { const size_t r = (size_t)(row0 + ai * HALF + m * 16); const float sr = rs[r];
                    const f32x4 v0 = PJ_A(ai, 0, m, 0, sr), v1 = PJ_A(ai, 0, m, 1, sr);
                    *(u32x4*)(CKV + r * 128 + wc * 32 + 8 * fq) = pack8(v0, v1);
                    float ss = v0[0] * v0[0] + v0[1] * v0[1] + v0[2] * v0[2] + v0[3] * v0[3] + v1[0] * v1[0] + v1[1] * v1[1] + v1[2] * v1[2] + v1[3] * v1[3];
                    ss += __shfl_xor(ss, 16); ss += __shfl_xor(ss, 32);
                    if (fq == 0) SSQ[r * 4 + wc] = ss;
                    const f32x4 w0 = PJ_A(ai, 1, m, 0, sr), w1 = PJ_A(ai, 1, m, 1, sr);
                    if (wc < 2) *(u32x4*)(KIDX + r * 64 + wc * 32 + 8 * fq) = pack8(w0, w1);
                    else if (wc == 2 && fq == 0) { *(f32x4*)(WIDX + r * 8) = w0; *(f32x4*)(WIDX + r * 8 + 4) = w1; } }
        } else {
            const int h = pn - 7; const int e0 = (wc & 1) * 32 + 8 * fq;
            f32x4 l0 = {0.f, 0.f, 0.f, 0.f}, l1 = l0;
            if (wc >= 2) { l0 = *(const f32x4*)(lb + h * 64 + e0); l1 = *(const f32x4*)(lb + h * 64 + e0 + 4); }
#pragma unroll
            for (int ai = 0; ai < 2; ++ai)
#pragma unroll
                for (int m = 0; m < 4; ++m) { const int row = row0 + ai * HALF + m * 16; const float sr = rs[row]; const size_t o = (size_t)row * 512 + h * 64 + e0;
                    const f32x4 a0 = PJ_A(ai, 0, m, 0, sr), a1 = PJ_A(ai, 0, m, 1, sr), b0 = PJ_A(ai, 1, m, 0, sr), b1 = PJ_A(ai, 1, m, 1, sr);
                    if (wc < 2) {
                        *(u32x4*)(HQ + o) = pack8(silu4(a0), silu4(a1));
                        *(u32x4*)(HV + o) = pack8(b0, b1);
                    } else {
                        f32x4 f0, f1;
#pragma unroll
                        for (int j = 0; j < 4; ++j) { f0[j] = __builtin_amdgcn_logf(l0[j] + (1.f - l0[j]) * ep_sig(a0[j])) * 0.6931471805599453f; f1[j] = __builtin_amdgcn_logf(l1[j] + (1.f - l1[j]) * ep_sig(a1[j])) * 0.6931471805599453f; }
                        *(f32x4*)(HLF + o) = f0; *(f32x4*)(HLF + o + 4) = f1;
                        *(u32x4*)(HG + o) = pack8(silu4(b0), silu4(b1));
                    } }
        }
#undef PJ_A
    }
};
template <bool I8> __device__ __forceinline__ f32x4 mma_sel(const bf16x8& a, const bf16x8& b, const f32x4& c) {
    if constexpr (I8) return __builtin_bit_cast(f32x4, __builtin_amdgcn_mfma_i32_16x16x64_i8(__builtin_bit_cast(pg8_i32x4, a), __builtin_bit_cast(pg8_i32x4, b), __builtin_bit_cast(pg8_i32x4, c), 0, 0, 0));
    else return __builtin_amdgcn_mfma_f32_16x16x32_bf16(a, b, c, 0, 0, 0);
}
template <class Epi, class Sched, bool ALIGN_EPI = false, bool SP2 = false, bool I8 = false, int KSW = 0>
__device__ __forceinline__ void gemm_phase(PG8_LAS unsigned char* lds, const Gemm g, const Sched& S, const Epi& E) {
    const int tid = threadIdx.x, wid = __builtin_amdgcn_readfirstlane(tid >> 6), lane = tid & 63, wr = wid >> 2, wc = wid & 3, fr = lane & 15, fq = lane >> 4;
    const int K = g.K, nt = K / BK;
    unsigned voffA[2], voffB[2];
#pragma unroll
    for (int i = 0; i < 2; ++i) { int R, C; stage_rc(tid * 16 + i * 8192, R, C); const int Rb = Epi::PERM ? ((R & ~31) + perm32(R & 31)) : R;
        voffA[i] = (unsigned)(R * K + C) * 2u; voffB[i] = (unsigned)(Rb * K + C) * 2u; }
    const size_t kstep = (size_t)(BK * 2);
    const size_t hstep = (size_t)HALF * K * 2;
    const size_t tstep = 2 * hstep;
    const unsigned ldsw = (unsigned)wid * 1024u;
    const int aoff = lds_byte(wr * 64 + fr, fq * 8), boff = lds_byte(wc * 32 + fr, fq * 8);
#define PG8_SA(b, h) (((b) * 2 + (h)) * HTB)
#define PG8_SB(b, h) ((4 + (b) * 2 + (h)) * HTB)
#define PG8_STAGE(bufoff, gbase, voff) do { _Pragma("unroll") for (int _i = 0; _i < 2; ++_i) \
        __builtin_amdgcn_global_load_lds((const unsigned*)((const char*)(gbase) + (voff)[_i]), (PG8_LAS unsigned*)(lds + (bufoff) + ldsw + _i * 8192), 16, 0, 0); } while (0)
#define PG8_LDA(dst, b, h) do { _Pragma("unroll") for (int m = 0; m < 4; ++m) _Pragma("unroll") for (int k = 0; k < 2; ++k) dst[m][k] = *(const PG8_LAS bf16x8*)(lds + PG8_SA(b, h) + aoff + m * 2048 + k * 1024); } while (0)
#define PG8_LDB(dst, b, h) do { _Pragma("unroll") for (int n = 0; n < 2; ++n) _Pragma("unroll") for (int k = 0; k < 2; ++k) dst[n][k] = *(const PG8_LAS bf16x8*)(lds + PG8_SB(b, h) + boff + n * 2048 + k * 1024); } while (0)
#define PG8_MMA_LOOP(ai, bj, At, Bt, SEL) _Pragma("unroll") for (int m = 0; m < 4; ++m) _Pragma("unroll") for (int n = 0; n < 2; ++n) _Pragma("unroll") for (int k = 0; k < 2; ++k) \
        acc[ai][bj][m][n] = mma_sel<SEL>(Bt[n][k], At[m][k], acc[ai][bj][m][n]);
#define PG8_MMA(ai, bj, At, Bt) do { __builtin_amdgcn_s_setprio(1); \
        if constexpr (KSW > 0) { if (i8m) { PG8_MMA_LOOP(ai, bj, At, Bt, true) } else { PG8_MMA_LOOP(ai, bj, At, Bt, false) } } else { PG8_MMA_LOOP(ai, bj, At, Bt, I8) } \
        __builtin_amdgcn_s_setprio(0); } while (0)
#define PG8_WAIT_V(n) asm volatile("s_waitcnt vmcnt(" #n ")" ::: "memory")
#define PG8_WAIT_L(n) asm volatile("s_waitcnt lgkmcnt(" #n ")" ::: "memory")
#define PG8_BAR __builtin_amdgcn_s_barrier()
#define PG8_SCHED __builtin_amdgcn_sched_barrier(0)
    Unit cur, nxt; int ui = 0;
    if (!S.next(0, cur)) return;
    f32x4 acc[2][2][4][2];
#pragma unroll
    for (int a = 0; a < 2; ++a)
#pragma unroll
        for (int b = 0; b < 2; ++b)
#pragma unroll
            for (int m = 0; m < 4; ++m)
#pragma unroll
                for (int n = 0; n < 2; ++n) acc[a][b][m][n] = (f32x4){0.f, 0.f, 0.f, 0.f};
    bf16x8 At[4][2], B0[2][2], B1[2][2];
    const char* cA = (const char*)g.A + (size_t)cur.pm * tstep; const char* cB = (const char*)g.Bt + (size_t)cur.pn * tstep;
    S.a_ready(cur);
    if constexpr (SP2) {
        PG8_STAGE(PG8_SB(0, 0), cB, voffB); PG8_STAGE(PG8_SB(0, 1), cB + hstep, voffB); PG8_STAGE(PG8_SA(0, 0), cA, voffA); PG8_STAGE(PG8_SA(0, 1), cA + hstep, voffA);
        if (wr == 1) PG8_BAR;
        PG8_WAIT_V(2); PG8_BAR;
        PG8_STAGE(PG8_SB(1, 0), cB + kstep, voffB); PG8_STAGE(PG8_SA(1, 0), cA + kstep, voffA); PG8_STAGE(PG8_SB(1, 1), cB + hstep + kstep, voffB);
        PG8_WAIT_V(6); PG8_BAR;
    } else {
        PG8_STAGE(PG8_SB(0, 0), cB, voffB); PG8_STAGE(PG8_SA(0, 0), cA, voffA); PG8_STAGE(PG8_SB(0, 1), cB + hstep, voffB); PG8_STAGE(PG8_SA(0, 1), cA + hstep, voffA);
        if (wr == 1) PG8_BAR;
        PG8_WAIT_V(4); PG8_BAR;
        PG8_STAGE(PG8_SB(1, 0), cB + kstep, voffB); PG8_STAGE(PG8_SA(1, 0), cA + kstep, voffA); PG8_STAGE(PG8_SB(1, 1), cB + hstep + kstep, voffB);
        PG8_WAIT_V(6); PG8_BAR;
    }
    for (;;) {
        const bool has_next = S.next(ui + 1, nxt);
        const char* nA = has_next ? (const char*)g.A + (size_t)nxt.pm * tstep : cA; const char* nB = has_next ? (const char*)g.Bt + (size_t)nxt.pn * tstep : cB;
#pragma unroll
        for (int seg = 0; seg < (KSW > 0 ? 2 : 1); ++seg) {
        const bool i8m = (seg == 0); (void)i8m;
        if constexpr (KSW > 0) { if (seg == 1) E.to_float(acc, cur, wr, wc, fr, fq); }
        for (int t = (seg ? KSW : 0); t < ((KSW > 0 && seg == 0) ? KSW : nt); t += 2) {
            const bool last = (t == nt - 2);
            const char* a1 = cA + (size_t)(t + 1) * kstep;
            const char* a2 = last ? nA : cA + (size_t)(t + 2) * kstep; const char* b2 = last ? nB : cB + (size_t)(t + 2) * kstep;
            const char* a3 = a2 + kstep; const char* b3 = b2 + kstep;
            if (last && has_next) S.a_ready(nxt);
            if constexpr (SP2) {
            PG8_LDB(B0, 0, 0); PG8_LDB(B1, 0, 1); PG8_SCHED; PG8_LDA(At, 0, 0); PG8_STAGE(PG8_SA(1, 1), a1 + hstep, voffA);
            PG8_WAIT_V(8); PG8_WAIT_L(0); PG8_BAR; PG8_MMA(0, 0, At, B0); PG8_MMA(0, 1, At, B1); PG8_BAR; PG8_SCHED;
            PG8_LDA(At, 0, 1); PG8_STAGE(PG8_SB(0, 0), b2, voffB); PG8_STAGE(PG8_SB(0, 1), b2 + hstep, voffB); PG8_STAGE(PG8_SA(0, 0), a2, voffA);
            PG8_WAIT_V(8); PG8_WAIT_L(0); PG8_BAR; PG8_MMA(1, 0, At, B0); PG8_MMA(1, 1, At, B1); PG8_BAR; PG8_SCHED;
            PG8_LDB(B0, 1, 0); PG8_LDB(B1, 1, 1); PG8_SCHED; PG8_LDA(At, 1, 0); PG8_STAGE(PG8_SA(0, 1), a2 + hstep, voffA);
            PG8_WAIT_V(8); PG8_WAIT_L(0); PG8_BAR; PG8_MMA(0, 0, At, B0); PG8_MMA(0, 1, At, B1); PG8_BAR; PG8_SCHED;
            PG8_LDA(At, 1, 1); PG8_STAGE(PG8_SB(1, 0), b3, voffB); PG8_STAGE(PG8_SB(1, 1), b3 + hstep, voffB); PG8_STAGE(PG8_SA(1, 0), a3, voffA);
            PG8_WAIT_V(8); PG8_WAIT_L(0); PG8_BAR; PG8_MMA(1, 0, At, B0); PG8_MMA(1, 1, At, B1); PG8_BAR; PG8_SCHED;
            } else {
            PG8_LDB(B0, 0, 0); PG8_SCHED; PG8_LDA(At, 0, 0); PG8_STAGE(PG8_SA(1, 1), a1 + hstep, voffA);
            PG8_WAIT_L(8); PG8_BAR; PG8_WAIT_L(0); PG8_MMA(0, 0, At, B0); PG8_BAR; PG8_SCHED;
            PG8_LDB(B1, 0, 1); PG8_STAGE(PG8_SB(0, 0), b2, voffB);
            PG8_BAR; PG8_WAIT_L(0); PG8_MMA(0, 1, At, B1); PG8_BAR;
            PG8_LDA(At, 0, 1); PG8_STAGE(PG8_SA(0, 0), a2, voffA);
            PG8_BAR; PG8_WAIT_L(0); PG8_MMA(1, 0, At, B0); PG8_BAR; PG8_SCHED;
            PG8_STAGE(PG8_SB(0, 1), b2 + hstep, voffB);
            PG8_WAIT_V(6); PG8_BAR; PG8_MMA(1, 1, At, B1); PG8_BAR;
            PG8_LDB(B0, 1, 0); PG8_SCHED; PG8_LDA(At, 1, 0); PG8_STAGE(PG8_SA(0, 1), a2 + hstep, voffA);
            PG8_WAIT_L(8); PG8_BAR; PG8_WAIT_L(0); PG8_MMA(0, 0, At, B0); PG8_BAR; PG8_SCHED;
            PG8_LDB(B1, 1, 1); PG8_STAGE(PG8_SB(1, 0), b3, voffB);
            PG8_BAR; PG8_WAIT_L(0); PG8_MMA(0, 1, At, B1); PG8_BAR;
            PG8_LDA(At, 1, 1); PG8_STAGE(PG8_SA(1, 0), a3, voffA);
            PG8_BAR; PG8_WAIT_L(0); PG8_MMA(1, 0, At, B0); PG8_BAR; PG8_SCHED;
            PG8_STAGE(PG8_SB(1, 1), b3 + hstep, voffB);
            PG8_WAIT_V(6); PG8_BAR; PG8_MMA(1, 1, At, B1); PG8_BAR;
            }
        }
        }
        if constexpr (ALIGN_EPI) { if (wr == 0) PG8_BAR; }
        if constexpr (!Epi::AFTER_DRAIN) { E(acc, cur, wr, wc, fr, fq); S.done(cur); }
        if (!has_next) break;
#pragma unroll
        for (int a = 0; a < 2; ++a)
#pragma unroll
            for (int b = 0; b < 2; ++b)
#pragma unroll
                for (int m = 0; m < 4; ++m)
#pragma unroll
                    for (int n = 0; n < 2; ++n) acc[a][b][m][n] = (f32x4){0.f, 0.f, 0.f, 0.f};
        cur = nxt; cA = nA; cB = nB; ++ui;
        if constexpr (ALIGN_EPI) { if (wr == 1) PG8_BAR; }
    }
    PG8_WAIT_V(0);
    if constexpr (!ALIGN_EPI) { if (wr == 0) PG8_BAR; }
    PG8_BAR;
    if constexpr (Epi::AFTER_DRAIN) { E.fused(acc, cur, wr, wc, fr, fq, lds, wid, lane); S.done(cur); }
#undef PG8_SA
#undef PG8_SB
#undef PG8_STAGE
#undef PG8_LDA
#undef PG8_LDB
#undef PG8_MMA
#undef PG8_MMA_LOOP
#undef PG8_WAIT_V
#undef PG8_WAIT_L
#undef PG8_BAR
#undef PG8_SCHED
}
}

struct Args { const float* in[16]; float* out; unsigned char* ws; int ph_lo, ph_hi; };
enum { I_X = 0, I_WIN, I_KVG, I_WUK, I_WUV, I_LBL, I_HGN, I_WOUT, I_LN1G, I_LN1B, I_PWQ, I_PSK, I_PU, I_PV, I_LN2G, I_LN2B };

struct Ctx {
    LAS unsigned char* lds; int tid, lane, wave; int G, bid;
    const float* in[16]; float* out; unsigned char* ws;
};

template <class ColMap>
__device__ __forceinline__ void tr_tile(const Ctx& C, const float* src, int ld_src, int k0, int n0, const ColMap& cm, u16* dst, int ld_dst, int koff) {
    LAS float* T = (LAS float*)C.lds;
    const int nn = C.tid & 63, kq = C.tid >> 6;
    const int col = cm(n0 + nn);
#pragma unroll
    for (int i = 0; i < 8; ++i) { const int kk = kq + 8 * i; T[kk * 65 + nn] = col >= 0 ? src[(size_t)(k0 + kk) * ld_src + col] : 0.f; }
    __syncthreads();
    const int kk2 = C.tid & 63, nq = C.tid >> 6;
#pragma unroll
    for (int i = 0; i < 8; ++i) { const int n2 = nq + 8 * i; const float v = T[kk2 * 65 + n2];
        dst[(size_t)(n0 + n2) * ld_dst + koff + k0 + kk2] = (u16)(cvtpk(v, 0.f) & 0xffffu); }
    __syncthreads();
}

__device__ __forceinline__ int w1_col(int n) {
    if (n < 1536) return 640 + (n - 1024);
    if (n < 1792) { const int j = n - 1536; return j < 128 ? 512 + j : (j < 192 ? 1152 + (j - 128) : (j < 200 ? 1216 + (j - 192) : -1)); }
    const int j = n - 1792, h = j >> 8, part = (j & 255) >> 6, e = j & 63;
    return 1224 + part * 512 + h * 64 + e;
}

__device__ __forceinline__ void cvt_copy(const Ctx& C, const float* src, u16* dst, size_t n8) {
    const size_t stride = (size_t)C.G * NTHREADS;
    for (size_t i = (size_t)C.bid * NTHREADS + C.tid; i < n8; i += stride) {
        const f32x4v a = *(const f32x4v*)(src + i * 8), b = *(const f32x4v*)(src + i * 8 + 4);
        u32x4v w; w.x = cvtpk(a[0], a[1]); w.y = cvtpk(a[2], a[3]); w.z = cvtpk(b[0], b[1]); w.w = cvtpk(b[2], b[3]);
        *(u32x4v*)(dst + i * 8) = w;
    }
}

__device__ __forceinline__ void quant_rows_fp8(const Ctx& C, const float* src, unsigned char* dst, float* inv, int nrows) {
    const int lane = C.lane, gw = C.bid * 8 + C.wave, nw = C.G * 8;
    for (int r = gw; r < nrows; r += nw) {
        f32x4v v[4];
#pragma unroll
        for (int i = 0; i < 4; ++i) v[i] = *(const f32x4v*)(src + (size_t)r * 1024 + lane * 16 + 4 * i);
        float am = 0.f;
#pragma unroll
        for (int i = 0; i < 4; ++i) am = fmaxf(am, fmaxf(fmaxf(fabsf(v[i][0]), fabsf(v[i][1])), fmaxf(fabsf(v[i][2]), fabsf(v[i][3]))));
        am = wave_max_f(am);
        const int e = (int)((__builtin_bit_cast(unsigned, am) >> 23) & 0xffu) - 126;
        int k = 8 - e; k = k > 100 ? 100 : (k < -100 ? -100 : k); if (am == 0.f) k = 0;
        const float s = __builtin_bit_cast(float, (unsigned)(127 + k) << 23), si = __builtin_bit_cast(float, (unsigned)(127 - k) << 23);
        u32x4v w;
#pragma unroll
        for (int i = 0; i < 4; ++i) { int t = 0; t = __builtin_amdgcn_cvt_pk_fp8_f32(v[i][0] * s, v[i][1] * s, t, false); t = __builtin_amdgcn_cvt_pk_fp8_f32(v[i][2] * s, v[i][3] * s, t, true); w[i] = (unsigned)t; }
        *(u32x4v*)(dst + ((size_t)(lane >> 3) * nrows + r) * 128 + (lane & 7) * 16) = w;
        if (lane == 0) inv[r] = si;
    }
}

template <bool SLICED = true>
__device__ __forceinline__ void quant_rows_i8(const Ctx& C, const float* src, unsigned char* dst, float* inv, int nrows) {
    const int lane = C.lane, gw = C.bid * 8 + C.wave, nw = C.G * 8;
    f32x4v vn[4];
    if (gw < nrows) {
#pragma unroll
        for (int i = 0; i < 4; ++i) vn[i] = *(const f32x4v*)(src + (size_t)gw * 1024 + lane * 16 + 4 * i); }
    for (int r = gw; r < nrows; r += nw) {
        f32x4v v[4];
#pragma unroll
        for (int i = 0; i < 4; ++i) v[i] = vn[i];
        { const int rn = r + nw < nrows ? r + nw : r;
#pragma unroll
          for (int i = 0; i < 4; ++i) vn[i] = *(const f32x4v*)(src + (size_t)rn * 1024 + lane * 16 + 4 * i); }
        float am = 0.f;
#pragma unroll
        for (int i = 0; i < 4; ++i) am = fmaxf(am, fmaxf(fmaxf(fabsf(v[i][0]), fabsf(v[i][1])), fmaxf(fabsf(v[i][2]), fabsf(v[i][3]))));
        am = wave_max_f(am);
        const float s = am > 0.f ? 127.f / am : 0.f;
        u32x4v w;
#pragma unroll
        for (int i = 0; i < 4; ++i) w[i] = pack_i8(v[i][0] * s, v[i][1] * s, v[i][2] * s, v[i][3] * s);
        if constexpr (SLICED) *(u32x4v*)(dst + ((size_t)(lane >> 3) * nrows + r) * 128 + (lane & 7) * 16) = w;
        else *(u32x4v*)(dst + (size_t)r * 1024 + lane * 16) = w;
        if (lane == 0) inv[r] = am * (1.f / 127.f);
    }
}

__device__ __forceinline__ void quant_wrows_i8(const Ctx& C, const u16* src, unsigned char* dst, float* sc, int nrows) {
    const int lane = C.lane, gw = C.bid * 8 + C.wave, nw = C.G * 8;
    for (int r = gw; r < nrows; r += nw) {
        const u32x4v y0 = *(const u32x4v*)(src + (size_t)r * 1024 + lane * 16), y1 = *(const u32x4v*)(src + (size_t)r * 1024 + lane * 16 + 8);
        float v[16]; float am = 0.f;
#pragma unroll
        for (int j = 0; j < 4; ++j) { v[2 * j] = bf_lo(y0[j]); v[2 * j + 1] = bf_hi(y0[j]); v[8 + 2 * j] = bf_lo(y1[j]); v[8 + 2 * j + 1] = bf_hi(y1[j]); }
#pragma unroll
        for (int j = 0; j < 16; ++j) am = fmaxf(am, fabsf(v[j]));
        am = wave_max_f(am);
        const float s = am > 0.f ? 127.f / am : 0.f;
        u32x4v w;
#pragma unroll
        for (int i = 0; i < 4; ++i) w[i] = pack_i8(v[4 * i] * s, v[4 * i + 1] * s, v[4 * i + 2] * s, v[4 * i + 3] * s);
        *(u32x4v*)(dst + (size_t)r * 1024 + lane * 16) = w;
        if (lane == 0) sc[r] = am * (1.f / 127.f);
    }
}
__device__ __forceinline__ void quant_w3_mixed(const Ctx& C) {
    const u16* src = (const u16*)(C.ws + WS_W3T); unsigned char* dst = C.ws + WS_W3M; float* sc = (float*)(C.ws + WS_W3S);
    const int lane = C.lane, gw = C.bid * 8 + C.wave, nw = C.G * 8;
    for (int r = gw; r < DM; r += nw) {
        const u32x4v y0 = *(const u32x4v*)(src + (size_t)r * K3 + lane * 16), y1 = *(const u32x4v*)(src + (size_t)r * K3 + lane * 16 + 8);
        const u32x4v hb = *(const u32x4v*)(src + (size_t)r * K3 + 1024 + lane * 8);
        float v[16]; float am = 0.f;
#pragma unroll
        for (int j = 0; j < 4; ++j) { v[2 * j] = bf_lo(y0[j]); v[2 * j + 1] = bf_hi(y0[j]); v[8 + 2 * j] = bf_lo(y1[j]); v[8 + 2 * j + 1] = bf_hi(y1[j]); }
#pragma unroll
        for (int j = 0; j < 16; ++j) am = fmaxf(am, fabsf(v[j]));
        am = wave_max_f(am);
        if (am == 0.f) am = 127.f;
        const float s = 127.f / am;
        u32x4v w, hs;
#pragma unroll
        for (int i = 0; i < 4; ++i) { w[i] = pack_i8(v[4 * i] * s, v[4 * i + 1] * s, v[4 * i + 2] * s, v[4 * i + 3] * s); hs[i] = cvtpk(bf_lo(hb[i]) * s, bf_hi(hb[i]) * s); }
        *(u32x4v*)(dst + (size_t)r * MIXB + lane * 16) = w;
        *(u32x4v*)(dst + (size_t)r * MIXB + 1024 + lane * 16) = hs;
        if (lane == 0) sc[r] = am * (1.f / 127.f);
    }
}
__device__ __forceinline__ void p0b_quant(const Ctx& C) {
    quant_w3_mixed(C);
    quant_wrows_i8(C, (const u16*)(C.ws + WS_W5T), C.ws + WS_W5Q, (float*)(C.ws + WS_W5S), NPQ);
    quant_wrows_i8(C, (const u16*)(C.ws + WS_W1T), C.ws + WS_W1Q, (float*)(C.ws + WS_W1S), N1);
}

__device__ __forceinline__ void p0_prologue(const Ctx& C) {
    unsigned char* ws = C.ws;
    if (C.bid == 0 && C.tid < 64) ((unsigned*)(ws + WS_CTL))[C.tid] = 0u;
    if (C.bid == 0) {
        const float* l = C.in[I_LBL]; float* lb = (float*)(ws + WS_LB);
        const float a = l[C.tid], b = l[512 + C.tid]; lb[C.tid] = 1.f / (1.f + expf(b - a));
    }
    quant_rows_i8<false>(C, C.in[I_X], ws + WS_XB, (float*)(ws + WS_XS), MTOK);
    quant_rows_i8(C, C.in[I_PU], ws + WS_UB, (float*)(ws + WS_USC), 16384);
    quant_rows_i8(C, C.in[I_PV], ws + WS_VB, (float*)(ws + WS_VSC), 16384);
    cvt_copy(C, C.in[I_PSK], (u16*)(ws + WS_SKB), (size_t)8 * 2 * 128 * 128 / 8);
    const float* w_in = C.in[I_WIN]; const float* w_out = C.in[I_WOUT]; const float* wq = C.in[I_PWQ];
    const float* kvg = C.in[I_KVG]; const float* wuk = C.in[I_WUK]; const float* wuv = C.in[I_WUV];
    u16* W1T = (u16*)(ws + WS_W1T); u16* W3T = (u16*)(ws + WS_W3T); u16* W5T = (u16*)(ws + WS_W5T);
    constexpr int T_W1F = 256, T_W1P = 44 * 16, T_W3F = 256, T_W3P = 16 * 8, T_W5 = 32 * 16, T_ALL = T_W1F + T_W1P + T_W3F + T_W3P + T_W5;
    LAS float* TA = (LAS float*)C.lds;
    LAS float* TB = TA + 64 * 65;
    for (int task = C.bid; task < T_ALL; task += C.G) {
        int t = task;
        if (t < T_W1F) {
            const int h = t >> 5, cb = (t >> 4) & 1, kb = t & 15, c0 = cb * 64, k0 = kb * 64;
            { const int d = C.tid & 63, q = C.tid >> 6;
#pragma unroll
              for (int i = 0; i < 8; ++i) { const int r = q + 8 * i; TA[r * 65 + d] = w_in[(size_t)(k0 + r) * DIN + h * 64 + d]; TB[r * 65 + d] = wuk[(size_t)(h * 128 + c0 + r) * 64 + d]; } }
            __syncthreads();
            { const int kk = C.tid & 63, q = C.tid >> 6;
#pragma unroll
              for (int i = 0; i < 8; ++i) { const int cc = q + 8 * i; float s = 0.f;
#pragma unroll 8
                  for (int d = 0; d < 64; ++d) s += TA[kk * 65 + d] * TB[cc * 65 + d];
                  s *= kvg[c0 + cc] * 0.125f;
                  W1T[(size_t)(h * 128 + c0 + cc) * 1024 + k0 + kk] = (u16)(cvtpk(s, 0.f) & 0xffffu); } }
            __syncthreads();
            continue;
        }
        t -= T_W1F;
        if (t < T_W1P) { const int nb = t >> 4, kb = t & 15; tr_tile(C, w_in, DIN, kb * 64, 1024 + nb * 64, [](int n) { return w1_col(n); }, W1T, 1024, 0); continue; }
        t -= T_W1P;
        if (t < T_W3F) {
            const int h = t >> 5, cb = (t >> 4) & 1, nb = t & 15, c0 = cb * 64, n0 = nb * 64;
            { const int x = C.tid & 63, q = C.tid >> 6;
#pragma unroll
              for (int i = 0; i < 8; ++i) { const int r = q + 8 * i; TA[r * 65 + x] = w_out[(size_t)(h * 64 + r) * 1024 + n0 + x]; TB[r * 65 + x] = wuv[(size_t)(h * 128 + c0 + r) * 64 + x]; } }
            __syncthreads();
            { const int cc = C.tid & 63, q = C.tid >> 6;
#pragma unroll
              for (int i = 0; i < 8; ++i) { const int nn = q + 8 * i; float s = 0.f;
#pragma unroll 8
                  for (int d = 0; d < 64; ++d) s += TB[cc * 65 + d] * TA[d * 65 + nn];
                  s *= kvg[c0 + cc];
                  W3T[(size_t)(n0 + nn) * K3 + h * 128 + c0 + cc] = (u16)(cvtpk(s, 0.f) & 0xffffu); } }
            __syncthreads();
            continue;
        }
        t -= T_W3F;
        if (t < T_W3P) { const int nb = t >> 3, kb = t & 7; tr_tile(C, w_out + (size_t)512 * 1024, 1024, kb * 64, nb * 64, [](int n) { return n; }, W3T, K3, 1024); continue; }
        t -= T_W3P;
        { const int nb = t >> 4, kb = t & 15; tr_tile(C, wq, NPQ, kb * 64, nb * 64, [](int n) { return n; }, W5T, 1024, 0); }
    }
}

#ifndef MK_CUSTOM_BAR
#define MK_CUSTOM_BAR 0
#endif
__device__ __forceinline__ void grid_bar(const Ctx& C, unsigned& target, int word = 24) {
    __syncthreads();
    if (C.tid == 0) {
        unsigned* ctr = (unsigned*)(C.ws + WS_CTL) + word;
        __builtin_amdgcn_fence(__ATOMIC_RELEASE, "agent");
        asm volatile("s_waitcnt vmcnt(0)" ::: "memory");
        __hip_atomic_fetch_add(ctr, 1u, __ATOMIC_RELAXED, __HIP_MEMORY_SCOPE_AGENT);
        target += (unsigned)C.G;
        for (unsigned spin = 0; spin < (1u << 24); ++spin) { if (__hip_atomic_load(ctr, __ATOMIC_RELAXED, __HIP_MEMORY_SCOPE_AGENT) >= target) break; __builtin_amdgcn_s_sleep(1); }
        __builtin_amdgcn_fence(__ATOMIC_ACQUIRE, "agent");
        asm volatile("s_waitcnt vmcnt(0)" ::: "memory");
    }
    __syncthreads();
}


__device__ __forceinline__ f32x4v mfma16(s16x8 a, s16x8 b, f32x4v c) { return __builtin_amdgcn_mfma_f32_16x16x32_bf16(a, b, c, 0, 0, 0); }
__device__ __forceinline__ f32x16v mfma32(s16x8 a, s16x8 b, f32x16v c) { return __builtin_amdgcn_mfma_f32_32x32x16_bf16(a, b, c, 0, 0, 0); }
__device__ __forceinline__ s16x4 tr4(const LAS u16* p) { return __builtin_bit_cast(s16x4, __builtin_amdgcn_ds_read_tr16_b64_v4i16((LAS s16x4*)p)); }
__device__ __forceinline__ s16x8 cat4(s16x4 a, s16x4 b) { s16x8 r; r[0] = a[0]; r[1] = a[1]; r[2] = a[2]; r[3] = a[3]; r[4] = b[0]; r[5] = b[1]; r[6] = b[2]; r[7] = b[3]; return r; }
__device__ __forceinline__ s16x8 pack8f(const f32x4v& a, const f32x4v& b) { u32x4v w; w.x = cvtpk(a[0], a[1]); w.y = cvtpk(a[2], a[3]); w.z = cvtpk(b[0], b[1]); w.w = cvtpk(b[2], b[3]); return __builtin_bit_cast(s16x8, w); }

__device__ __forceinline__ float scan32_incl(float v) {
    v += __builtin_bit_cast(float, __builtin_amdgcn_update_dpp(0, __builtin_bit_cast(int, v), 0x111, 0xf, 0xf, true));
    v += __builtin_bit_cast(float, __builtin_amdgcn_update_dpp(0, __builtin_bit_cast(int, v), 0x112, 0xf, 0xf, true));
    v += __builtin_bit_cast(float, __builtin_amdgcn_update_dpp(0, __builtin_bit_cast(int, v), 0x114, 0xf, 0xf, true));
    v += __builtin_bit_cast(float, __builtin_amdgcn_update_dpp(0, __builtin_bit_cast(int, v), 0x118, 0xf, 0xf, true));
    v += __builtin_bit_cast(float, __builtin_amdgcn_update_dpp(0, __builtin_bit_cast(int, v), 0x142, 0xa, 0xf, false));
    return v;
}
constexpr int HG_SET = 16640, HG_OI = 2 * HG_SET, HG_SSQ = HG_OI + 2 * 8192;

__device__ __forceinline__ void hgrn_seq(const Ctx& C, int bh) {
    const int b = bh >> 3, h = bh & 7;
    const int tid = C.tid, lane = C.lane, wave = C.wave, fr = lane & 15, fq = lane >> 4;
    unsigned char* ws = C.ws;
    const u16* HQ = (const u16*)(ws + WS_HQ); const float* HLF = (const float*)(ws + WS_HLF); const u16* HV = (const u16*)(ws + WS_HV); const u16* HG = (const u16*)(ws + WS_HG);
    u16* MIX = (u16*)(ws + WS_MIX);
    const size_t rowbase = (size_t)b * SEQ;
    constexpr int NCH = SEQ / 32;
    LAS float* SSQ = (LAS float*)(C.lds + HG_SSQ);
    if (wave >= 4) {
        const int t = lane & 31, cg = (tid - 256) >> 5;
        f32x4v gn0 = *(const f32x4v*)(C.in[I_HGN] + 8 * cg), gn1 = *(const f32x4v*)(C.in[I_HGN] + 8 * cg + 4);
        f32x4v lfa[4], lfb[4]; u32x4v qv[4], vv[4], gg[4]; u32x4v gp1 = {0u, 0u, 0u, 0u}, gp2 = gp1;
#define HG_LOAD(k_, n_) do { const int nc_ = (n_) < NCH ? (n_) : NCH - 1; const size_t o_ = (rowbase + (size_t)nc_ * 32 + t) * 512 + h * 64 + 8 * cg; lfa[k_] = *(const f32x4v*)(HLF + o_); lfb[k_] = *(const f32x4v*)(HLF + o_ + 4); \
            qv[k_] = *(const u32x4v*)(HQ + o_); vv[k_] = *(const u32x4v*)(HV + o_); gg[k_] = *(const u32x4v*)(HG + o_); } while (0)
        HG_LOAD(0, 0); HG_LOAD(1, 1); HG_LOAD(2, 2); HG_LOAD(3, 3);
#define S_BODY(n, k) { \
              \
            if ((n) >= 1) { \
                const LAS float* OI = (const LAS float*)(C.lds + HG_OI) + (((n) - 1) & 1) * 2048; \
                const LAS float* sq = SSQ + (((n) - 1) & 1) * 128; \
                const float rstd = __builtin_amdgcn_rsqf(((sq[t] + sq[32 + t]) + (sq[64 + t] + sq[96 + t])) * (1.f / 64.f) + EPS); \
                float o[8]; \
                _Pragma("unroll") for (int j = 0; j < 8; ++j) o[j] = OI[(8 * cg + j) * 32 + t] * rstd; \
                u32x4v w; \
                w.x = cvtpk(o[0] * gn0[0] * bf_lo(gp2.x), o[1] * gn0[1] * bf_hi(gp2.x)); w.y = cvtpk(o[2] * gn0[2] * bf_lo(gp2.y), o[3] * gn0[3] * bf_hi(gp2.y)); \
                w.z = cvtpk(o[4] * gn1[0] * bf_lo(gp2.z), o[5] * gn1[1] * bf_hi(gp2.z)); w.w = cvtpk(o[6] * gn1[2] * bf_lo(gp2.w), o[7] * gn1[3] * bf_hi(gp2.w)); \
                *(u32x4v*)(MIX + (rowbase + (size_t)((n) - 1) * 32 + t) * (MIXB / 2) + 512 + h * 64 + 8 * cg) = w;     \
            } \
              \
            if ((n) + 1 < NCH) { \
                LAS unsigned char* S_ = C.lds + (((n) + 1) & 1) * HG_SET; \
                LAS u16* QT = (LAS u16*)S_; LAS u16* KT = QT + 2048; LAS u16* KDT = KT + 2048; LAS u16* VS = KDT + 2048; LAS float* DEC = (LAS float*)(VS + 2048); \
                float lf[8], qf[8]; \
                _Pragma("unroll") for (int j = 0; j < 4; ++j) { lf[j] = lfa[k][j]; lf[4 + j] = lfb[k][j]; qf[2 * j] = bf_lo(qv[k][j]); qf[2 * j + 1] = bf_hi(qv[k][j]); } \
                float qt[8], kt[8], kd[8], dc[8]; \
                _Pragma("unroll") for (int j = 0; j < 8; ++j) { \
                    const float bcum = scan32_incl(lf[j]); \
                    const float bl31 = __builtin_bit_cast(float, __builtin_amdgcn_readlane(__builtin_bit_cast(int, bcum), 31)), bl63 = __builtin_bit_cast(float, __builtin_amdgcn_readlane(__builtin_bit_cast(int, bcum), 63)); \
                    const float bl = lane < 32 ? bl31 : bl63; \
                    const float kk = 1.f - fast_exp(lf[j]); \
                    qt[j] = qf[j] * fast_exp(bcum); kt[j] = kk * fast_exp(-bcum); kd[j] = kk * fast_exp(bl - bcum); dc[j] = fast_exp(bl); \
                } \
                { u32x4v w; w.x = cvtpk(qt[0], qt[1]); w.y = cvtpk(qt[2], qt[3]); w.z = cvtpk(qt[4], qt[5]); w.w = cvtpk(qt[6], qt[7]); *(LAS u32x4v*)(QT + t * 64 + 8 * cg) = w; \
                  w.x = cvtpk(kt[0], kt[1]); w.y = cvtpk(kt[2], kt[3]); w.z = cvtpk(kt[4], kt[5]); w.w = cvtpk(kt[6], kt[7]); *(LAS u32x4v*)(KT + t * 64 + 8 * cg) = w; \
                  *(LAS u32x4v*)(VS + t * 64 + 8 * cg) = vv[k]; \
                  _Pragma("unroll") for (int j = 0; j < 8; ++j) KDT[(8 * cg + j) * 32 + t] = (u16)(cvtpk(kd[j], 0.f) & 0xffffu); \
                  if (t == 0) { *(LAS f32x4v*)(DEC + 8 * cg) = (f32x4v){dc[0], dc[1], dc[2], dc[3]}; *(LAS f32x4v*)(DEC + 8 * cg + 4) = (f32x4v){dc[4], dc[5], dc[6], dc[7]}; } } \
                gp2 = gp1; gp1 = gg[k]; \
            } else { gp2 = gp1; } \
            HG_LOAD(k, (n) + 5);                                             \
            __syncthreads(); }
        for (int n0 = -1; ; n0 += 4) {
            S_BODY(n0, 0) S_BODY(n0 + 1, 1)
            if (n0 + 1 >= NCH) break;
            S_BODY(n0 + 2, 2) S_BODY(n0 + 3, 3)
        }
#undef S_BODY
#undef HG_LOAD
    } else {
        const int et = wave;
        f32x4v Sst[4];
#pragma unroll
        for (int i = 0; i < 4; ++i) Sst[i] = (f32x4v){0.f, 0.f, 0.f, 0.f};
        const int q = (lane & 15) >> 2, p = lane & 3;
        for (int n = -1; n <= NCH; ++n) {
            if (n >= 0 && n < NCH) {
                LAS unsigned char* S_ = C.lds + (n & 1) * HG_SET;
                const LAS u16* QT = (const LAS u16*)S_; const LAS u16* KT = QT + 2048; const LAS u16* KDT = KT + 2048; const LAS u16* VS = KDT + 2048; const LAS float* DEC = (const LAS float*)(VS + 2048);
                LAS float* OI = (LAS float*)(C.lds + HG_OI) + (n & 1) * 2048;
                f32x4v oi[2] = {{0.f, 0.f, 0.f, 0.f}, {0.f, 0.f, 0.f, 0.f}};
#pragma unroll
                for (int ks = 0; ks < 2; ++ks) {
                    const s16x8 sa = pack8f(Sst[2 * ks], Sst[2 * ks + 1]);
#pragma unroll
                    for (int tt = 0; tt < 2; ++tt) {
                        const s16x4 lo = *(const LAS s16x4*)(QT + (16 * tt + fr) * 64 + 32 * ks + 4 * fq), hi = *(const LAS s16x4*)(QT + (16 * tt + fr) * 64 + 32 * ks + 16 + 4 * fq);
                        oi[tt] = mfma16(sa, cat4(lo, hi), oi[tt]);
                    }
                }
                f32x4v a00 = {0.f, 0.f, 0.f, 0.f}, a10 = a00, a11 = a00;
#pragma unroll
                for (int ks = 0; ks < 2; ++ks) {
                    const s16x8 k0 = *(const LAS s16x8*)(KT + fr * 64 + 32 * ks + 8 * fq), k1 = *(const LAS s16x8*)(KT + (16 + fr) * 64 + 32 * ks + 8 * fq);
                    const s16x8 q0 = *(const LAS s16x8*)(QT + fr * 64 + 32 * ks + 8 * fq), q1 = *(const LAS s16x8*)(QT + (16 + fr) * 64 + 32 * ks + 8 * fq);
                    a00 = mfma16(k0, q0, a00); a10 = mfma16(k0, q1, a10); a11 = mfma16(k1, q1, a11);
                }
#pragma unroll
                for (int i = 0; i < 4; ++i) { const bool keep = (4 * fq + i) <= fr; a00[i] = keep ? a00[i] : 0.f; a11[i] = keep ? a11[i] : 0.f; }
                const f32x4v z = {0.f, 0.f, 0.f, 0.f};
                const s16x8 pb0 = pack8f(a00, z), pb1 = pack8f(a10, a11);
                const s16x8 va = cat4(tr4(VS + (4 * fq + q) * 64 + 16 * et + 4 * p), tr4(VS + (16 + 4 * fq + q) * 64 + 16 * et + 4 * p));
                oi[0] = mfma16(va, pb0, oi[0]); oi[1] = mfma16(va, pb1, oi[1]);
                const s16x8 vb = cat4(tr4(VS + (8 * fq + q) * 64 + 16 * et + 4 * p), tr4(VS + (8 * fq + 4 + q) * 64 + 16 * et + 4 * p));
#pragma unroll
                for (int dt = 0; dt < 4; ++dt) {
                    const s16x8 ka = *(const LAS s16x8*)(KDT + (16 * dt + fr) * 32 + 8 * fq);
                    const f32x4v ds = mfma16(ka, vb, z);
                    const f32x4v dc = *(const LAS f32x4v*)(DEC + 16 * dt + 4 * fq);
                    Sst[dt] = Sst[dt] * dc + ds;
                }
                LAS float* sq = SSQ + (n & 1) * 128 + et * 32;
#pragma unroll
                for (int tt = 0; tt < 2; ++tt) { float s = 0.f;
#pragma unroll
                    for (int i = 0; i < 4; ++i) { OI[(16 * et + 4 * fq + i) * 32 + 16 * tt + fr] = oi[tt][i]; s += oi[tt][i] * oi[tt][i]; }
                    s += __shfl_xor(s, 16); s += __shfl_xor(s, 32);
                    if (fq == 0) sq[16 * tt + fr] = s; }
            }
            __syncthreads();
        }
    }
    __syncthreads();
}

constexpr int DSA_SC = 0, DSA_H1 = 131072, DSA_IDX = 139264, DSA_KST = 143360, DSA_ITEM = 159744;
__device__ __forceinline__ unsigned off_b(unsigned row, unsigned ch) { return 256u * row + 16u * (ch ^ (((row & 3) << 2) | ((row >> 2) & 3))); }
__device__ __forceinline__ unsigned mono16(unsigned h) { return (h & 0x8000u) ? (~h & 0xffffu) : (h | 0x8000u); }

__device__ __forceinline__ int wave_incl_scan_dpp(int v) {
    v += __builtin_amdgcn_update_dpp(0, v, 0x111, 0xf, 0xf, true);
    v += __builtin_amdgcn_update_dpp(0, v, 0x112, 0xf, 0xf, true);
    v += __builtin_amdgcn_update_dpp(0, v, 0x114, 0xf, 0xf, true);
    v += __builtin_amdgcn_update_dpp(0, v, 0x118, 0xf, 0xf, true);
    v += __builtin_amdgcn_update_dpp(0, v, 0x142, 0xa, 0xf, false);
    v += __builtin_amdgcn_update_dpp(0, v, 0x143, 0xc, 0xf, false);
    return v;
}
__device__ __forceinline__ void find_bin(const LAS unsigned* hist, int lane, int target, int& B, int& above) {
    const u32x4v c = *(const LAS u32x4v*)(hist + 4 * lane);
    const int tot = (int)(c.x + c.y + c.z + c.w);
    const int pre = wave_incl_scan_dpp(tot);
    const int all = __builtin_amdgcn_readlane(pre, 63);
    const int suf = all - pre + tot;
    const int ab = suf - tot;
    const bool here = (ab < target) && (suf >= target);
    int b = -1, a = 0;
    if (here) {
        int cum = ab;
        if (cum + (int)c.w >= target) { b = 4 * lane + 3; a = cum; }
        else { cum += (int)c.w;
            if (cum + (int)c.z >= target) { b = 4 * lane + 2; a = cum; }
            else { cum += (int)c.z;
                if (cum + (int)c.y >= target) { b = 4 * lane + 1; a = cum; }
                else { cum += (int)c.y; b = 4 * lane; a = cum; } } }
    }
    const unsigned long long m = __ballot(here);
    const int src = m ? (int)__builtin_ctzll(m) : 0;
    B = __shfl(b, src); above = __shfl(a, src);
}

__device__ __forceinline__ int wave_incl_scan(int v, int lane) {
#pragma unroll
    for (int d = 1; d < 64; d <<= 1) { const int o = __shfl_up(v, d); if (lane >= d) v += o; }
    return v;
}

typedef short s16x2v __attribute__((ext_vector_type(2)));
__device__ __forceinline__ unsigned relu_pk_bf16(unsigned x) { return __builtin_bit_cast(unsigned, __builtin_elementwise_max(__builtin_bit_cast(s16x2v, x), (s16x2v){0, 0})); }

struct APre { s16x8 Aop[4][2]; f32x4v w0[2], w1[2]; u32x4v g[2][2]; };
__device__ __forceinline__ void dsa_pre(const Ctx& C, int b, int qt, APre& P) {
    const int lane = C.lane, wave = C.wave, fr = lane & 15, fq = lane >> 4;
    unsigned char* ws = C.ws;
    const u16* QIDX = (const u16*)(ws + WS_QIDX); const u16* KIDX = (const u16*)(ws + WS_KIDX); const float* WIDX = (const float*)(ws + WS_WIDX);
    const size_t tb = (size_t)b * SEQ; const int q0 = qt * 8, nt16 = (q0 + 8 + 15) >> 4;
#pragma unroll
    for (int m = 0; m < 4; ++m) { const u16* p = QIDX + (tb + q0 + 4 * (m >> 1) + (fr >> 2)) * 512 + (4 * (m & 1) + (fr & 3)) * 64 + 8 * fq;
#pragma unroll
        for (int ks = 0; ks < 2; ++ks) P.Aop[m][ks] = *(const s16x8*)(p + 32 * ks); }
#pragma unroll
    for (int qq = 0; qq < 2; ++qq) { const float* wp = WIDX + (tb + q0 + 4 * qq + fq) * 8; P.w0[qq] = *(const f32x4v*)wp; P.w1[qq] = *(const f32x4v*)(wp + 4); }
    const int lrow = lane >> 3, lpc = lane & 7;
    const u16* kbase = KIDX + (tb + lrow) * 64 + lpc * 8;
#pragma unroll
    for (int j = 0; j < 2; ++j) { const int t_ = wave + 8 * j < nt16 ? wave + 8 * j : (wave < nt16 ? wave : 0);
        P.g[j][0] = *(const u32x4v*)(kbase + (size_t)t_ * 1024); P.g[j][1] = *(const u32x4v*)(kbase + (size_t)t_ * 1024 + 512); }
}

__device__ __forceinline__ int dsa_item(const Ctx& C, int b, int qt, APre& P, int nxt) {
    const int tid = C.tid, lane = C.lane, wave = C.wave;
    unsigned char* ws = C.ws;
    const u16* QLAT = (const u16*)(ws + WS_QLAT); const u16* QIDX = (const u16*)(ws + WS_QIDX); const u16* CKV = (const u16*)(ws + WS_CKV); const u16* KIDX = (const u16*)(ws + WS_KIDX);
    const float* WIDX = (const float*)(ws + WS_WIDX); const float* SSQ = (const float*)(ws + WS_SSQ); u16* MIX = (u16*)(ws + WS_MIX);
    LAS _Float16* SC = (LAS _Float16*)(C.lds + DSA_SC); LAS u16* SCK = (LAS u16*)(C.lds + DSA_SC);
    LAS unsigned* H1 = (LAS unsigned*)(C.lds + DSA_H1);
    const size_t tb = (size_t)b * SEQ; const int q0 = qt * 8;
    { constexpr int repA = 0;
        const int fr = lane & 15, fq = lane >> 4;
        s16x8 Aop[4][2]; s16x8 Wop[2];
#pragma unroll
        for (int m = 0; m < 4; ++m) { Aop[m][0] = P.Aop[m][0]; Aop[m][1] = P.Aop[m][1]; }
#pragma unroll
        for (int qq = 0; qq < 2; ++qq) { const f32x4v w0 = P.w0[qq], w1 = P.w1[qq];
            const f32x4v zz = {0.f, 0.f, 0.f, 0.f}; const bool own = fr == 4 * fq + qq;
            Wop[qq] = pack8f(own ? w0 : zz, own ? w1 : zz); }
        const int nt16 = (q0 + 8 + 15) >> 4;
        LAS unsigned char* KST = C.lds + DSA_KST + wave * 2048;
        const int lrow = lane >> 3, lpc = lane & 7;
        const u16* kbase = KIDX + (tb + lrow) * 64 + lpc * 8;
        const unsigned wo0 = (unsigned)(lrow * 128 + ((lpc ^ (lrow & 7)) * 16)), wo1 = wo0 + 1024u;
        const unsigned ro0 = (unsigned)(fr * 128 + ((fq ^ (fr & 7)) * 16)), ro1 = (unsigned)(fr * 128 + (((4 + fq) ^ (fr & 7)) * 16));
        u32x4v g0a, g0b, g1a, g1b;
#define A_GLOAD(da, db, kt_) do { da = *(const u32x4v*)(kbase + (size_t)(kt_) * 1024); db = *(const u32x4v*)(kbase + (size_t)(kt_) * 1024 + 512); } while (0)
#define A_STAGE(da, db, B0_, B1_) do { *(LAS u32x4v*)(KST + wo0) = da; *(LAS u32x4v*)(KST + wo1) = db; LDS_FENCE(); B0_ = *(const LAS s16x8*)(KST + ro0); B1_ = *(const LAS s16x8*)(KST + ro1); } while (0)
#define A_MMA(acc_, B0_, B1_) do { _Pragma("unroll") for (int m = 0; m < 4; ++m) { acc_[m] = mfma16(Aop[m][0], B0_, (f32x4v){0.f, 0.f, 0.f, 0.f}); acc_[m] = mfma16(Aop[m][1], B1_, acc_[m]); } } while (0)
#define A_EPI1(acc_, d0_, d1_) do { if (((MK_REPEAT >> 17) & 1) && repA) { d0_ = acc_[0] + acc_[1] + acc_[2] + acc_[3]; break; } u32x4v pa_, pb_;                      \
            pa_.x = relu_pk_bf16(cvtpk(acc_[0][0], acc_[0][1])); pa_.y = relu_pk_bf16(cvtpk(acc_[0][2], acc_[0][3])); pa_.z = relu_pk_bf16(cvtpk(acc_[1][0], acc_[1][1])); pa_.w = relu_pk_bf16(cvtpk(acc_[1][2], acc_[1][3])); \
            pb_.x = relu_pk_bf16(cvtpk(acc_[2][0], acc_[2][1])); pb_.y = relu_pk_bf16(cvtpk(acc_[2][2], acc_[2][3])); pb_.z = relu_pk_bf16(cvtpk(acc_[3][0], acc_[3][1])); pb_.w = relu_pk_bf16(cvtpk(acc_[3][2], acc_[3][3])); \
            d0_ = mfma16(Wop[0], __builtin_bit_cast(s16x8, pa_), (f32x4v){0.f, 0.f, 0.f, 0.f}); \
            d0_ = mfma16(Wop[1], __builtin_bit_cast(s16x8, pb_), d0_); } while (0)
#define A_EPI2(d0_, d1_, kt_) do { if (((MK_REPEAT >> 16) & 1) && repA) { dummyA += d0_[0] + d0_[1]; break; } const int kpos = (kt_) * 16 + fr;     \
            const unsigned hh_ = __builtin_bit_cast(unsigned, __builtin_amdgcn_cvt_pkrtz(d0_[0], d0_[1])); \
            const unsigned kk_ = hh_ ^ (__builtin_bit_cast(unsigned, __builtin_bit_cast(s16x2v, hh_) >> 15) | 0x80008000u);      \
            SCK[fq * 8192 + kpos] = (u16)kk_; SCK[(4 + fq) * 8192 + kpos] = (u16)(kk_ >> 16); \
            if (repA == 0) { if (kpos <= q0 + fq) atomicAdd((unsigned*)(H1 + fq * 256 + ((kk_ >> 8) & 0xffu)), 1u); if (kpos <= q0 + 4 + fq) atomicAdd((unsigned*)(H1 + (4 + fq) * 256 + (kk_ >> 24)), 1u); } } while (0)
        float dummyA = 0.f;
#define A_WRITE(da, db) do { *(LAS u32x4v*)(KST + wo0) = da; *(LAS u32x4v*)(KST + wo1) = db; } while (0)
#define A_READ(B0_, B1_) do { LDS_FENCE(); B0_ = *(const LAS s16x8*)(KST + ro0); B1_ = *(const LAS s16x8*)(KST + ro1); } while (0)
        if (wave < nt16) {
            s16x8 bc0, bc1, bn0, bn1; f32x4v accA[4], accB[4], hd; u32x4v g2a, g2b, g3a, g3b;
#define A_TCL(t_) ((t_) < nt16 ? (t_) : wave)
            g0a = P.g[0][0]; g0b = P.g[0][1]; g1a = P.g[1][0]; g1b = P.g[1][1];
            A_GLOAD(g2a, g2b, A_TCL(wave + 16)); A_GLOAD(g3a, g3b, A_TCL(wave + 24));
            A_WRITE(g0a, g0b); A_READ(bc0, bc1);
            A_MMA(accA, bc0, bc1);
            A_GLOAD(g0a, g0b, A_TCL(wave + 32));
            A_WRITE(g1a, g1b); A_GLOAD(g1a, g1b, A_TCL(wave + 40));
            int kt = wave;
#define A_STEP(aX, aY, bx0, bx1, ga, gb) { A_READ(bx0, bx1); A_EPI1(aX, hd, hd); A_MMA(aY, bx0, bx1); A_EPI2(hd, hd, kt); if (kt + 8 >= nt16) break; \
                A_WRITE(ga, gb); A_GLOAD(ga, gb, (kt + 48 < nt16 ? kt + 48 : kt)); kt += 8; }
            for (;;) {
                A_STEP(accA, accB, bn0, bn1, g2a, g2b)
                A_STEP(accB, accA, bc0, bc1, g3a, g3b)
                A_STEP(accA, accB, bn0, bn1, g0a, g0b)
                A_STEP(accB, accA, bc0, bc1, g1a, g1b)
            }
#undef A_STEP
#undef A_TCL
        }
#undef A_WRITE
#undef A_READ
        if (dummyA == 12345.678f) SC[0] = (_Float16)0.f;
#undef A_GLOAD
#undef A_STAGE
#undef A_MMA
#undef A_EPI1
#undef A_EPI2
    }
    LAS int* itemw2 = (LAS int*)(C.lds + DSA_ITEM) + 1;
    if (tid == 0) *itemw2 = nxt;
    __syncthreads();
    const int nx = __builtin_amdgcn_readfirstlane(*itemw2);
    const int tq = q0 + wave, nk = tq + 1;
    LAS unsigned* h1 = H1 + wave * 256;
    LAS unsigned* hist = h1;
    LAS u16* idx = (LAS u16*)(C.lds + DSA_IDX) + wave * 256;
    LAS float* rsel = (LAS float*)(C.lds + DSA_KST + wave * 2048);
    const LAS u16* scq = (const LAS u16*)(C.lds + DSA_SC) + wave * 8192;
    s16x8 Bq[4];
    { const int fr = lane & 15, fq = lane >> 4;
#pragma unroll
      for (int ks = 0; ks < 4; ++ks) { Bq[ks] = (s16x8){0, 0, 0, 0, 0, 0, 0, 0}; if (fr < 8) Bq[ks] = *(const s16x8*)(QLAT + (tb + tq) * 1024 + fr * 128 + 32 * ks + 8 * fq); } }
    int cnt;
    const int frC = lane & 15, fqC = lane >> 4;
    const u16* ckb = CKV + tb * 128 + frC * 8;
    u32x4v gbuf[8]; f32x4v q4e = {0.f, 0.f, 0.f, 0.f}; bool early = false;
#define C_ISSUE(ch_) do { int kk_[8]; _Pragma("unroll") for (int i = 0; i < 8; ++i) { const int s_ = (ch_) * 32 + 4 * i + fqC; kk_[i] = (int)idx[s_ < cnt ? s_ : cnt - 1]; }     \
            _Pragma("unroll") for (int i = 0; i < 8; ++i) gbuf[i] = *(const u32x4v*)(ckb + (size_t)kk_[i] * 128); } while (0)
#define C_EARLY() do { LDS_FENCE(); C_ISSUE(0); q4e = *(const f32x4v*)(SSQ + (tb + idx[lane < cnt ? lane : cnt - 1]) * 4); } while (0)
    u32x4v h1save = (u32x4v){0u, 0u, 0u, 0u};
    if ((MK_REPEAT >> 9) & 1) h1save = *(const LAS u32x4v*)(h1 + 4 * lane);
    for (int repB = 0; repB < (((MK_REPEAT >> 9) & 1) ? 2 : 1); ++repB) { LDS_FENCE();
    if (repB) { *(LAS u32x4v*)(h1 + 4 * lane) = h1save; LDS_FENCE(); }
    if (nk <= TOPK) {
        cnt = nk;
#pragma unroll
        for (int i = 0; i < 4; ++i) idx[lane + 64 * i] = (u16)(lane + 64 * i);
    } else {
        cnt = TOPK;
        const int nit = (nk + 511) >> 9;
        int B1, above1; find_bin(h1, lane, TOPK, B1, above1);
        LDS_FENCE();
        *(LAS u32x4v*)(hist + 4 * lane) = (u32x4v){0u, 0u, 0u, 0u};
        LDS_FENCE();
#pragma unroll 2
        for (int it = 0; it < nit; ++it) { const int base = it * 512 + lane * 8;
            if ((it + 1) * 512 <= nk) {
                const u32x4v v = *(const LAS u32x4v*)(scq + base);
#pragma unroll
                for (int j = 0; j < 8; ++j) { const unsigned key = (v[j >> 1] >> ((j & 1) * 16)) & 0xffffu; if ((int)(key >> 8) == B1) atomicAdd((unsigned*)(hist + (key & 255u)), 1u); }
            } else if (base < nk) { const u32x4v v = *(const LAS u32x4v*)(scq + base);
#pragma unroll
                for (int j = 0; j < 8; ++j) { const unsigned key = (v[j >> 1] >> ((j & 1) * 16)) & 0xffffu; if (base + j < nk && (int)(key >> 8) == B1) atomicAdd((unsigned*)(hist + (key & 255u)), 1u); } } }
        LDS_FENCE();
        int B2, above2; find_bin(hist, lane, TOPK - above1, B2, above2);
        const unsigned T = ((unsigned)B1 << 8) | (unsigned)B2;
        const int ngt = above1 + above2, need_eq = TOPK - ngt;
        int pos_gt = 0, pos_eq = 0;
#pragma unroll 2
        for (int it = 0; it < nit; ++it) { const int base = it * 512 + lane * 8;
            u32x4v v = (u32x4v){0u, 0u, 0u, 0u};
            if (base < nk) v = *(const LAS u32x4v*)(scq + base);
            unsigned key[8];
#pragma unroll
            for (int j = 0; j < 8; ++j) key[j] = (v[j >> 1] >> ((j & 1) * 16)) & 0xffffu;
            if ((it + 1) * 512 > nk) {
#pragma unroll
                for (int j = 0; j < 8; ++j) if (base + j >= nk) key[j] = 0u; }
            unsigned mgt = 0u, meq = 0u;
#pragma unroll
            for (int j = 0; j < 8; ++j) { mgt |= (key[j] > T ? 1u : 0u) << j; meq |= (key[j] == T ? 1u : 0u) << j; }
            const int cgt = __builtin_popcount(mgt), ceq = __builtin_popcount(meq);
            const int packed = cgt | (ceq << 16);
            const int incl = wave_incl_scan_dpp(packed), excl = incl - packed, tot = __builtin_amdgcn_readlane(incl, 63);
            int og = pos_gt + (excl & 0xffff), oe = pos_eq + (excl >> 16);
            pos_gt += tot & 0xffff; pos_eq += tot >> 16;
            while (mgt) { const int j = __builtin_ctz(mgt); mgt &= mgt - 1u; idx[og] = (u16)(base + j); ++og; }
            while (meq) { const int j = __builtin_ctz(meq); meq &= meq - 1u; if (oe < need_eq) idx[ngt + oe] = (u16)(base + j); ++oe; }
            if (!early && pos_gt >= 64 && it + 1 < nit) { early = true; C_EARLY(); } }
    }
    }
    *(LAS u32x4v*)(h1 + 4 * lane) = (u32x4v){0u, 0u, 0u, 0u};
    LDS_FENCE();
    for (int repC = 0; repC < (((MK_REPEAT >> 10) & 1) ? 2 : 1); ++repC) {
        const int fr = lane & 15, fq = lane >> 4;
        const size_t tok = tb + tq;
        const int nch = (cnt + 31) >> 5;
        if (!early || repC) C_EARLY();
        { int kr[3]; f32x4v q4[4]; q4[0] = q4e;
#pragma unroll
          for (int i = 1; i < 4; ++i) { const int s = lane + 64 * i; kr[i - 1] = (int)idx[s < cnt ? s : cnt - 1]; }
#pragma unroll
          for (int i = 1; i < 4; ++i) q4[i] = *(const f32x4v*)(SSQ + (tb + kr[i - 1]) * 4);
#pragma unroll
          for (int i = 0; i < 4; ++i) { const int s = lane + 64 * i; rsel[s] = s < cnt ? __builtin_amdgcn_rsqf((q4[i][0] + q4[i][1] + q4[i][2] + q4[i][3]) * (1.f / 128.f) + EPS) : 0.f; } }
        f32x4v O[8];
#pragma unroll
        for (int ct = 0; ct < 8; ++ct) O[ct] = (f32x4v){0.f, 0.f, 0.f, 0.f};
        float mrun = -__builtin_inff(), lsum = 0.f;
        const int rho0 = 8 * (fr >> 2) + (fr & 3);
        const int tq_ = (lane & 15) >> 2, tp = lane & 3;
        LAS unsigned char* const CB = C.lds + DSA_SC + wave * 16384;
        auto c_chunk = [&](const int ch, LAS unsigned char* const CH) __attribute__((always_inline)) {
            f32x4v sacc[2];
#pragma unroll
            for (int T = 0; T < 2; ++T) { sacc[T] = (f32x4v){0.f, 0.f, 0.f, 0.f};
#pragma unroll
                for (int ks = 0; ks < 4; ++ks) { const s16x8 a = *(const LAS s16x8*)(CH + off_b(rho0 + 4 * T, 4 * ks + fq)); sacc[T] = mfma16(a, Bq[ks], sacc[T]); } }
            const f32x4v r0 = *(const LAS f32x4v*)(rsel + ch * 32 + 8 * fq), r1 = *(const LAS f32x4v*)(rsel + ch * 32 + 8 * fq + 4);
            float sv[8];
#pragma unroll
            for (int i = 0; i < 4; ++i) { sv[i] = sacc[0][i] * r0[i]; sv[4 + i] = sacc[1][i] * r1[i]; }
            if (ch * 32 + 32 > cnt) {
#pragma unroll
                for (int i = 0; i < 4; ++i) { const int s0 = ch * 32 + 8 * fq + i; if (s0 >= cnt) sv[i] = -__builtin_inff(); if (s0 + 4 >= cnt) sv[4 + i] = -__builtin_inff(); } }
            float cmax = fmaxf(fmaxf(fmaxf(sv[0], sv[1]), fmaxf(sv[2], sv[3])), fmaxf(fmaxf(sv[4], sv[5]), fmaxf(sv[6], sv[7])));
            cmax = fmaxf(cmax, __shfl_xor(cmax, 16)); cmax = fmaxf(cmax, __shfl_xor(cmax, 32));
            const bool need = cmax > mrun + 8.f;
            if (__any(need)) {
                const float mnew = need ? cmax : mrun;
                const float alpha = fast_exp(mrun - mnew);
                mrun = mnew; lsum *= alpha;
#pragma unroll
                for (int ct = 0; ct < 8; ++ct) O[ct] = O[ct] * alpha;
            }
            float p[8]; float ps = 0.f;
#pragma unroll
            for (int i = 0; i < 8; ++i) { p[i] = fast_exp(sv[i] - mrun); ps += p[i]; }
            lsum += ps;
            f32x4v pa, pb;
#pragma unroll
            for (int i = 0; i < 4; ++i) { pa[i] = p[i] * r0[i]; pb[i] = p[4 + i] * r1[i]; }
            const s16x8 pop = pack8f(pa, pb);
#pragma unroll
            for (int ct = 0; ct < 8; ++ct) {
                const s16x4 t0 = tr4((const LAS u16*)(CH + off_b(8 * fq + tq_, 2 * ct + (tp >> 1)) + 8 * (tp & 1)));
                const s16x4 t1 = tr4((const LAS u16*)(CH + off_b(8 * fq + 4 + tq_, 2 * ct + (tp >> 1)) + 8 * (tp & 1)));
                O[ct] = mfma16(cat4(t0, t1), pop, O[ct]);
            }
        };
#pragma unroll 1
        for (int ch = 0; ch < nch; ch += 2) {
#pragma unroll
            for (int i = 0; i < 8; ++i) *(LAS u32x4v*)(CB + off_b(4 * i + fq, fr)) = gbuf[i];
            if (ch + 1 < nch) C_ISSUE(ch + 1);
            LDS_FENCE();
            c_chunk(ch, CB);
            if (ch + 1 < nch) {
#pragma unroll
                for (int i = 0; i < 8; ++i) *(LAS u32x4v*)(CB + 8192 + off_b(4 * i + fq, fr)) = gbuf[i];
                if (ch + 2 < nch) C_ISSUE(ch + 2);
                LDS_FENCE();
                c_chunk(ch + 1, CB + 8192);
            }
        }
#undef C_ISSUE
#undef C_EARLY
        lsum += __shfl_xor(lsum, 16); lsum += __shfl_xor(lsum, 32);
        const float inv = 1.f / lsum;
        float am = 0.f;
#pragma unroll
        for (int ct = 0; ct < 8; ++ct) { O[ct] = O[ct] * inv; am = fmaxf(am, fmaxf(fmaxf(fabsf(O[ct][0]), fabsf(O[ct][1])), fmaxf(fabsf(O[ct][2]), fabsf(O[ct][3])))); }
        if (fr >= 8) am = 0.f;
        am = wave_max_f(am);
        const float qs = am > 0.f ? 127.f / am : 0.f;
        if (fr < 8) {
            unsigned char* mp = (unsigned char*)MIX + tok * MIXB + fr * 128 + 4 * fq;
#pragma unroll
            for (int ct = 0; ct < 8; ++ct) *(unsigned*)(mp + 16 * ct) = pack_i8(O[ct][0] * qs, O[ct][1] * qs, O[ct][2] * qs, O[ct][3] * qs);
        }
        if (lane == 0) ((float*)(ws + WS_MIXS))[tok] = am * (1.f / 127.f);
    }
    dsa_pre(C, b, (SEQ / 8 - 1) - (nx < SEQ / 8 ? nx : SEQ / 8 - 1), P);
    return nx;
}

__device__ __forceinline__ void p2_mixers(const Ctx& C, int cw = 0) {
    if (C.bid < 64) { hgrn_seq(C, C.bid); if ((MK_REPEAT >> 7) & 1) hgrn_seq(C, C.bid); }
    unsigned* qctr = (unsigned*)(C.ws + WS_CTL);
    for (int i = C.tid; i < 2048; i += NTHREADS) ((LAS unsigned*)(C.lds + DSA_H1))[i] = 0u;
    __syncthreads();
    LAS int* itemw = (LAS int*)(C.lds + DSA_ITEM);
    APre P;
    const int xcc = (int)(__builtin_amdgcn_s_getreg((3 << 11) | 20) & 0x7u);
    for (int k = 0; k < NB; ++k) { const int bq = (xcc + k) & 7;
        if (C.tid == 0) *itemw = (int)atomicAdd(qctr + 8 * cw + bq, 1u);
        __syncthreads();
        int item = *itemw;
        __syncthreads();
        if (item < SEQ / 8) dsa_pre(C, bq, (SEQ / 8 - 1) - item, P);
        while (item < SEQ / 8) {
            int nxt = 0;
            if (C.tid == 0) nxt = (int)atomicAdd(qctr + 8 * cw + bq, 1u);
            item = dsa_item(C, bq, (SEQ / 8 - 1) - item, P, nxt);
            __syncthreads();
        }
    }
}


__device__ __forceinline__ float wave_sum(float v) {
#pragma unroll
    for (int d = 1; d < 64; d <<= 1) v += __shfl_xor(v, d);
    return v;
}
__device__ __forceinline__ void p4_ln1(const Ctx& C) {
    const u16* Y1 = (const u16*)(C.ws + WS_Y1); u16* HB = (u16*)(C.ws + WS_HB); unsigned char* H8 = C.ws + WS_H8; float* HS = (float*)(C.ws + WS_HS);
    const float* g = C.in[I_LN1G]; const float* bb = C.in[I_LN1B];
    const int lane = C.lane, gw = C.bid * 8 + C.wave, nw = C.G * 8;
    f32x4v gv[4], bv[4];
#pragma unroll
    for (int c = 0; c < 4; ++c) { gv[c] = *(const f32x4v*)(g + lane * 16 + 4 * c); bv[c] = *(const f32x4v*)(bb + lane * 16 + 4 * c); }
    u32x4v ya[4], yb[4];
#define LN1_LOAD(k_, r_) do { const int rr_ = (r_) < MTOK ? (r_) : gw; ya[k_] = *(const u32x4v*)(Y1 + (size_t)rr_ * 1024 + lane * 16); yb[k_] = *(const u32x4v*)(Y1 + (size_t)rr_ * 1024 + lane * 16 + 8); } while (0)
    LN1_LOAD(0, gw); LN1_LOAD(1, gw + nw); LN1_LOAD(2, gw + 2 * nw); LN1_LOAD(3, gw + 3 * nw);
    for (int r0 = gw; r0 < MTOK; r0 += 4 * nw) {
#pragma unroll
    for (int kq = 0; kq < 4; ++kq) { const int r = r0 + kq * nw; const bool rv = r < MTOK;
        const u32x4v y0 = ya[kq], y1 = yb[kq];
        LN1_LOAD(kq, r + 4 * nw);
        float v[16]; float s = 0.f;
#pragma unroll
        for (int j = 0; j < 4; ++j) { v[2 * j] = bf_lo(y0[j]); v[2 * j + 1] = bf_hi(y0[j]); v[8 + 2 * j] = bf_lo(y1[j]); v[8 + 2 * j + 1] = bf_hi(y1[j]); }
#pragma unroll
        for (int j = 0; j < 16; ++j) s += v[j];
        const float mu = wave_sum_f(s) * (1.f / 1024.f);
        float q = 0.f;
#pragma unroll
        for (int j = 0; j < 16; ++j) { v[j] -= mu; q += v[j] * v[j]; }
        const float rstd = __builtin_amdgcn_rsqf(wave_sum_f(q) * (1.f / 1024.f) + EPS);
        float am = 0.f;
#pragma unroll
        for (int j = 0; j < 16; ++j) { v[j] = v[j] * rstd * gv[j >> 2][j & 3] + bv[j >> 2][j & 3]; am = fmaxf(am, fabsf(v[j])); }
        u32x4v w0, w1;
#pragma unroll
        for (int j = 0; j < 4; ++j) { w0[j] = cvtpk(v[2 * j], v[2 * j + 1]); w1[j] = cvtpk(v[8 + 2 * j], v[8 + 2 * j + 1]); }
        if (rv) { *(u32x4v*)(HB + (size_t)r * 1024 + lane * 16) = w0; *(u32x4v*)(HB + (size_t)r * 1024 + lane * 16 + 8) = w1; }
        am = wave_max_f(am);
        const float qs = am > 0.f ? 127.f / am : 0.f;
        u32x4v w8;
#pragma unroll
        for (int j = 0; j < 4; ++j) w8[j] = pack_i8(v[4 * j] * qs, v[4 * j + 1] * qs, v[4 * j + 2] * qs, v[4 * j + 3] * qs);
        if (rv) { *(u32x4v*)(H8 + (size_t)r * 1024 + lane * 16) = w8; if (lane == 0) HS[r] = am * (1.f / 127.f); }
    }
    }
#undef LN1_LOAD
}

constexpr int SSROW = 136;
constexpr int PE_SS = 0, PE_TV = 0, PE_TI = 32768, PE_EU = 53248, PE_EID = 131072, PE_EG = 147456;

__device__ __forceinline__ void ins16(float (&tv)[16], int (&ti)[16], float v, int id) {
#pragma unroll
    for (int j = 15; j >= 0; --j) {
        const bool c = v > tv[j];
        const bool cp = (j > 0) ? (v > tv[j > 0 ? j - 1 : 0]) : false;
        const float nv = cp ? tv[j > 0 ? j - 1 : 0] : v; const int ni = cp ? ti[j > 0 ? j - 1 : 0] : id;
        tv[j] = c ? nv : tv[j]; ti[j] = c ? ni : ti[j];
    }
}

__device__ __forceinline__ float gelu_tanh(float x) {
    const float u = 0.7978845608028654f * (x + 0.044715f * x * x * x);
    const float e = fast_exp(2.f * u);
    const float th = 1.f - 2.f * __builtin_amdgcn_rcpf(e + 1.f);
    return 0.5f * x * (1.f + th);
}


#ifndef MK_PASSBAR
#define MK_PASSBAR 0
#endif
constexpr int PE_PD = 0, PE_STAT = 131072, PE_WSC = 133120;
constexpr size_t WS_GSID = WS_MIX, WS_GSG = WS_MIX + 32 * MiB, WS_GSU = WS_MIX + 64 * MiB;
constexpr int NSEG = 8, SEGB = 128;

__device__ __forceinline__ void p6_peer(const Ctx& C) {
    unsigned char* ws = C.ws;
    const u16* PQ = (const u16*)(ws + WS_PQ); const u16* HB = (const u16*)(ws + WS_HB); const u16* SKB = (const u16*)(ws + WS_SKB); const unsigned char* H8 = ws + WS_H8; const float* HS = (const float*)(ws + WS_HS);
    const unsigned char* U8 = ws + WS_UB; const unsigned char* V8 = ws + WS_VB; const float* USC = (const float*)(ws + WS_USC); const float* VSC = (const float*)(ws + WS_VSC);
    u16* YB = (u16*)(ws + WS_YB);
    unsigned* G_SID = (unsigned*)(ws + WS_GSID); float* G_SG = (float*)(ws + WS_GSG); float* G_SU = (float*)(ws + WS_GSU);
    const float* g2 = C.in[I_LN2G]; const float* b2 = C.in[I_LN2B];
    const int tid = C.tid, lane = C.lane, wave = C.wave, fr = lane & 15, fq = lane >> 4;
    LAS u16* SSK = (LAS u16*)(C.lds + PE_SS);
    LAS float* TV = (LAS float*)(C.lds + PE_TV); LAS u16* TI = (LAS u16*)(C.lds + PE_TI);
    LAS int* EID = (LAS int*)(C.lds + PE_EID); LAS float* EG = (LAS float*)(C.lds + PE_EG); LAS float* EU = (LAS float*)(C.lds + PE_EU);
    cg::grid_group grid = cg::this_grid();
    const int ntile = MTOK / 32, tiles_per_wg = (ntile + C.G - 1) / C.G, nsr = (tiles_per_wg + 7) / 8;
    for (int sr = 0; sr < nsr; ++sr) {
    for (int jj = 0; jj < 8; ++jj) { const int tile = C.bid + (8 * sr + jj) * C.G; if (tile >= ntile) break;
        const size_t t0 = (size_t)tile * 32;
        int tid_r = C.tid; asm volatile("" : "+v"(tid_r));
        const int lane_r = tid_r & 63, fr_r = lane_r & 15, fq_r = lane_r >> 4;
#define tid tid_r
#define lane lane_r
#define fr fr_r
#define fq fq_r
#define SK_KEYS(x_, y_) ({ const unsigned hh_ = __builtin_bit_cast(unsigned, __builtin_amdgcn_cvt_pkrtz(x_, y_)); hh_ ^ (__builtin_bit_cast(unsigned, __builtin_bit_cast(s16x2v, hh_) >> 15) | 0x80008000u); })
#define SK_LOAD(dst, hp_, k0_) do { _Pragma("unroll") for (int kk = 0; kk < 4; ++kk) _Pragma("unroll") for (int ks = 0; ks < 4; ++ks) \
            dst[kk][ks] = *(const s16x8*)(SKB + ((size_t)(hp_) * 128 + 16 * ((k0_) + kk) + fr) * 128 + 32 * ks + 8 * fq); } while (0)
#define PQ_LOAD(dst, hp_) do { _Pragma("unroll") for (int tt = 0; tt < 2; ++tt) _Pragma("unroll") for (int ks = 0; ks < 4; ++ks) dst[tt][ks] = *(const s16x8*)(PQ + (t0 + 16 * tt + fr) * NPQ + (hp_) * 128 + 32 * ks + 8 * fq); } while (0)
#define SK_COMP(src, Bq_, hp_, k0_) do { _Pragma("unroll") for (int kk = 0; kk < 4; ++kk) { const int kt = (k0_) + kk; f32x4v a0 = {0.f, 0.f, 0.f, 0.f}, a1 = a0; \
            _Pragma("unroll") for (int ks = 0; ks < 4; ++ks) { a0 = mfma16(src[kk][ks], Bq_[0][ks], a0); a1 = mfma16(src[kk][ks], Bq_[1][ks], a1); } \
              \
            u32x2v kwa_, kwb_; kwa_.x = SK_KEYS(a0[0], a0[1]); kwa_.y = SK_KEYS(a0[2], a0[3]); kwb_.x = SK_KEYS(a1[0], a1[1]); kwb_.y = SK_KEYS(a1[2], a1[3]); \
            *(LAS u32x2v*)(SSK + ((hp_) * 32 + fr) * SSROW + 16 * kt + 4 * fq) = kwa_; *(LAS u32x2v*)(SSK + ((hp_) * 32 + 16 + fr) * SSROW + 16 * kt + 4 * fq) = kwb_; } } while (0)
#pragma unroll 1
        for (int rep1 = 0; rep1 < (((MK_REPEAT >> 11) & 1) ? 2 : 1); ++rep1) {
            const int hp0 = 2 * wave, hp1 = hp0 + 1;
            s16x8 akA[4][4], akB[4][4], Bt0[2][4], Bt1[2][4];
            PQ_LOAD(Bt0, hp0); SK_LOAD(akA, hp0, 0); SK_LOAD(akB, hp0, 4); PQ_LOAD(Bt1, hp1);
            SK_COMP(akA, Bt0, hp0, 0); SK_LOAD(akA, hp1, 0);
            SK_COMP(akB, Bt0, hp0, 4); SK_LOAD(akB, hp1, 4);
            SK_COMP(akA, Bt1, hp1, 0);
            SK_COMP(akB, Bt1, hp1, 4);
        }
#undef SK_LOAD
#undef PQ_LOAD
#undef SK_COMP
#undef SK_KEYS
        __syncthreads();
        for (int repS = 0; repS < (((MK_REPEAT >> 12) & 1) ? 2 : 1); ++repS) {
            if (repS) __syncthreads();
            const int tok = tid & 31, hp = tid >> 5;
            float tk[16];
#pragma unroll
            for (int j = 0; j < 16; ++j) tk[j] = __builtin_bit_cast(float, 0x40000000u);
            const LAS u16* rowp = SSK + (hp * 32 + tok) * SSROW;
#pragma unroll 2
            for (int kb = 0; kb < 16; ++kb) {
                const u32x4v w = *(const LAS u32x4v*)(rowp + 8 * kb);
#pragma unroll
                for (int j = 0; j < 8; ++j) { const int k = 8 * kb + j; const unsigned k16 = (j & 1) ? (w[j >> 1] >> 16) : (w[j >> 1] & 0xffffu);
                    const float x = __builtin_bit_cast(float, (k16 << 7) | (0x40000000u | (unsigned)(127 - k)));
                    float nk[16];
                    nk[0] = __builtin_amdgcn_fmed3f(__builtin_inff(), x, tk[0]);
#pragma unroll
                    for (int jj = 1; jj < 16; ++jj) nk[jj] = __builtin_amdgcn_fmed3f(tk[jj - 1], x, tk[jj]);
#pragma unroll
                    for (int jj = 0; jj < 16; ++jj) tk[jj] = nk[jj]; }
            }
            if (repS + 1 < (((MK_REPEAT >> 12) & 1) ? 2 : 1)) continue;
            __syncthreads();
#pragma unroll
            for (int j = 0; j < 16; ++j) { const unsigned bits = __builtin_bit_cast(unsigned, tk[j]); const unsigned k16 = (bits >> 7) & 0xffffu;
                const unsigned hb = (k16 & 0x8000u) ? (k16 & 0x7fffu) : (~k16 & 0xffffu);
                TV[tid * 16 + j] = (float)__builtin_bit_cast(_Float16, (unsigned short)hb); TI[tid * 16 + j] = (u16)(127u - (bits & 0x7fu)); }
        }
        __syncthreads();
        for (int repK = 0; repK < (((MK_REPEAT >> 13) & 1) ? 2 : 1); ++repK) if (tid < 256) {
            int tid_o = tid; asm volatile("" : "+v"(tid_o));
            const int tok = tid_o & 31, h = tid_o >> 5;
            const int ra = ((2 * h) * 32 + tok) * 16, rb = ((2 * h + 1) * 32 + tok) * 16;
            float va[16], vb[16];
#pragma unroll
            for (int j = 0; j < 16; ++j) { va[j] = TV[ra + j]; vb[j] = TV[rb + j]; }
            float tk[16];
#pragma unroll
            for (int j = 0; j < 16; ++j) tk[j] = -__builtin_inff();
#pragma unroll
            for (int a = 0; a < 16; ++a)
#pragma unroll
                for (int b = 0; b < 16; ++b) if ((a + 1) * (b + 1) <= 16) {
                    const float x = __builtin_bit_cast(float, (__builtin_bit_cast(unsigned, va[a] + vb[b]) & 0xffffff00u) | (unsigned)(a * 16 + b));
                    float nk[16];
                    nk[0] = __builtin_amdgcn_fmed3f(__builtin_inff(), x, tk[0]);
#pragma unroll
                    for (int j = 1; j < 16; ++j) nk[j] = __builtin_amdgcn_fmed3f(tk[j - 1], x, tk[j]);
#pragma unroll
                    for (int j = 0; j < 16; ++j) tk[j] = nk[j];
                }
            float tv[16]; int ti[16];
#pragma unroll
            for (int j = 0; j < 16; ++j) { const unsigned bits = __builtin_bit_cast(unsigned, tk[j]); tv[j] = __builtin_bit_cast(float, bits & 0xffffff00u);
                ti[j] = (int)TI[ra + ((bits >> 4) & 15u)] * 128 + (int)TI[rb + (bits & 15u)]; }
            float mx = tv[0], sum = 0.f, e[16];
#pragma unroll
            for (int j = 0; j < 16; ++j) { e[j] = fast_exp(tv[j] - mx); sum += e[j]; }
            const float inv = __builtin_amdgcn_rcpf(sum);
#pragma unroll
            for (int j = 0; j < 16; ++j) { EID[tok * 128 + h * 16 + j] = ti[j]; EG[tok * 128 + h * 16 + j] = e[j] * inv * VSC[ti[j]]; EU[tok * 128 + h * 16 + j] = USC[ti[j]]; }
        }
        __syncthreads();
        { const u32x4v i0 = *(const LAS u32x4v*)(EID + tid * 8), i1 = *(const LAS u32x4v*)(EID + tid * 8 + 4);
          const f32x4v a0 = *(const LAS f32x4v*)(EG + tid * 8), a1 = *(const LAS f32x4v*)(EG + tid * 8 + 4), u0 = *(const LAS f32x4v*)(EU + tid * 8), u1 = *(const LAS f32x4v*)(EU + tid * 8 + 4);
          *(u32x4v*)(G_SID + t0 * 128 + tid * 8) = i0; *(u32x4v*)(G_SID + t0 * 128 + tid * 8 + 4) = i1;
          *(f32x4v*)(G_SG + t0 * 128 + tid * 8) = a0; *(f32x4v*)(G_SG + t0 * 128 + tid * 8 + 4) = a1;
          *(f32x4v*)(G_SU + t0 * 128 + tid * 8) = u0; *(f32x4v*)(G_SU + t0 * 128 + tid * 8 + 4) = u1; }
        __syncthreads();
#undef tid
#undef lane
#undef fr
#undef fq
    }
    __syncthreads();
    int lane_o = C.lane, wave_o = C.wave; asm volatile("" : "+v"(lane_o), "+s"(wave_o));
#define lane lane_o
#define wave wave_o
    LAS float* PD = (LAS float*)(C.lds + PE_PD) + wave * 4096;
    LAS float* STAT = (LAS float*)(C.lds + PE_STAT) + wave * 64;
    LAS float* WSC = (LAS float*)(C.lds + PE_WSC) + wave * 32;
    {
#pragma unroll
        for (int i = 0; i < 16; ++i) *(LAS f32x4v*)(PD + (i * 64 + lane) * 4) = (f32x4v){0.f, 0.f, 0.f, 0.f};
        STAT[lane] = 0.f;
        LDS_FENCE();
    }
#define ID_LOAD(kb_) (*(const u32x2v*)(sid + 16 * (kb_) + 2 * pc))
#define ROW_ISSUE(buf, idv, hb_, tbl) do { _Pragma("unroll") for (int jj_ = 0; jj_ < 8; ++jj_) { const int j_ = 8 * ((hb_) & 1) + jj_; \
            const unsigned id_ = (unsigned)__shfl((int)((j_ & 1) ? idv.y : idv.x), 8 * g + (j_ >> 1)); \
            buf[jj_] = *(const u32x4v*)((tbl) + ((id_ << 7) + (unsigned)(pc * 16))); } } while (0)
#define STREAM(tbl, CONSUME) do { \
        u32x2v idA_ = idP0, idB_ = idP1; u32x4v bA_[8], bB_[8];                       \
        idP0 = *(const u32x2v*)(sidn + 2 * pc); idP1 = *(const u32x2v*)(sidn + 16 + 2 * pc); \
        ROW_ISSUE(bA_, idA_, 0, tbl); ROW_ISSUE(bB_, idA_, 1, tbl); \
        _Pragma("unroll 1") for (int hb = 0; hb < 16; hb += 2) { \
            __builtin_amdgcn_sched_barrier(0); CONSUME(bA_, hb); __builtin_amdgcn_sched_barrier(0);        \
            if (hb + 2 < 16) ROW_ISSUE(bA_, idB_, hb + 2, tbl); \
            __builtin_amdgcn_sched_barrier(0); CONSUME(bB_, hb + 1); __builtin_amdgcn_sched_barrier(0); \
            if (hb + 2 < 16) { ROW_ISSUE(bB_, idB_, hb + 3, tbl); idA_ = idB_; if (hb + 4 < 16) idB_ = ID_LOAD((hb >> 1) + 2); } } } while (0)
#define R_TOKEN(r_) ({ const int q_ = 8 * (r_) + g; const int tl_ = C.bid + (8 * sr + (q_ >> 2)) * C.G; (tl_ < ntile ? (size_t)tl_ * 32 + 4 * wave + (q_ & 3) : (size_t)0); })
    asm volatile("" : "+v"(lane_o));
    { const int g = lane >> 3, pc = lane & 7;
    u32x2v idP0, idP1; { const unsigned* s0_ = G_SID + R_TOKEN(0) * 128; idP0 = *(const u32x2v*)(s0_ + 2 * pc); idP1 = *(const u32x2v*)(s0_ + 16 + 2 * pc); }
    for (int repU = 0; repU < (((MK_REPEAT >> 20) & 5) ? 2 : 1); ++repU)
#pragma unroll 1
    for (int seg = 0; seg < NSEG; ++seg) {
#if MK_PASSBAR == 1
        grid.sync();
#endif
        const unsigned char* tbl = U8 + (size_t)seg * (16384u * SEGB);
#pragma unroll 1
        for (int r = 0; r < 4; ++r) {
            const int q = 8 * r + g; const int tile = C.bid + (8 * sr + (q >> 2)) * C.G; const bool valid = tile < ntile;
            const size_t token = valid ? (size_t)tile * 32 + 4 * wave + (q & 3) : 0;
            const unsigned* sid = G_SID + token * 128; const unsigned* sidn = G_SID + R_TOKEN((r + 1) & 3) * 128;
            const u32x4v x8 = *(const u32x4v*)(H8 + token * 1024 + seg * SEGB + pc * 16);
            LAS int* pdq = (LAS int*)PD + q * 128;
#define U_CONSUME(buf, hb_) do { int pv_[8]; \
                _Pragma("unroll") for (int i = 0; i < 8; ++i) { int a_ = __builtin_amdgcn_sdot4((int)buf[i][0], (int)x8[0], 0, false); a_ = __builtin_amdgcn_sdot4((int)buf[i][1], (int)x8[1], a_, false);     \
                    a_ = __builtin_amdgcn_sdot4((int)buf[i][2], (int)x8[2], a_, false); pv_[i] = __builtin_amdgcn_sdot4((int)buf[i][3], (int)x8[3], a_, false); } \
                int r_[4], q_[2];                                               \
                _Pragma("unroll") for (int i = 0; i < 4; ++i) { const int snd_ = (pc & 4) ? pv_[i] : pv_[i + 4], kp_ = (pc & 4) ? pv_[i + 4] : pv_[i]; r_[i] = kp_ + dppi_xor4(snd_); } \
                _Pragma("unroll") for (int i = 0; i < 2; ++i) { const int snd_ = (pc & 2) ? r_[i] : r_[i + 2], kp_ = (pc & 2) ? r_[i + 2] : r_[i]; q_[i] = kp_ + dppi_xor2(snd_); } \
                const int z_ = ((pc & 1) ? q_[1] : q_[0]) + dppi_xor1((pc & 1) ? q_[0] : q_[1]); \
                if (valid && repU == 0) pdq[8 * (hb_) + pc] += z_; } while (0)
#ifndef MK_NOU
            STREAM(tbl, U_CONSUME);
#endif
#undef U_CONSUME
        }
    }
    }
    LDS_FENCE();
    asm volatile("" : "+v"(lane_o));
#define W_TOKEN(q_) ({ const int tl_ = C.bid + (8 * sr + ((q_) >> 2)) * C.G; (size_t)(tl_ < ntile ? tl_ : C.bid) * 32 + 4 * wave + ((q_) & 3); })
    float nsg0, nsg1, nsu0, nsu1, nhs;
    { const size_t tk_ = W_TOKEN(0); nsg0 = G_SG[tk_ * 128 + lane]; nsg1 = G_SG[tk_ * 128 + 64 + lane]; nsu0 = G_SU[tk_ * 128 + lane]; nsu1 = G_SU[tk_ * 128 + 64 + lane]; nhs = HS[tk_]; }
#pragma unroll 1
    for (int q = 0; q < 32; ++q) { const int tile = C.bid + (8 * sr + (q >> 2)) * C.G;
        const float sg0 = nsg0, sg1 = nsg1, su0 = nsu0, su1 = nsu1, hs = nhs;
        { const size_t tk_ = W_TOKEN(q + 1 < 32 ? q + 1 : q); nsg0 = G_SG[tk_ * 128 + lane]; nsg1 = G_SG[tk_ * 128 + 64 + lane]; nsu0 = G_SU[tk_ * 128 + lane]; nsu1 = G_SU[tk_ * 128 + 64 + lane]; nhs = HS[tk_]; }
        if (tile >= ntile) continue;
        const float w0 = sg0 * gelu_tanh((float)((LAS int*)PD)[q * 128 + lane] * (su0 * hs));
        const float w1 = sg1 * gelu_tanh((float)((LAS int*)PD)[q * 128 + 64 + lane] * (su1 * hs));
        float am = fmaxf(fabsf(w0), fabsf(w1));
        am = wave_max_f(am);
        const float qs = am > 0.f ? 127.f / am : 0.f;
        LAS signed char* w8 = (LAS signed char*)(PD + q * 128);
        w8[lane] = (signed char)(int)__builtin_rintf(w0 * qs); w8[64 + lane] = (signed char)(int)__builtin_rintf(w1 * qs);
        if (lane == 0) WSC[q] = am * (1.f / 127.f); }
#undef W_TOKEN
    LDS_FENCE();
    asm volatile("" : "+v"(lane_o));
    { const int g = lane >> 3, pc = lane & 7;
    const unsigned shb = 8u * (unsigned)(lane & 3), selb = 0x0c0c0c0cu & ~(0xffu << shb);
    u32x2v idP0, idP1; { const unsigned* s0_ = G_SID + R_TOKEN(0) * 128; idP0 = *(const u32x2v*)(s0_ + 2 * pc); idP1 = *(const u32x2v*)(s0_ + 16 + 2 * pc); }
#pragma unroll 1
    for (int seg = 0; seg < NSEG; ++seg) {
#if MK_PASSBAR == 1
        grid.sync();
#endif
        const unsigned char* tbl = V8 + (size_t)seg * (16384u * SEGB);
#pragma unroll 1
        for (int r = 0; r < 4; ++r) {
            const int q = 8 * r + g; const int tile = C.bid + (8 * sr + (q >> 2)) * C.G; const bool valid = tile < ntile;
            const size_t token = valid ? (size_t)tile * 32 + 4 * wave + (q & 3) : 0;
            const unsigned* sid = G_SID + token * 128; const unsigned* sidn = G_SID + R_TOKEN((r + 1) & 3) * 128;
            const LAS unsigned char* wq_ = (const LAS unsigned char*)(PD + q * 128);
            const u32x4v h0 = *(const u32x4v*)(HB + token * 1024 + seg * SEGB + pc * 16), h1 = *(const u32x4v*)(HB + token * 1024 + seg * SEGB + pc * 16 + 8);
            i32x4v accR[4];
#pragma unroll
            for (int j = 0; j < 4; ++j) accR[j] = (i32x4v){0, 0, 0, 0};
#define V_CONSUME(buf, hb_) do { const u32x2v w8_ = *(const LAS u32x2v*)(wq_ + 8 * (hb_)); \
                _Pragma("unroll") for (int i = 0; i < 8; ++i) { const int bop_ = (int)__builtin_amdgcn_perm(w8_.y, w8_.x, selb | ((unsigned)i << shb)); \
                    _Pragma("unroll") for (int r_ = 0; r_ < 4; ++r_) accR[r_] = __builtin_amdgcn_mfma_i32_4x4x4i8((int)buf[i][r_], bop_, accR[r_], 0, 0, 0); } } while (0)
#ifndef MK_NOV
            STREAM(tbl, V_CONSUME);
#endif
#undef V_CONSUME
#pragma unroll
            for (int r_ = 0; r_ < 4; ++r_) {
#pragma unroll
                for (int a = 0; a < 4; a += 2) { const int snd = (pc & 1) ? accR[r_][a] : accR[r_][a + 1]; const int rcv = dppi_xor1(snd); if (pc & 1) accR[r_][a] = rcv; else accR[r_][a + 1] = rcv; }
#pragma unroll
                for (int a = 0; a < 2; ++a) { const int snd = (pc & 2) ? accR[r_][a] : accR[r_][a + 2]; const int rcv = dppi_xor2(snd); if (pc & 2) accR[r_][a] = rcv; else accR[r_][a + 2] = rcv; }
            }
            const float wsq = WSC[q];
            float y[16]; float s1 = 0.f, s2 = 0.f;
#pragma unroll
            for (int j = 0; j < 4; ++j) { y[2 * j] = ALPHA * bf_lo(h0[j]) + (float)accR[j >> 1][2 * (j & 1)] * wsq; y[2 * j + 1] = ALPHA * bf_hi(h0[j]) + (float)accR[j >> 1][2 * (j & 1) + 1] * wsq;
                y[8 + 2 * j] = ALPHA * bf_lo(h1[j]) + (float)accR[2 + (j >> 1)][2 * (j & 1)] * wsq; y[8 + 2 * j + 1] = ALPHA * bf_hi(h1[j]) + (float)accR[2 + (j >> 1)][2 * (j & 1) + 1] * wsq; }
#pragma unroll
            for (int j = 0; j < 16; ++j) { s1 += y[j]; s2 += y[j] * y[j]; }
            s1 += dpp_xor1(s1); s2 += dpp_xor1(s2); s1 += dpp_xor2(s1); s2 += dpp_xor2(s2); s1 += dpp_xor4(s1); s2 += dpp_xor4(s2);
            if (valid) { u16* op = YB + token * 1024 + seg * SEGB + pc * 16;
                u32x4v w0, w1;
#pragma unroll
                for (int c = 0; c < 4; ++c) { w0[c] = cvtpk(y[2 * c], y[2 * c + 1]); w1[c] = cvtpk(y[8 + 2 * c], y[8 + 2 * c + 1]); }
                *(u32x4v*)op = w0; *(u32x4v*)(op + 8) = w1;
                if (pc == 0) { STAT[2 * q] += s1; STAT[2 * q + 1] += s2; } }
        }
    }
    }
    LDS_FENCE();
    asm volatile("" : "+v"(lane_o));
    __builtin_amdgcn_fence(__ATOMIC_RELEASE, "workgroup");
    asm volatile("s_waitcnt vmcnt(0)" ::: "memory");
#define L_TOKEN(q_) ({ const int tl_ = C.bid + (8 * sr + ((q_) >> 2)) * C.G; (size_t)(tl_ < ntile ? tl_ : C.bid) * 32 + 4 * wave + ((q_) & 3); })
    u32x4v yn0, yn1; { const size_t tk_ = L_TOKEN(0); yn0 = *(const u32x4v*)(YB + tk_ * 1024 + lane * 16); yn1 = *(const u32x4v*)(YB + tk_ * 1024 + lane * 16 + 8); }
    f32x4v ga4[4], ba4[4];
#pragma unroll
    for (int c = 0; c < 4; ++c) { ga4[c] = *(const f32x4v*)(g2 + lane * 16 + 4 * c); ba4[c] = *(const f32x4v*)(b2 + lane * 16 + 4 * c); }
#pragma unroll 1
    for (int q = 0; q < 32; ++q) { const int tile = C.bid + (8 * sr + (q >> 2)) * C.G;
        const u32x4v y0 = yn0, y1 = yn1;
        { const size_t tk_ = L_TOKEN(q + 1 < 32 ? q + 1 : q); yn0 = *(const u32x4v*)(YB + tk_ * 1024 + lane * 16); yn1 = *(const u32x4v*)(YB + tk_ * 1024 + lane * 16 + 8); }
        if (tile >= ntile) continue;
        const size_t token = (size_t)tile * 32 + 4 * wave + (q & 3);
        const float mu = STAT[2 * q] * (1.f / 1024.f), var = STAT[2 * q + 1] * (1.f / 1024.f) - mu * mu;
        const float rstd = __builtin_amdgcn_rsqf(fmaxf(var, 0.f) + EPS);
        float* op = C.out + token * 1024 + lane * 16;
#pragma unroll
        for (int c = 0; c < 4; ++c) { const u32x4v& yy = c < 2 ? y0 : y1; const f32x4v yv = {bf_lo(yy[2 * (c & 1)]), bf_hi(yy[2 * (c & 1)]), bf_lo(yy[2 * (c & 1) + 1]), bf_hi(yy[2 * (c & 1) + 1])};
            *(f32x4v*)(op + 4 * c) = (yv - mu) * rstd * ga4[c] + ba4[c]; } }
#undef L_TOKEN
#undef ID_LOAD
#undef R_TOKEN
#undef ROW_ISSUE
#undef STREAM
#undef lane
#undef wave
    __syncthreads();
    }
}


#ifndef MK_LAUNCHES
#define MK_LAUNCHES 1
#endif
constexpr int NPHASE = 7;
#define REP(k) for (int rep_ = 0; rep_ < (((MK_REPEAT >> (k)) & 1) ? 2 : 1); ++rep_, ((MK_REPEAT >> (k)) & 1) ? grid.sync() : (void)0)


__global__ void __launch_bounds__(NTHREADS, 2) hymba_fwd(Args args) {
    extern __shared__ __attribute__((aligned(16))) unsigned char lds_raw[];
    Ctx C;
    C.lds = (LAS unsigned char*)lds_raw;
    C.tid = threadIdx.x; C.lane = C.tid & 63; C.wave = __builtin_amdgcn_readfirstlane(C.tid >> 6);
    C.G = gridDim.x; C.bid = blockIdx.x;
#pragma unroll
    for (int i = 0; i < 16; ++i) C.in[i] = args.in[i];
    C.out = args.out; C.ws = args.ws;
    const int lo = args.ph_lo, hi = args.ph_hi;
    cg::grid_group grid = cg::this_grid();
#ifdef MK_ONLY
#define IN(k) ((k) == MK_ONLY)
#else
#define IN(k) (lo <= (k) && (k) < hi)
#endif
    unsigned bar_target = 0u;
#define SEAM(k) do { if (IN(k) && IN((k) + 1)) { if ((k) == 0 || MK_REPEAT || !MK_CUSTOM_BAR) grid.sync(); else grid_bar(C, bar_target); } } while (0)
    unsigned char* ws = C.ws;
    if (IN(0)) REP(0) p0_prologue(C);
    SEAM(0);
    if (IN(0)) p0b_quant(C);
    SEAM(0);
    if (IN(1)) REP(1) {
        pg8::Gemm g{(const pg8::bf16_t*)(ws + WS_XB), (const pg8::bf16_t*)(ws + WS_W1Q), MTOK, N1, DM / 2};
        pg8::StaticOrder S; S.init(MTOK, N1, C.G, C.bid);
        pg8::EpiProj E{(pg8::bf16_t*)(ws + WS_QLAT), (pg8::bf16_t*)(ws + WS_QIDX), (pg8::bf16_t*)(ws + WS_CKV), (pg8::bf16_t*)(ws + WS_KIDX), (float*)(ws + WS_WIDX), (float*)(ws + WS_SSQ),
                       (pg8::bf16_t*)(ws + WS_HQ), (float*)(ws + WS_HLF), (pg8::bf16_t*)(ws + WS_HV), (pg8::bf16_t*)(ws + WS_HG), (const float*)(ws + WS_LB), (const float*)(ws + WS_XS), (const float*)(ws + WS_W1S)};
        pg8::gemm_phase<pg8::EpiProj, pg8::StaticOrder, true, true, true>(C.lds, g, S, E);
    }
    SEAM(1);
    if (IN(2)) REP(2) p2_mixers(C, rep_);
    SEAM(2);
    if (IN(3)) REP(3) {
        pg8::Gemm g{(const pg8::bf16_t*)(ws + WS_MIX), (const pg8::bf16_t*)(ws + WS_W3M), MTOK, DM, MIXB / 2};
        pg8::StaticOrder S; S.init(MTOK, DM, C.G, C.bid);
        pg8::EpiY1 E{C.in[I_X], (pg8::bf16_t*)(ws + WS_Y1), ALPHA, (const float*)(ws + WS_MIXS), (const float*)(ws + WS_W3S)};
        pg8::gemm_phase<pg8::EpiY1, pg8::StaticOrder, true, true, false, 8>(C.lds, g, S, E);
    }
    SEAM(3);
    if (IN(4)) REP(4) p4_ln1(C);
    SEAM(4);
    if (IN(5)) REP(5) {
        pg8::Gemm g{(const pg8::bf16_t*)(ws + WS_H8), (const pg8::bf16_t*)(ws + WS_W5Q), MTOK, NPQ, DM / 2};
        pg8::StaticOrder S; S.init(MTOK, NPQ, C.G, C.bid);
        pg8::EpiPQ E{(pg8::bf16_t*)(ws + WS_PQ), NPQ, (const float*)(ws + WS_HS), (const float*)(ws + WS_W5S)};
        pg8::gemm_phase<pg8::EpiPQ, pg8::StaticOrder, true, true, true>(C.lds, g, S, E);
    }
    SEAM(5);
    if (IN(6)) REP(6) p6_peer(C);
#undef IN
#undef SEAM
}

extern "C" void kernel_launch(void* const* d_in, const int* in_sizes, int n_in, void* d_out, int out_size, void* d_ws, size_t ws_size, hipStream_t stream) {
    static int grid = 0;
    if (grid == 0) {
        if (n_in != 16 || out_size != MTOK * DM || ws_size < WS_END) { fprintf(stderr, "kernel_launch: unexpected shapes (n_in %d, out %d, ws %zu)\n", n_in, out_size, ws_size); grid = -1; return; }
        int dev = 0, cus = 0, per_cu = 0;
        if (hipGetDevice(&dev) != hipSuccess || hipDeviceGetAttribute(&cus, hipDeviceAttributeMultiprocessorCount, dev) != hipSuccess) { grid = -1; return; }
        if (hipFuncSetAttribute((const void*)hymba_fwd, hipFuncAttributeMaxDynamicSharedMemorySize, LDS_BYTES) != hipSuccess) { fprintf(stderr, "kernel_launch: hipFuncSetAttribute failed\n"); grid = -1; return; }
        if (hipOccupancyMaxActiveBlocksPerMultiprocessor(&per_cu, (const void*)hymba_fwd, NTHREADS, LDS_BYTES) != hipSuccess || per_cu < 1) { fprintf(stderr, "kernel_launch: occupancy query says %d blocks per CU\n", per_cu); (void)hipGetLastError(); grid = -1; return; }
        grid = cus;
    }
    if (grid < 0) return;
    Args a{};
    for (int i = 0; i < 16; ++i) a.in[i] = (const float*)d_in[i];
    a.out = (float*)d_out; a.ws = (unsigned char*)d_ws;
#if MK_LAUNCHES == 1
    a.ph_lo = 0; a.ph_hi = NPHASE;
    void* kargs[] = {&a};
    hipError_t e = hipLaunchCooperativeKernel((const void*)hymba_fwd, dim3(grid), dim3(NTHREADS), kargs, LDS_BYTES, stream);
    if (e != hipSuccess) fprintf(stderr, "kernel_launch: cooperative launch failed: %s (grid %d)\n", hipGetErrorString(e), grid);
#else
    for (int p = 0; p < NPHASE; ++p) { a.ph_lo = p; a.ph_hi = p + 1; hipLaunchKernelGGL(hymba_fwd, dim3(grid), dim3(NTHREADS), LDS_BYTES, stream, a); }
#endif
}
```

```cpp
#include <hip/hip_runtime.h>
#include <hip/hip_cooperative_groups.h>
#include <cstdio>
#include <cstdint>
namespace cg = cooperative_groups;

#define LAS __attribute__((address_space(3)))
typedef unsigned short u16;
typedef short s16x8 __attribute__((ext_vector_type(8)));
typedef short s16x4 __attribute__((ext_vector_type(4)));
typedef float f32x4v __attribute__((ext_vector_type(4)));
typedef float f32x16v __attribute__((ext_vector_type(16)));
typedef unsigned u32x4v __attribute__((ext_vector_type(4)));
typedef unsigned u32x2v __attribute__((ext_vector_type(2)));
typedef __bf16 bf16x2v __attribute__((ext_vector_type(2)));

constexpr int NB = 8, SEQ = 8192, DM = 1024, MTOK = NB * SEQ;
constexpr int DIN = 3272;
constexpr int N1 = 3840;
constexpr int K3 = 1536;
constexpr int NPQ = 2048;
constexpr float EPS = 1e-5f;
constexpr float ALPHA = 1.189207115002721f;
constexpr int TOPK = 256;

constexpr size_t MiB = 1u << 20;
constexpr size_t WS_CTL = 0, WS_LB = 4096, WS_USC = 65536, WS_VSC = 131072;
constexpr size_t WS_W1T = 1 * MiB, WS_W3T = 9 * MiB, WS_W5T = 12 * MiB, WS_SKB = 16 * MiB, WS_UB = 17 * MiB, WS_VB = 49 * MiB;
constexpr size_t WS_XB = 832 * MiB, WS_MIX = 96 * MiB;
constexpr size_t WS_H8 = WS_MIX + 96 * MiB, WS_HS = WS_MIX + 160 * MiB;
constexpr size_t WS_W1Q = 36 * MiB, WS_W1S = 272 * 1024, WS_XS = 40 * MiB;
constexpr size_t WS_W3M = 44 * MiB, WS_W3S = 288 * 1024, WS_MIXS = 41 * MiB;
constexpr int MIXB = 2048;
constexpr size_t WS_W5Q = 34 * MiB, WS_W5S = 256 * 1024;
constexpr size_t WS_R2 = 288 * MiB;
constexpr size_t WS_QLAT = WS_R2, WS_QIDX = WS_R2 + 128 * MiB, WS_CKV = WS_R2 + 192 * MiB, WS_KIDX = WS_R2 + 208 * MiB, WS_WIDX = WS_R2 + 216 * MiB, WS_SSQ = WS_R2 + 218 * MiB;
constexpr size_t WS_HQ = WS_R2 + 224 * MiB, WS_HLF = WS_R2 + 288 * MiB, WS_HV = WS_R2 + 416 * MiB, WS_HG = WS_R2 + 480 * MiB;
constexpr size_t WS_Y1 = WS_R2, WS_HB = WS_R2 + 256 * MiB, WS_PQ = WS_R2;
constexpr size_t WS_YB = WS_R2 + 384 * MiB;
constexpr size_t WS_END = 896 * MiB;

#ifndef MK_REPEAT
#define MK_REPEAT 0
#endif
#ifndef MK_NOSORT
#define MK_NOSORT 0
#endif
constexpr int LDS_BYTES = 160 * 1024;
constexpr int NTHREADS = 512;

typedef float f32x2v __attribute__((ext_vector_type(2)));
__device__ __forceinline__ unsigned cvtpk(float lo, float hi) { const f32x2v v = {lo, hi}; const bf16x2v b = __builtin_convertvector(v, bf16x2v); return __builtin_bit_cast(unsigned, b); }
__device__ __forceinline__ float bf_lo(unsigned w) { return __builtin_bit_cast(float, w << 16); }
__device__ __forceinline__ float bf_hi(unsigned w) { return __builtin_bit_cast(float, w & 0xffff0000u); }
__device__ __forceinline__ float bf1(u16 w) { return __builtin_bit_cast(float, (unsigned)w << 16); }
__device__ __forceinline__ float fast_exp(float x) { return __builtin_amdgcn_exp2f(x * 1.4426950408889634f); }
__device__ __forceinline__ float sigmoidf_(float x) { return __builtin_amdgcn_rcpf(1.f + fast_exp(-x)); }
__device__ __forceinline__ float siluf_(float x) { return x * sigmoidf_(x); }
typedef int i32x4v __attribute__((ext_vector_type(4)));
__device__ __forceinline__ unsigned pack_i8(float a, float b, float c, float d) {
    const int ia = (int)__builtin_rintf(a), ib = (int)__builtin_rintf(b), ic = (int)__builtin_rintf(c), id = (int)__builtin_rintf(d);
    return ((unsigned)ia & 0xffu) | (((unsigned)ib & 0xffu) << 8) | (((unsigned)ic & 0xffu) << 16) | ((unsigned)id << 24);
}
__device__ __forceinline__ float dot2bf(unsigned a, unsigned b, float acc) { return __builtin_amdgcn_fdot2_f32_bf16(__builtin_bit_cast(bf16x2v, a), __builtin_bit_cast(bf16x2v, b), acc, false); }
__device__ __forceinline__ float dpp_xor1(float v) { return __builtin_bit_cast(float, __builtin_amdgcn_update_dpp(0, __builtin_bit_cast(int, v), 0xB1, 0xf, 0xf, true)); }
__device__ __forceinline__ float dpp_xor2(float v) { return __builtin_bit_cast(float, __builtin_amdgcn_update_dpp(0, __builtin_bit_cast(int, v), 0x4E, 0xf, 0xf, true)); }
__device__ __forceinline__ int dppi_xor1(int v) { return __builtin_amdgcn_update_dpp(0, v, 0xB1, 0xf, 0xf, true); }
__device__ __forceinline__ int dppi_xor2(int v) { return __builtin_amdgcn_update_dpp(0, v, 0x4E, 0xf, 0xf, true); }
__device__ __forceinline__ int dppi_xor4(int v) { return __builtin_amdgcn_update_dpp(0, __builtin_amdgcn_update_dpp(0, v, 0x141, 0xf, 0xf, true), 0x1B, 0xf, 0xf, true); }
__device__ __forceinline__ float dpp_xor4(float v) { const int t = __builtin_amdgcn_update_dpp(0, __builtin_bit_cast(int, v), 0x141, 0xf, 0xf, true); return __builtin_bit_cast(float, __builtin_amdgcn_update_dpp(0, t, 0x1B, 0xf, 0xf, true)); }
__device__ __forceinline__ float dpp_rowmirror(float v) { return __builtin_bit_cast(float, __builtin_amdgcn_update_dpp(0, __builtin_bit_cast(int, v), 0x140, 0xf, 0xf, true)); }
__device__ __forceinline__ float wave_max_f(float v) { v = fmaxf(v, dpp_xor1(v)); v = fmaxf(v, dpp_xor2(v)); v = fmaxf(v, dpp_xor4(v)); v = fmaxf(v, dpp_rowmirror(v)); v = fmaxf(v, __shfl_xor(v, 16)); return fmaxf(v, __shfl_xor(v, 32)); }
__device__ __forceinline__ float wave_sum_f(float v) { v += dpp_xor1(v); v += dpp_xor2(v); v += dpp_xor4(v); v += dpp_rowmirror(v); v += __shfl_xor(v, 16); return v + __shfl_xor(v, 32); }
#define LDS_FENCE() asm volatile("s_waitcnt lgkmcnt(0)" ::: "memory")

namespace pg8 {
#define PG8_LAS __attribute__((address_space(3)))
typedef unsigned short bf16_t;
typedef short bf16x8 __attribute__((ext_vector_type(8)));
typedef float f32x4 __attribute__((ext_vector_type(4)));
typedef unsigned u32x4 __attribute__((ext_vector_type(4)));
constexpr int BM = 256, BK = 64, HALF = 128, HTB = HALF * BK * 2  , STAGE_BYTES = 8 * HTB, NXCD = 8, WGM = 8;

__host__ __device__ __forceinline__ int lds_byte(int r, int c) { const int st = (r >> 4) * 2 + (c >> 5), rr = r & 15, cc = c & 31, ob = rr * 64 + cc * 2; return st * 1024 + (ob ^ (((ob >> 9) & 1) << 5)); }
__host__ __device__ __forceinline__ void stage_rc(int b, int& R, int& C) { const int st = b / 1024, sb = b % 1024, swz = sb ^ (((sb >> 9) & 1) << 5); R = (st >> 1) * 16 + swz / 64; C = (st & 1) * 32 + (swz % 64) / 2; }
__host__ __device__ __forceinline__ int perm32(int rho) { const int n = rho >> 4, i = rho & 15; return 8 * (i >> 2) + 4 * n + (i & 3); }

typedef int pg8_i32x4 __attribute__((ext_vector_type(4)));
struct Unit { int pm, pn; };
struct Gemm { const bf16_t* A; const bf16_t* Bt; int M, N, K; };

struct StaticOrder {
    int nM, nN, nwg, G, c;
    __host__ __device__ void init(int M, int N, int G_, int c_) { nM = M / BM; nN = N / BM; nwg = nM * nN; G = G_; c = c_; }
    __host__ __device__ bool next(int i, Unit& u) const {
        const long L = (long)i * G + c; if (L >= nwg) return false;
        int wgid = (int)L; { const int q = nwg / NXCD, r = nwg % NXCD, xcd = wgid % NXCD, off = wgid / NXCD; wgid = (xcd < r ? xcd * (q + 1) : r * (q + 1) + (xcd - r) * q) + off; }
        const int nig = WGM * nN, gid = wgid / nig, fm = gid * WGM, gsz = (nM - fm) < WGM ? (nM - fm) : WGM;
        u.pm = fm + ((wgid % nig) % gsz); u.pn = (wgid % nig) / gsz; return true;
    }
    __device__ __forceinline__ void a_ready(const Unit&) const {}
    __device__ __forceinline__ void done(const Unit&) const {}
};

__device__ __forceinline__ unsigned cvt_pk_bf16(float lo, float hi) { return cvtpk(lo, hi); }
typedef float f32x2 __attribute__((ext_vector_type(2)));

__device__ __forceinline__ u32x4 pack8(const f32x4& v0, const f32x4& v1) { u32x4 w; w.x = cvt_pk_bf16(v0[0], v0[1]); w.y = cvt_pk_bf16(v0[2], v0[3]); w.z = cvt_pk_bf16(v1[0], v1[1]); w.w = cvt_pk_bf16(v1[2], v1[3]); return w; }

struct EpiPlain {
    static constexpr bool PERM = true, AFTER_DRAIN = false;
    bf16_t* O; int ldc;
    __device__ __forceinline__ void operator()(const f32x4 (&acc)[2][2][4][2], const Unit& u, int wr, int wc, int fr, int fq) const {
        const int row0 = u.pm * BM + wr * 64 + fr, col0 = u.pn * BM + wc * 32 + 8 * fq;
#pragma unroll
        for (int ai = 0; ai < 2; ++ai)
#pragma unroll
            for (int m = 0; m < 4; ++m) { bf16_t* rowp = O + (size_t)(row0 + ai * HALF + m * 16) * ldc + col0;
#pragma unroll
                for (int bj = 0; bj < 2; ++bj) *(u32x4*)(rowp + bj * HALF) = pack8(acc[ai][bj][m][0], acc[ai][bj][m][1]); }
    }
};

struct EpiPQ {
    static constexpr bool PERM = true, AFTER_DRAIN = false;
    bf16_t* O; int ldc; const float* rs; const float* cs;
    __device__ __forceinline__ void operator()(const f32x4 (&acc)[2][2][4][2], const Unit& u, int wr, int wc, int fr, int fq) const {
        const int row0 = u.pm * BM + wr * 64 + fr, col0 = u.pn * BM + wc * 32 + 8 * fq;
        f32x4 c0[2], c1[2];
#pragma unroll
        for (int bj = 0; bj < 2; ++bj) { c0[bj] = *(const f32x4*)(cs + col0 + bj * HALF); c1[bj] = *(const f32x4*)(cs + col0 + bj * HALF + 4); }
#pragma unroll
        for (int ai = 0; ai < 2; ++ai)
#pragma unroll
            for (int m = 0; m < 4; ++m) { const int row = row0 + ai * HALF + m * 16; const float sr = rs[row];
                const size_t rb = (size_t)u.pm * 16 + wr * 4 + ai * 8 + m;
#pragma unroll
                for (int bj = 0; bj < 2; ++bj) { bf16_t* rowp = O + ((rb * 16 + (2 * u.pn + bj)) * 4 + wc) * 512 + (fr + 16 * fq) * 8;
                    const f32x4 v0 = __builtin_convertvector(__builtin_bit_cast(pg8_i32x4, acc[ai][bj][m][0]), f32x4) * sr * c0[bj], v1 = __builtin_convertvector(__builtin_bit_cast(pg8_i32x4, acc[ai][bj][m][1]), f32x4) * sr * c1[bj];
                    *(u32x4*)rowp = pack8(v0, v1); } }
    }
};

struct EpiY1 {
    static constexpr bool PERM = true, AFTER_DRAIN = false;
    const unsigned char* X8; const float* xs; bf16_t* Y; float alpha; const float* rs; const float* cs;
    __device__ __forceinline__ void to_float(f32x4 (&acc)[2][2][4][2], const Unit& u, int wr, int wc, int fr, int fq) const {
        const int row0 = u.pm * BM + wr * 64 + fr;
#pragma unroll
        for (int ai = 0; ai < 2; ++ai)
#pragma unroll
            for (int m = 0; m < 4; ++m) { const float sr = rs[row0 + ai * HALF + m * 16];
#pragma unroll
                for (int bj = 0; bj < 2; ++bj)
#pragma unroll
                    for (int n = 0; n < 2; ++n) acc[ai][bj][m][n] = __builtin_convertvector(__builtin_bit_cast(pg8_i32x4, acc[ai][bj][m][n]), f32x4) * sr; }
    }
    __device__ __forceinline__ void operator()(const f32x4 (&acc)[2][2][4][2], const Unit& u, int wr, int wc, int fr, int fq) const {
        const int row0 = u.pm * BM + wr * 64 + fr, col0 = u.pn * BM + wc * 32 + 8 * fq;
#pragma unroll
        for (int ai = 0; ai < 2; ++ai)
#pragma unroll
            for (int m = 0; m < 4; ++m) { const size_t o = (size_t)(row0 + ai * HALF + m * 16) * 1024 + col0; const float xa = xs[row0 + ai * HALF + m * 16];
#pragma unroll
                for (int bj = 0; bj < 2; ++bj) {
                    const unsigned* xp = (const unsigned*)(X8 + o + bj * HALF); const unsigned xw0 = xp[0], xw1 = xp[1];
                    f32x4 x0, x1;
#pragma unroll
                    for (int k = 0; k < 4; ++k) { x0[k] = xa * (float)((int)(xw0 << (24 - 8 * k)) >> 24); x1[k] = xa * (float)((int)(xw1 << (24 - 8 * k)) >> 24); }
                    const f32x4 c0 = *(const f32x4*)(cs + col0 + bj * HALF), c1 = *(const f32x4*)(cs + col0 + bj * HALF + 4);
                    *(u32x4*)(Y + o + bj * HALF) = pack8(x0 * alpha + acc[ai][bj][m][0] * c0, x1 * alpha + acc[ai][bj][m][1] * c1); } }
    }
};

__device__ __forceinline__ float ep_exp(float x) { return __builtin_amdgcn_exp2f(x * 1.4426950408889634f); }
__device__ __forceinline__ float ep_sig(float x) { return __builtin_amdgcn_rcpf(1.f + ep_exp(-x)); }
__device__ __forceinline__ f32x4 silu4(const f32x4& v) { f32x4 r; r[0] = v[0] * ep_sig(v[0]); r[1] = v[1] * ep_sig(v[1]); r[2] = v[2] * ep_sig(v[2]); r[3] = v[3] * ep_sig(v[3]); return r; }

struct EpiProj {
    static constexpr bool PERM = true, AFTER_DRAIN = false;
    bf16_t *QLAT, *QIDX, *CKV, *KIDX; float *WIDX, *SSQ; bf16_t* HQ; float* HLF; bf16_t *HV, *HG; const float* lb; const float* rs; const float* cs;
    __device__ __forceinline__ void operator()(const f32x4 (&acc)[2][2][4][2], const Unit& u, int wr, int wc, int fr, int fq) const {
        const int row0 = u.pm * BM + wr * 64 + fr, pn = u.pn;
        f32x4 cv[2][2];
#pragma unroll
        for (int bj = 0; bj < 2; ++bj)
#pragma unroll
            for (int n = 0; n < 2; ++n) cv[bj][n] = *(const f32x4*)(cs + pn * BM + bj * HALF + wc * 32 + 8 * fq + 4 * n);
#define PJ_A(ai, bj, m, n, sr) (__builtin_convertvector(__builtin_bit_cast(pg8_i32x4, acc[ai][bj][m][n]), f32x4) * (sr) * cv[bj][n])
        if (pn < 6) {
            bf16_t* base = pn < 4 ? QLAT : QIDX; const int ld = pn < 4 ? 1024 : 512; const int col0 = (pn < 4 ? pn : pn - 4) * BM + wc * 32 + 8 * fq;
#pragma unroll
            for (int ai = 0; ai < 2; ++ai)
#pragma unroll
                for (int m = 0; m < 4; ++m) { const int row = row0 + ai * HALF + m * 16; const float sr = rs[row]; bf16_t* rowp = base + (size_t)row * ld + col0;
#pragma unroll
                    for (int bj = 0; bj < 2; ++bj) *(u32x4*)(rowp + bj * HALF) = pack8(PJ_A(ai, bj, m, 0, sr), PJ_A(ai, bj, m, 1, sr)); }
        } else if (pn == 6) {
#pragma unroll
            for (int ai = 0; ai < 2; ++ai)
#pragma unroll
                for (int m = 0; m < 4; ++m) { const size_t r = (size_t)(row0 + ai * HALF + m * 16); const float sr = rs[r];
                    const f32x4 v0 = PJ_A(ai, 0, m, 0, sr), v1 = PJ_A(ai, 0, m, 1, sr);
                    *(u32x4*)(CKV + r * 128 + wc * 32 + 8 * fq) = pack8(v0, v1);
                    float ss = v0[0] * v0[0] + v0[1] * v0[1] + v0[2] * v0[2] + v0[3] * v0[3] + v1[0] * v1[0] + v1[1] * v1[1] + v1[2] * v1[2] + v1[3] * v1[3];
                    ss += __shfl_xor(ss, 16); ss += __shfl_xor(ss, 32);
                    if (fq == 0) SSQ[r * 4 + wc] = ss;
                    const f32x4 w0 = PJ_A(ai, 1, m, 0, sr), w1 = PJ_A(ai, 1, m, 1, sr);
                    if (wc < 2) *(u32x4*)(KIDX + ((r >> 4) * 2 + wc) * 512 + ((int)(r & 15) + 16 * fq) * 8) = pack8(w0, w1);
                    else if (wc == 2 && fq == 0) { *(f32x4*)(WIDX + r * 8) = w0; *(f32x4*)(WIDX + r * 8 + 4) = w1; } }
        } else {
            const int h = pn - 7; const int e0 = (wc & 1) * 32 + 8 * fq;
            f32x4 l0 = {0.f, 0.f, 0.f, 0.f}, l1 = l0;
            if (wc >= 2) { l0 = *(const f32x4*)(lb + h * 64 + e0); l1 = *(const f32x4*)(lb + h * 64 + e0 + 4); }
#pragma unroll
            for (int ai = 0; ai < 2; ++ai)
#pragma unroll
                for (int m = 0; m < 4; ++m) { const int row = row0 + ai * HALF + m * 16; const float sr = rs[row]; const size_t o = (((((size_t)(row >> 13) * 8 + h) * 256 + ((row & 8191) >> 5)) * 8 + (e0 >> 3)) * 32 + (row & 31)) * 8;
                    const f32x4 a0 = PJ_A(ai, 0, m, 0, sr), a1 = PJ_A(ai, 0, m, 1, sr), b0 = PJ_A(ai, 1, m, 0, sr), b1 = PJ_A(ai, 1, m, 1, sr);
                    if (wc < 2) {
                        *(u32x4*)(HQ + o) = pack8(silu4(a0), silu4(a1));
                        *(u32x4*)(HV + o) = pack8(b0, b1);
                    } else {
                        f32x4 f0, f1;
#pragma unroll
                        for (int j = 0; j < 4; ++j) { f0[j] = __builtin_amdgcn_logf(l0[j] + (1.f - l0[j]) * ep_sig(a0[j])) * 0.6931471805599453f; f1[j] = __builtin_amdgcn_logf(l1[j] + (1.f - l1[j]) * ep_sig(a1[j])) * 0.6931471805599453f; }
                        *(f32x4*)(HLF + o) = f0; *(f32x4*)(HLF + o + 4) = f1;
                        *(u32x4*)(HG + o) = pack8(silu4(b0), silu4(b1));
                    } }
        }
#undef PJ_A
    }
};
template <bool I8> __device__ __forceinline__ f32x4 mma_sel(const bf16x8& a, const bf16x8& b, const f32x4& c) {
    if constexpr (I8) return __builtin_bit_cast(f32x4, __builtin_amdgcn_mfma_i32_16x16x64_i8(__builtin_bit_cast(pg8_i32x4, a), __builtin_bit_cast(pg8_i32x4, b), __builtin_bit_cast(pg8_i32x4, c), 0, 0, 0));
    else return __builtin_amdgcn_mfma_f32_16x16x32_bf16(a, b, c, 0, 0, 0);
}
template <class Epi, class Sched, bool ALIGN_EPI = false, bool SP2 = false, bool I8 = false, int KSW = 0>
__device__ __forceinline__ void gemm_phase(PG8_LAS unsigned char* lds, const Gemm g, const Sched& S, const Epi& E) {
    const int tid = threadIdx.x, wid = __builtin_amdgcn_readfirstlane(tid >> 6), lane = tid & 63, wr = wid >> 2, wc = wid & 3, fr = lane & 15, fq = lane >> 4;
    const int K = g.K, nt = K / BK;
    unsigned voffA[2], voffB[2];
#pragma unroll
    for (int i = 0; i < 2; ++i) { int R, C; stage_rc(tid * 16 + i * 8192, R, C); const int Rb = Epi::PERM ? ((R & ~31) + perm32(R & 31)) : R;
        voffA[i] = (unsigned)(R * K + C) * 2u; voffB[i] = (unsigned)(Rb * K + C) * 2u; }
    const size_t kstep = (size_t)(BK * 2);
    const size_t hstep = (size_t)HALF * K * 2;
    const size_t tstep = 2 * hstep;
    const unsigned ldsw = (unsigned)wid * 1024u;
    const int aoff = lds_byte(wr * 64 + fr, fq * 8), boff = lds_byte(wc * 32 + fr, fq * 8);
#define PG8_SA(b, h) (((b) * 2 + (h)) * HTB)
#define PG8_SB(b, h) ((4 + (b) * 2 + (h)) * HTB)
#define PG8_STAGE(bufoff, gbase, voff) do { _Pragma("unroll") for (int _i = 0; _i < 2; ++_i) \
        __builtin_amdgcn_global_load_lds((const unsigned*)((const char*)(gbase) + (voff)[_i]), (PG8_LAS unsigned*)(lds + (bufoff) + ldsw + _i * 8192), 16, 0, 0); } while (0)
#define PG8_LDA(dst, b, h) do { _Pragma("unroll") for (int m = 0; m < 4; ++m) _Pragma("unroll") for (int k = 0; k < 2; ++k) dst[m][k] = *(const PG8_LAS bf16x8*)(lds + PG8_SA(b, h) + aoff + m * 2048 + k * 1024); } while (0)
#define PG8_LDB(dst, b, h) do { _Pragma("unroll") for (int n = 0; n < 2; ++n) _Pragma("unroll") for (int k = 0; k < 2; ++k) dst[n][k] = *(const PG8_LAS bf16x8*)(lds + PG8_SB(b, h) + boff + n * 2048 + k * 1024); } while (0)
#define PG8_MMA_LOOP(ai, bj, At, Bt, SEL) _Pragma("unroll") for (int m = 0; m < 4; ++m) _Pragma("unroll") for (int n = 0; n < 2; ++n) _Pragma("unroll") for (int k = 0; k < 2; ++k) \
        acc[ai][bj][m][n] = mma_sel<SEL>(Bt[n][k], At[m][k], acc[ai][bj][m][n]);
#define PG8_MMA(ai, bj, At, Bt) do { __builtin_amdgcn_s_setprio(1); \
        if constexpr (KSW > 0) { if (i8m) { PG8_MMA_LOOP(ai, bj, At, Bt, true) } else { PG8_MMA_LOOP(ai, bj, At, Bt, false) } } else { PG8_MMA_LOOP(ai, bj, At, Bt, I8) } \
        __builtin_amdgcn_s_setprio(0); } while (0)
#define PG8_WAIT_V(n) asm volatile("s_waitcnt vmcnt(" #n ")" ::: "memory")
#define PG8_WAIT_L(n) asm volatile("s_waitcnt lgkmcnt(" #n ")" ::: "memory")
#define PG8_BAR __builtin_amdgcn_s_barrier()
#define PG8_SCHED __builtin_amdgcn_sched_barrier(0)
    Unit cur, nxt; int ui = 0;
    if (!S.next(0, cur)) return;
    f32x4 acc[2][2][4][2];
#pragma unroll
    for (int a = 0; a < 2; ++a)
#pragma unroll
        for (int b = 0; b < 2; ++b)
#pragma unroll
            for (int m = 0; m < 4; ++m)
#pragma unroll
                for (int n = 0; n < 2; ++n) acc[a][b][m][n] = (f32x4){0.f, 0.f, 0.f, 0.f};
    bf16x8 At[4][2], B0[2][2], B1[2][2];
    const char* cA = (const char*)g.A + (size_t)cur.pm * tstep; const char* cB = (const char*)g.Bt + (size_t)cur.pn * tstep;
    S.a_ready(cur);
    if constexpr (SP2) {
        PG8_STAGE(PG8_SB(0, 0), cB, voffB); PG8_STAGE(PG8_SB(0, 1), cB + hstep, voffB); PG8_STAGE(PG8_SA(0, 0), cA, voffA); PG8_STAGE(PG8_SA(0, 1), cA + hstep, voffA);
        if (wr == 1) PG8_BAR;
        PG8_WAIT_V(2); PG8_BAR;
        PG8_STAGE(PG8_SB(1, 0), cB + kstep, voffB); PG8_STAGE(PG8_SA(1, 0), cA + kstep, voffA); PG8_STAGE(PG8_SB(1, 1), cB + hstep + kstep, voffB);
        PG8_WAIT_V(6); PG8_BAR;
    } else {
        PG8_STAGE(PG8_SB(0, 0), cB, voffB); PG8_STAGE(PG8_SA(0, 0), cA, voffA); PG8_STAGE(PG8_SB(0, 1), cB + hstep, voffB); PG8_STAGE(PG8_SA(0, 1), cA + hstep, voffA);
        if (wr == 1) PG8_BAR;
        PG8_WAIT_V(4); PG8_BAR;
        PG8_STAGE(PG8_SB(1, 0), cB + kstep, voffB); PG8_STAGE(PG8_SA(1, 0), cA + kstep, voffA); PG8_STAGE(PG8_SB(1, 1), cB + hstep + kstep, voffB);
        PG8_WAIT_V(6); PG8_BAR;
    }
    for (;;) {
        const bool has_next = S.next(ui + 1, nxt);
        const char* nA = has_next ? (const char*)g.A + (size_t)nxt.pm * tstep : cA; const char* nB = has_next ? (const char*)g.Bt + (size_t)nxt.pn * tstep : cB;
#pragma unroll
        for (int seg = 0; seg < (KSW > 0 ? 2 : 1); ++seg) {
        const bool i8m = (seg == 0); (void)i8m;
        if constexpr (KSW > 0) { if (seg == 1) E.to_float(acc, cur, wr, wc, fr, fq); }
        for (int t = (seg ? KSW : 0); t < ((KSW > 0 && seg == 0) ? KSW : nt); t += 2) {
            const bool last = (t == nt - 2);
            const char* a1 = cA + (size_t)(t + 1) * kstep;
            const char* a2 = last ? nA : cA + (size_t)(t + 2) * kstep; const char* b2 = last ? nB : cB + (size_t)(t + 2) * kstep;
            const char* a3 = a2 + kstep; const char* b3 = b2 + kstep;
            if (last && has_next) S.a_ready(nxt);
            if constexpr (SP2) {
            PG8_LDB(B0, 0, 0); PG8_LDB(B1, 0, 1); PG8_SCHED; PG8_LDA(At, 0, 0); PG8_STAGE(PG8_SA(1, 1), a1 + hstep, voffA);
            PG8_WAIT_V(8); PG8_WAIT_L(0); PG8_BAR; PG8_MMA(0, 0, At, B0); PG8_MMA(0, 1, At, B1); PG8_BAR; PG8_SCHED;
            PG8_LDA(At, 0, 1); PG8_STAGE(PG8_SB(0, 0), b2, voffB); PG8_STAGE(PG8_SB(0, 1), b2 + hstep, voffB); PG8_STAGE(PG8_SA(0, 0), a2, voffA);
            PG8_WAIT_V(8); PG8_WAIT_L(0); PG8_BAR; PG8_MMA(1, 0, At, B0); PG8_MMA(1, 1, At, B1); PG8_BAR; PG8_SCHED;
            PG8_LDB(B0, 1, 0); PG8_LDB(B1, 1, 1); PG8_SCHED; PG8_LDA(At, 1, 0); PG8_STAGE(PG8_SA(0, 1), a2 + hstep, voffA);
            PG8_WAIT_V(8); PG8_WAIT_L(0); PG8_BAR; PG8_MMA(0, 0, At, B0); PG8_MMA(0, 1, At, B1); PG8_BAR; PG8_SCHED;
            PG8_LDA(At, 1, 1); PG8_STAGE(PG8_SB(1, 0), b3, voffB); PG8_STAGE(PG8_SB(1, 1), b3 + hstep, voffB); PG8_STAGE(PG8_SA(1, 0), a3, voffA);
            PG8_WAIT_V(8); PG8_WAIT_L(0); PG8_BAR; PG8_MMA(1, 0, At, B0); PG8_MMA(1, 1, At, B1); PG8_BAR; PG8_SCHED;
            } else {
            PG8_LDB(B0, 0, 0); PG8_SCHED; PG8_LDA(At, 0, 0); PG8_STAGE(PG8_SA(1, 1), a1 + hstep, voffA);
            PG8_WAIT_L(8); PG8_BAR; PG8_WAIT_L(0); PG8_MMA(0, 0, At, B0); PG8_BAR; PG8_SCHED;
            PG8_LDB(B1, 0, 1); PG8_STAGE(PG8_SB(0, 0), b2, voffB);
            PG8_BAR; PG8_WAIT_L(0); PG8_MMA(0, 1, At, B1); PG8_BAR;
            PG8_LDA(At, 0, 1); PG8_STAGE(PG8_SA(0, 0), a2, voffA);
            PG8_BAR; PG8_WAIT_L(0); PG8_MMA(1, 0, At, B0); PG8_BAR; PG8_SCHED;
            PG8_STAGE(PG8_SB(0, 1), b2 + hstep, voffB);
            PG8_WAIT_V(6); PG8_BAR; PG8_MMA(1, 1, At, B1); PG8_BAR;
            PG8_LDB(B0, 1, 0); PG8_SCHED; PG8_LDA(At, 1, 0); PG8_STAGE(PG8_SA(0, 1), a2 + hstep, voffA);
            PG8_WAIT_L(8); PG8_BAR; PG8_WAIT_L(0); PG8_MMA(0, 0, At, B0); PG8_BAR; PG8_SCHED;
            PG8_LDB(B1, 1, 1); PG8_STAGE(PG8_SB(1, 0), b3, voffB);
            PG8_BAR; PG8_WAIT_L(0); PG8_MMA(0, 1, At, B1); PG8_BAR;
            PG8_LDA(At, 1, 1); PG8_STAGE(PG8_SA(1, 0), a3, voffA);
            PG8_BAR; PG8_WAIT_L(0); PG8_MMA(1, 0, At, B0); PG8_BAR; PG8_SCHED;
            PG8_STAGE(PG8_SB(1, 1), b3 + hstep, voffB);
            PG8_WAIT_V(6); PG8_BAR; PG8_MMA(1, 1, At, B1); PG8_BAR;
            }
        }
        }
        if constexpr (ALIGN_EPI) { if (wr == 0) PG8_BAR; }
        if constexpr (!Epi::AFTER_DRAIN) { E(acc, cur, wr, wc, fr, fq); S.done(cur); }
        if (!has_next) break;
#pragma unroll
        for (int a = 0; a < 2; ++a)
#pragma unroll
            for (int b = 0; b < 2; ++b)
#pragma unroll
                for (int m = 0; m < 4; ++m)
#pragma unroll
                    for (int n = 0; n < 2; ++n) acc[a][b][m][n] = (f32x4){0.f, 0.f, 0.f, 0.f};
        cur = nxt; cA = nA; cB = nB; ++ui;
        if constexpr (ALIGN_EPI) { if (wr == 1) PG8_BAR; }
    }
    PG8_WAIT_V(0);
    if constexpr (!ALIGN_EPI) { if (wr == 0) PG8_BAR; }
    PG8_BAR;
    if constexpr (Epi::AFTER_DRAIN) { E.fused(acc, cur, wr, wc, fr, fq, lds, wid, lane); S.done(cur); }
#undef PG8_SA
#undef PG8_SB
#undef PG8_STAGE
#undef PG8_LDA
#undef PG8_LDB
#undef PG8_MMA
#undef PG8_MMA_LOOP
#undef PG8_WAIT_V
#undef PG8_WAIT_L
#undef PG8_BAR
#undef PG8_SCHED
}
}

struct Args { const float* in[16]; float* out; unsigned char* ws; int ph_lo, ph_hi; };
enum { I_X = 0, I_WIN, I_KVG, I_WUK, I_WUV, I_LBL, I_HGN, I_WOUT, I_LN1G, I_LN1B, I_PWQ, I_PSK, I_PU, I_PV, I_LN2G, I_LN2B };

struct Ctx {
    LAS unsigned char* lds; int tid, lane, wave; int G, bid;
    const float* in[16]; float* out; unsigned char* ws;
};

template <class ColMap>
__device__ __forceinline__ void tr_tile(const Ctx& C, const float* src, int ld_src, int k0, int n0, const ColMap& cm, u16* dst, int ld_dst, int koff) {
    LAS float* T = (LAS float*)C.lds;
    const int nn = C.tid & 63, kq = C.tid >> 6;
    const int col = cm(n0 + nn);
#pragma unroll
    for (int i = 0; i < 8; ++i) { const int kk = kq + 8 * i; T[kk * 65 + nn] = col >= 0 ? src[(size_t)(k0 + kk) * ld_src + col] : 0.f; }
    __syncthreads();
    const int kk2 = C.tid & 63, nq = C.tid >> 6;
#pragma unroll
    for (int i = 0; i < 8; ++i) { const int n2 = nq + 8 * i; const float v = T[kk2 * 65 + n2];
        dst[(size_t)(n0 + n2) * ld_dst + koff + k0 + kk2] = (u16)(cvtpk(v, 0.f) & 0xffffu); }
    __syncthreads();
}

__device__ __forceinline__ int w1_col(int n) {
    if (n < 1536) return 640 + (n - 1024);
    if (n < 1792) { const int j = n - 1536; return j < 128 ? 512 + j : (j < 192 ? 1152 + (j - 128) : (j < 200 ? 1216 + (j - 192) : -1)); }
    const int j = n - 1792, h = j >> 8, part = (j & 255) >> 6, e = j & 63;
    return 1224 + part * 512 + h * 64 + e;
}

__device__ __forceinline__ void cvt_copy(const Ctx& C, const float* src, u16* dst, size_t n8) {
    const size_t stride = (size_t)C.G * NTHREADS;
    for (size_t i = (size_t)C.bid * NTHREADS + C.tid; i < n8; i += stride) {
        const f32x4v a = *(const f32x4v*)(src + i * 8), b = *(const f32x4v*)(src + i * 8 + 4);
        u32x4v w; w.x = cvtpk(a[0], a[1]); w.y = cvtpk(a[2], a[3]); w.z = cvtpk(b[0], b[1]); w.w = cvtpk(b[2], b[3]);
        *(u32x4v*)(dst + i * 8) = w;
    }
}

__device__ __forceinline__ void quant_rows_fp8(const Ctx& C, const float* src, unsigned char* dst, float* inv, int nrows) {
    const int lane = C.lane, gw = C.bid * 8 + C.wave, nw = C.G * 8;
    for (int r = gw; r < nrows; r += nw) {
        f32x4v v[4];
#pragma unroll
        for (int i = 0; i < 4; ++i) v[i] = *(const f32x4v*)(src + (size_t)r * 1024 + lane * 16 + 4 * i);
        float am = 0.f;
#pragma unroll
        for (int i = 0; i < 4; ++i) am = fmaxf(am, fmaxf(fmaxf(fabsf(v[i][0]), fabsf(v[i][1])), fmaxf(fabsf(v[i][2]), fabsf(v[i][3]))));
        am = wave_max_f(am);
        const int e = (int)((__builtin_bit_cast(unsigned, am) >> 23) & 0xffu) - 126;
        int k = 8 - e; k = k > 100 ? 100 : (k < -100 ? -100 : k); if (am == 0.f) k = 0;
        const float s = __builtin_bit_cast(float, (unsigned)(127 + k) << 23), si = __builtin_bit_cast(float, (unsigned)(127 - k) << 23);
        u32x4v w;
#pragma unroll
        for (int i = 0; i < 4; ++i) { int t = 0; t = __builtin_amdgcn_cvt_pk_fp8_f32(v[i][0] * s, v[i][1] * s, t, false); t = __builtin_amdgcn_cvt_pk_fp8_f32(v[i][2] * s, v[i][3] * s, t, true); w[i] = (unsigned)t; }
        *(u32x4v*)(dst + ((size_t)(lane >> 3) * nrows + r) * 128 + (lane & 7) * 16) = w;
        if (lane == 0) inv[r] = si;
    }
}

template <bool SLICED = true, int ISTR = 1>
__device__ __forceinline__ void quant_rows_i8(const Ctx& C, const float* src, unsigned char* dst, float* inv, int nrows) {
    const int lane = C.lane, gw = C.bid * 8 + C.wave, nw = C.G * 8;
    f32x4v vn[4];
    if (gw < nrows) {
#pragma unroll
        for (int i = 0; i < 4; ++i) vn[i] = *(const f32x4v*)(src + (size_t)gw * 1024 + lane * 16 + 4 * i); }
    for (int r = gw; r < nrows; r += nw) {
        f32x4v v[4];
#pragma unroll
        for (int i = 0; i < 4; ++i) v[i] = vn[i];
        { const int rn = r + nw < nrows ? r + nw : r;
#pragma unroll
          for (int i = 0; i < 4; ++i) vn[i] = *(const f32x4v*)(src + (size_t)rn * 1024 + lane * 16 + 4 * i); }
        float am = 0.f;
#pragma unroll
        for (int i = 0; i < 4; ++i) am = fmaxf(am, fmaxf(fmaxf(fabsf(v[i][0]), fabsf(v[i][1])), fmaxf(fabsf(v[i][2]), fabsf(v[i][3]))));
        am = wave_max_f(am);
        const float s = am > 0.f ? 127.f / am : 0.f;
        u32x4v w;
#pragma unroll
        for (int i = 0; i < 4; ++i) w[i] = pack_i8(v[i][0] * s, v[i][1] * s, v[i][2] * s, v[i][3] * s);
        if constexpr (SLICED) *(u32x4v*)(dst + ((size_t)(lane >> 3) * nrows + r) * 128 + (lane & 7) * 16) = w;
        else *(u32x4v*)(dst + (size_t)r * 1024 + lane * 16) = w;
        if (lane == 0) inv[(size_t)r * ISTR] = am * (1.f / 127.f);
    }
}

__device__ __forceinline__ void quant_wrows_i8(const Ctx& C, const u16* src, unsigned char* dst, float* sc, int nrows) {
    const int lane = C.lane, gw = C.bid * 8 + C.wave, nw = C.G * 8;
    for (int r = gw; r < nrows; r += nw) {
        const u32x4v y0 = *(const u32x4v*)(src + (size_t)r * 1024 + lane * 16), y1 = *(const u32x4v*)(src + (size_t)r * 1024 + lane * 16 + 8);
        float v[16]; float am = 0.f;
#pragma unroll
        for (int j = 0; j < 4; ++j) { v[2 * j] = bf_lo(y0[j]); v[2 * j + 1] = bf_hi(y0[j]); v[8 + 2 * j] = bf_lo(y1[j]); v[8 + 2 * j + 1] = bf_hi(y1[j]); }
#pragma unroll
        for (int j = 0; j < 16; ++j) am = fmaxf(am, fabsf(v[j]));
        am = wave_max_f(am);
        const float s = am > 0.f ? 127.f / am : 0.f;
        u32x4v w;
#pragma unroll
        for (int i = 0; i < 4; ++i) w[i] = pack_i8(v[4 * i] * s, v[4 * i + 1] * s, v[4 * i + 2] * s, v[4 * i + 3] * s);
        *(u32x4v*)(dst + (size_t)r * 1024 + lane * 16) = w;
        if (lane == 0) sc[r] = am * (1.f / 127.f);
    }
}
__device__ __forceinline__ void quant_w3_mixed(const Ctx& C) {
    const u16* src = (const u16*)(C.ws + WS_W3T); unsigned char* dst = C.ws + WS_W3M; float* sc = (float*)(C.ws + WS_W3S);
    const int lane = C.lane, gw = C.bid * 8 + C.wave, nw = C.G * 8;
    for (int r = gw; r < DM; r += nw) {
        const u32x4v y0 = *(const u32x4v*)(src + (size_t)r * K3 + lane * 16), y1 = *(const u32x4v*)(src + (size_t)r * K3 + lane * 16 + 8);
        const u32x4v hb = *(const u32x4v*)(src + (size_t)r * K3 + 1024 + lane * 8);
        float v[16]; float am = 0.f;
#pragma unroll
        for (int j = 0; j < 4; ++j) { v[2 * j] = bf_lo(y0[j]); v[2 * j + 1] = bf_hi(y0[j]); v[8 + 2 * j] = bf_lo(y1[j]); v[8 + 2 * j + 1] = bf_hi(y1[j]); }
#pragma unroll
        for (int j = 0; j < 16; ++j) am = fmaxf(am, fabsf(v[j]));
        am = wave_max_f(am);
        if (am == 0.f) am = 127.f;
        const float s = 127.f / am;
        u32x4v w, hs;
#pragma unroll
        for (int i = 0; i < 4; ++i) { w[i] = pack_i8(v[4 * i] * s, v[4 * i + 1] * s, v[4 * i + 2] * s, v[4 * i + 3] * s); hs[i] = cvtpk(bf_lo(hb[i]) * s, bf_hi(hb[i]) * s); }
        *(u32x4v*)(dst + (size_t)r * MIXB + lane * 16) = w;
        *(u32x4v*)(dst + (size_t)r * MIXB + 1024 + lane * 16) = hs;
        if (lane == 0) sc[r] = am * (1.f / 127.f);
    }
}
__device__ __forceinline__ void p0b_quant(const Ctx& C) {
    quant_w3_mixed(C);
    quant_wrows_i8(C, (const u16*)(C.ws + WS_W5T), C.ws + WS_W5Q, (float*)(C.ws + WS_W5S), NPQ);
    quant_wrows_i8(C, (const u16*)(C.ws + WS_W1T), C.ws + WS_W1Q, (float*)(C.ws + WS_W1S), N1);
}

__device__ __forceinline__ void p0_prologue(const Ctx& C) {
    unsigned char* ws = C.ws;
    if (C.bid == 0 && C.tid < 64) ((unsigned*)(ws + WS_CTL))[C.tid] = 0u;
    if (C.bid == 0) {
        const float* l = C.in[I_LBL]; float* lb = (float*)(ws + WS_LB);
        const float a = l[C.tid], b = l[512 + C.tid]; lb[C.tid] = 1.f / (1.f + expf(b - a));
    }
    quant_rows_i8<false>(C, C.in[I_X], ws + WS_XB, (float*)(ws + WS_XS), MTOK);
    quant_rows_i8<true, 2>(C, C.in[I_PU], ws + WS_UB, (float*)(ws + WS_USC), 16384);
    quant_rows_i8<true, 2>(C, C.in[I_PV], ws + WS_VB, (float*)(ws + WS_USC) + 1, 16384);
    { const float* psk = C.in[I_PSK]; u16* skb = (u16*)(ws + WS_SKB);
      for (size_t g = (size_t)C.bid * NTHREADS + C.tid; g < (size_t)16 * 8 * 4 * 64; g += (size_t)C.G * NTHREADS) {
          const int l = (int)(g & 63), ks = (int)((g >> 6) & 3), kt = (int)((g >> 8) & 7), hp = (int)(g >> 11);
          const float* sp = psk + ((size_t)(hp * 128 + 16 * kt + (l & 15)) * 128 + 32 * ks + 8 * (l >> 4));
          const f32x4v a = *(const f32x4v*)sp, b = *(const f32x4v*)(sp + 4);
          u32x4v w; w.x = cvtpk(a[0], a[1]); w.y = cvtpk(a[2], a[3]); w.z = cvtpk(b[0], b[1]); w.w = cvtpk(b[2], b[3]);
          *(u32x4v*)(skb + g * 8) = w; } }
    const float* w_in = C.in[I_WIN]; const float* w_out = C.in[I_WOUT]; const float* wq = C.in[I_PWQ];
    const float* kvg = C.in[I_KVG]; const float* wuk = C.in[I_WUK]; const float* wuv = C.in[I_WUV];
    u16* W1T = (u16*)(ws + WS_W1T); u16* W3T = (u16*)(ws + WS_W3T); u16* W5T = (u16*)(ws + WS_W5T);
    constexpr int T_W1F = 256, T_W1P = 44 * 16, T_W3F = 256, T_W3P = 16 * 8, T_W5 = 32 * 16, T_ALL = T_W1F + T_W1P + T_W3F + T_W3P + T_W5;
    LAS float* TA = (LAS float*)C.lds;
    LAS float* TB = TA + 64 * 65;
    for (int task = C.bid; task < T_ALL; task += C.G) {
        int t = task;
        if (t < T_W1F) {
            const int h = t >> 5, cb = (t >> 4) & 1, kb = t & 15, c0 = cb * 64, k0 = kb * 64;
            { const int d = C.tid & 63, q = C.tid >> 6;
#pragma unroll
              for (int i = 0; i < 8; ++i) { const int r = q + 8 * i; TA[r * 65 + d] = w_in[(size_t)(k0 + r) * DIN + h * 64 + d]; TB[r * 65 + d] = wuk[(size_t)(h * 128 + c0 + r) * 64 + d]; } }
            __syncthreads();
            { const int kk = C.tid & 63, q = C.tid >> 6;
#pragma unroll
              for (int i = 0; i < 8; ++i) { const int cc = q + 8 * i; float s = 0.f;
#pragma unroll 8
                  for (int d = 0; d < 64; ++d) s += TA[kk * 65 + d] * TB[cc * 65 + d];
                  s *= kvg[c0 + cc] * 0.125f;
                  W1T[(size_t)(h * 128 + c0 + cc) * 1024 + k0 + kk] = (u16)(cvtpk(s, 0.f) & 0xffffu); } }
            __syncthreads();
            continue;
        }
        t -= T_W1F;
        if (t < T_W1P) { const int nb = t >> 4, kb = t & 15; tr_tile(C, w_in, DIN, kb * 64, 1024 + nb * 64, [](int n) { return w1_col(n); }, W1T, 1024, 0); continue; }
        t -= T_W1P;
        if (t < T_W3F) {
            const int h = t >> 5, cb = (t >> 4) & 1, nb = t & 15, c0 = cb * 64, n0 = nb * 64;
            { const int x = C.tid & 63, q = C.tid >> 6;
#pragma unroll
              for (int i = 0; i < 8; ++i) { const int r = q + 8 * i; TA[r * 65 + x] = w_out[(size_t)(h * 64 + r) * 1024 + n0 + x]; TB[r * 65 + x] = wuv[(size_t)(h * 128 + c0 + r) * 64 + x]; } }
            __syncthreads();
            { const int cc = C.tid & 63, q = C.tid >> 6;
#pragma unroll
              for (int i = 0; i < 8; ++i) { const int nn = q + 8 * i; float s = 0.f;
#pragma unroll 8
                  for (int d = 0; d < 64; ++d) s += TB[cc * 65 + d] * TA[d * 65 + nn];
                  s *= kvg[c0 + cc];
                  W3T[(size_t)(n0 + nn) * K3 + h * 128 + c0 + cc] = (u16)(cvtpk(s, 0.f) & 0xffffu); } }
            __syncthreads();
            continue;
        }
        t -= T_W3F;
        if (t < T_W3P) { const int nb = t >> 3, kb = t & 7; tr_tile(C, w_out + (size_t)512 * 1024, 1024, kb * 64, nb * 64, [](int n) { return n; }, W3T, K3, 1024); continue; }
        t -= T_W3P;
        { const int nb = t >> 4, kb = t & 15; tr_tile(C, wq, NPQ, kb * 64, nb * 64, [](int n) { return n; }, W5T, 1024, 0); }
    }
}

#ifndef MK_CUSTOM_BAR
#define MK_CUSTOM_BAR 0
#endif
__device__ __forceinline__ void grid_bar(const Ctx& C, unsigned& target, int word = 24) {
    __syncthreads();
    if (C.tid == 0) {
        unsigned* ctr = (unsigned*)(C.ws + WS_CTL) + word;
        __builtin_amdgcn_fence(__ATOMIC_RELEASE, "agent");
        asm volatile("s_waitcnt vmcnt(0)" ::: "memory");
        __hip_atomic_fetch_add(ctr, 1u, __ATOMIC_RELAXED, __HIP_MEMORY_SCOPE_AGENT);
        target += (unsigned)C.G;
        for (unsigned spin = 0; spin < (1u << 24); ++spin) { if (__hip_atomic_load(ctr, __ATOMIC_RELAXED, __HIP_MEMORY_SCOPE_AGENT) >= target) break; __builtin_amdgcn_s_sleep(1); }
        __builtin_amdgcn_fence(__ATOMIC_ACQUIRE, "agent");
        asm volatile("s_waitcnt vmcnt(0)" ::: "memory");
    }
    __syncthreads();
}


__device__ __forceinline__ f32x4v mfma16(s16x8 a, s16x8 b, f32x4v c) { return __builtin_amdgcn_mfma_f32_16x16x32_bf16(a, b, c, 0, 0, 0); }
__device__ __forceinline__ f32x16v mfma32(s16x8 a, s16x8 b, f32x16v c) { return __builtin_amdgcn_mfma_f32_32x32x16_bf16(a, b, c, 0, 0, 0); }
__device__ __forceinline__ s16x4 tr4(const LAS u16* p) { return __builtin_bit_cast(s16x4, __builtin_amdgcn_ds_read_tr16_b64_v4i16((LAS s16x4*)p)); }
__device__ __forceinline__ s16x8 cat4(s16x4 a, s16x4 b) { s16x8 r; r[0] = a[0]; r[1] = a[1]; r[2] = a[2]; r[3] = a[3]; r[4] = b[0]; r[5] = b[1]; r[6] = b[2]; r[7] = b[3]; return r; }
__device__ __forceinline__ s16x8 pack8f(const f32x4v& a, const f32x4v& b) { u32x4v w; w.x = cvtpk(a[0], a[1]); w.y = cvtpk(a[2], a[3]); w.z = cvtpk(b[0], b[1]); w.w = cvtpk(b[2], b[3]); return __builtin_bit_cast(s16x8, w); }

__device__ __forceinline__ float scan32_incl(float v) {
    v += __builtin_bit_cast(float, __builtin_amdgcn_update_dpp(0, __builtin_bit_cast(int, v), 0x111, 0xf, 0xf, true));
    v += __builtin_bit_cast(float, __builtin_amdgcn_update_dpp(0, __builtin_bit_cast(int, v), 0x112, 0xf, 0xf, true));
    v += __builtin_bit_cast(float, __builtin_amdgcn_update_dpp(0, __builtin_bit_cast(int, v), 0x114, 0xf, 0xf, true));
    v += __builtin_bit_cast(float, __builtin_amdgcn_update_dpp(0, __builtin_bit_cast(int, v), 0x118, 0xf, 0xf, true));
    v += __builtin_bit_cast(float, __builtin_amdgcn_update_dpp(0, __builtin_bit_cast(int, v), 0x142, 0xa, 0xf, false));
    return v;
}
constexpr int HG_SET = 16640, HG_OI = 2 * HG_SET, HG_SSQ = HG_OI + 2 * 8192;

__device__ __forceinline__ void hgrn_seq(const Ctx& C, int bh) {
    const int b = bh >> 3, h = bh & 7;
    const int tid = C.tid, lane = C.lane, wave = C.wave, fr = lane & 15, fq = lane >> 4;
    unsigned char* ws = C.ws;
    const u16* HQ = (const u16*)(ws + WS_HQ); const float* HLF = (const float*)(ws + WS_HLF); const u16* HV = (const u16*)(ws + WS_HV); const u16* HG = (const u16*)(ws + WS_HG);
    u16* MIX = (u16*)(ws + WS_MIX);
    const size_t rowbase = (size_t)b * SEQ;
    constexpr int NCH = SEQ / 32;
    LAS float* SSQ = (LAS float*)(C.lds + HG_SSQ);
    if (wave >= 4) {
        const int t = lane & 31, cg = (tid - 256) >> 5;
        f32x4v gn0 = *(const f32x4v*)(C.in[I_HGN] + 8 * cg), gn1 = *(const f32x4v*)(C.in[I_HGN] + 8 * cg + 4);
        f32x4v lfa[4], lfb[4]; u32x4v qv[4], vv[4], gg[4]; u32x4v gp1 = {0u, 0u, 0u, 0u}, gp2 = gp1;
#define HG_LOAD(k_, n_) do { const int nc_ = (n_) < NCH ? (n_) : NCH - 1; const size_t o_ = (((((size_t)b * 8 + h) * 256 + nc_) * 8 + cg) * 32 + t) * 8;     lfa[k_] = *(const f32x4v*)(HLF + o_); lfb[k_] = *(const f32x4v*)(HLF + o_ + 4); \
            qv[k_] = *(const u32x4v*)(HQ + o_); vv[k_] = *(const u32x4v*)(HV + o_); gg[k_] = *(const u32x4v*)(HG + o_); } while (0)
        HG_LOAD(0, 0); HG_LOAD(1, 1); HG_LOAD(2, 2); HG_LOAD(3, 3);
#define S_BODY(n, k) { \
              \
            if ((n) >= 1) { \
                const LAS float* OI = (const LAS float*)(C.lds + HG_OI) + (((n) - 1) & 1) * 2048; \
                const LAS float* sq = SSQ + (((n) - 1) & 1) * 128; \
                const float rstd = __builtin_amdgcn_rsqf(((sq[t] + sq[32 + t]) + (sq[64 + t] + sq[96 + t])) * (1.f / 64.f) + EPS); \
                float o[8]; \
                _Pragma("unroll") for (int j = 0; j < 8; ++j) o[j] = OI[(8 * cg + j) * 32 + t] * rstd; \
                u32x4v w; \
                w.x = cvtpk(o[0] * gn0[0] * bf_lo(gp2.x), o[1] * gn0[1] * bf_hi(gp2.x)); w.y = cvtpk(o[2] * gn0[2] * bf_lo(gp2.y), o[3] * gn0[3] * bf_hi(gp2.y)); \
                w.z = cvtpk(o[4] * gn1[0] * bf_lo(gp2.z), o[5] * gn1[1] * bf_hi(gp2.z)); w.w = cvtpk(o[6] * gn1[2] * bf_lo(gp2.w), o[7] * gn1[3] * bf_hi(gp2.w)); \
                *(u32x4v*)(MIX + (rowbase + (size_t)((n) - 1) * 32 + t) * (MIXB / 2) + 512 + h * 64 + 8 * cg) = w;     \
            } \
              \
            if ((n) + 1 < NCH) { \
                LAS unsigned char* S_ = C.lds + (((n) + 1) & 1) * HG_SET; \
                LAS u16* QT = (LAS u16*)S_; LAS u16* KT = QT + 2048; LAS u16* KDT = KT + 2048; LAS u16* VS = KDT + 2048; LAS float* DEC = (LAS float*)(VS + 2048); \
                float lf[8], qf[8]; \
                _Pragma("unroll") for (int j = 0; j < 4; ++j) { lf[j] = lfa[k][j]; lf[4 + j] = lfb[k][j]; qf[2 * j] = bf_lo(qv[k][j]); qf[2 * j + 1] = bf_hi(qv[k][j]); } \
                float qt[8], kt[8], kd[8], dc[8]; \
                _Pragma("unroll") for (int j = 0; j < 8; ++j) { \
                    const float bcum = scan32_incl(lf[j]); \
                    const float bl31 = __builtin_bit_cast(float, __builtin_amdgcn_readlane(__builtin_bit_cast(int, bcum), 31)), bl63 = __builtin_bit_cast(float, __builtin_amdgcn_readlane(__builtin_bit_cast(int, bcum), 63)); \
                    const float bl = lane < 32 ? bl31 : bl63; \
                    const float kk = 1.f - fast_exp(lf[j]); \
                    qt[j] = qf[j] * fast_exp(bcum); kt[j] = kk * fast_exp(-bcum); kd[j] = kk * fast_exp(bl - bcum); dc[j] = fast_exp(bl); \
                } \
                { u32x4v w; w.x = cvtpk(qt[0], qt[1]); w.y = cvtpk(qt[2], qt[3]); w.z = cvtpk(qt[4], qt[5]); w.w = cvtpk(qt[6], qt[7]); *(LAS u32x4v*)(QT + t * 64 + 8 * cg) = w; \
                  w.x = cvtpk(kt[0], kt[1]); w.y = cvtpk(kt[2], kt[3]); w.z = cvtpk(kt[4], kt[5]); w.w = cvtpk(kt[6], kt[7]); *(LAS u32x4v*)(KT + t * 64 + 8 * cg) = w; \
                  *(LAS u32x4v*)(VS + t * 64 + 8 * cg) = vv[k]; \
                  _Pragma("unroll") for (int j = 0; j < 8; ++j) KDT[(8 * cg + j) * 32 + t] = (u16)(cvtpk(kd[j], 0.f) & 0xffffu); \
                  if (t == 0) { *(LAS f32x4v*)(DEC + 8 * cg) = (f32x4v){dc[0], dc[1], dc[2], dc[3]}; *(LAS f32x4v*)(DEC + 8 * cg + 4) = (f32x4v){dc[4], dc[5], dc[6], dc[7]}; } } \
                gp2 = gp1; gp1 = gg[k]; \
            } else { gp2 = gp1; } \
            HG_LOAD(k, (n) + 5);                                             \
            __syncthreads(); }
        for (int n0 = -1; ; n0 += 4) {
            S_BODY(n0, 0) S_BODY(n0 + 1, 1)
            if (n0 + 1 >= NCH) break;
            S_BODY(n0 + 2, 2) S_BODY(n0 + 3, 3)
        }
#undef S_BODY
#undef HG_LOAD
    } else {
        const int et = wave;
        f32x4v Sst[4];
#pragma unroll
        for (int i = 0; i < 4; ++i) Sst[i] = (f32x4v){0.f, 0.f, 0.f, 0.f};
        const int q = (lane & 15) >> 2, p = lane & 3;
        for (int n = -1; n <= NCH; ++n) {
            if (n >= 0 && n < NCH) {
                LAS unsigned char* S_ = C.lds + (n & 1) * HG_SET;
                const LAS u16* QT = (const LAS u16*)S_; const LAS u16* KT = QT + 2048; const LAS u16* KDT = KT + 2048; const LAS u16* VS = KDT + 2048; const LAS float* DEC = (const LAS float*)(VS + 2048);
                LAS float* OI = (LAS float*)(C.lds + HG_OI) + (n & 1) * 2048;
                f32x4v oi[2] = {{0.f, 0.f, 0.f, 0.f}, {0.f, 0.f, 0.f, 0.f}};
#pragma unroll
                for (int ks = 0; ks < 2; ++ks) {
                    const s16x8 sa = pack8f(Sst[2 * ks], Sst[2 * ks + 1]);
#pragma unroll
                    for (int tt = 0; tt < 2; ++tt) {
                        const s16x4 lo = *(const LAS s16x4*)(QT + (16 * tt + fr) * 64 + 32 * ks + 4 * fq), hi = *(const LAS s16x4*)(QT + (16 * tt + fr) * 64 + 32 * ks + 16 + 4 * fq);
                        oi[tt] = mfma16(sa, cat4(lo, hi), oi[tt]);
                    }
                }
                f32x4v a00 = {0.f, 0.f, 0.f, 0.f}, a10 = a00, a11 = a00;
#pragma unroll
                for (int ks = 0; ks < 2; ++ks) {
                    const s16x8 k0 = *(const LAS s16x8*)(KT + fr * 64 + 32 * ks + 8 * fq), k1 = *(const LAS s16x8*)(KT + (16 + fr) * 64 + 32 * ks + 8 * fq);
                    const s16x8 q0 = *(const LAS s16x8*)(QT + fr * 64 + 32 * ks + 8 * fq), q1 = *(const LAS s16x8*)(QT + (16 + fr) * 64 + 32 * ks + 8 * fq);
                    a00 = mfma16(k0, q0, a00); a10 = mfma16(k0, q1, a10); a11 = mfma16(k1, q1, a11);
                }
#pragma unroll
                for (int i = 0; i < 4; ++i) { const bool keep = (4 * fq + i) <= fr; a00[i] = keep ? a00[i] : 0.f; a11[i] = keep ? a11[i] : 0.f; }
                const f32x4v z = {0.f, 0.f, 0.f, 0.f};
                const s16x8 pb0 = pack8f(a00, z), pb1 = pack8f(a10, a11);
                const s16x8 va = cat4(tr4(VS + (4 * fq + q) * 64 + 16 * et + 4 * p), tr4(VS + (16 + 4 * fq + q) * 64 + 16 * et + 4 * p));
                oi[0] = mfma16(va, pb0, oi[0]); oi[1] = mfma16(va, pb1, oi[1]);
                const s16x8 vb = cat4(tr4(VS + (8 * fq + q) * 64 + 16 * et + 4 * p), tr4(VS + (8 * fq + 4 + q) * 64 + 16 * et + 4 * p));
#pragma unroll
                for (int dt = 0; dt < 4; ++dt) {
                    const s16x8 ka = *(const LAS s16x8*)(KDT + (16 * dt + fr) * 32 + 8 * fq);
                    const f32x4v ds = mfma16(ka, vb, z);
                    const f32x4v dc = *(const LAS f32x4v*)(DEC + 16 * dt + 4 * fq);
                    Sst[dt] = Sst[dt] * dc + ds;
                }
                LAS float* sq = SSQ + (n & 1) * 128 + et * 32;
#pragma unroll
                for (int tt = 0; tt < 2; ++tt) { float s = 0.f;
#pragma unroll
                    for (int i = 0; i < 4; ++i) { OI[(16 * et + 4 * fq + i) * 32 + 16 * tt + fr] = oi[tt][i]; s += oi[tt][i] * oi[tt][i]; }
                    s += __shfl_xor(s, 16); s += __shfl_xor(s, 32);
                    if (fq == 0) sq[16 * tt + fr] = s; }
            }
            __syncthreads();
        }
    }
    __syncthreads();
}

constexpr int DSA_SC = 0, DSA_H1 = 131072, DSA_IDX = 139264, DSA_KST = 143360, DSA_ITEM = 159744;
__device__ __forceinline__ unsigned off_b(unsigned row, unsigned ch) { return 256u * row + 16u * (ch ^ (((row & 3) << 2) | ((row >> 2) & 3))); }
__device__ __forceinline__ unsigned mono16(unsigned h) { return (h & 0x8000u) ? (~h & 0xffffu) : (h | 0x8000u); }

__device__ __forceinline__ int wave_incl_scan_dpp(int v) {
    v += __builtin_amdgcn_update_dpp(0, v, 0x111, 0xf, 0xf, true);
    v += __builtin_amdgcn_update_dpp(0, v, 0x112, 0xf, 0xf, true);
    v += __builtin_amdgcn_update_dpp(0, v, 0x114, 0xf, 0xf, true);
    v += __builtin_amdgcn_update_dpp(0, v, 0x118, 0xf, 0xf, true);
    v += __builtin_amdgcn_update_dpp(0, v, 0x142, 0xa, 0xf, false);
    v += __builtin_amdgcn_update_dpp(0, v, 0x143, 0xc, 0xf, false);
    return v;
}
__device__ __forceinline__ void find_bin(const LAS unsigned* hist, int lane, int target, int& B, int& above) {
    const u32x4v c = *(const LAS u32x4v*)(hist + 4 * lane);
    const int tot = (int)(c.x + c.y + c.z + c.w);
    const int pre = wave_incl_scan_dpp(tot);
    const int all = __builtin_amdgcn_readlane(pre, 63);
    const int suf = all - pre + tot;
    const int ab = suf - tot;
    const bool here = (ab < target) && (suf >= target);
    int b = -1, a = 0;
    if (here) {
        int cum = ab;
        if (cum + (int)c.w >= target) { b = 4 * lane + 3; a = cum; }
        else { cum += (int)c.w;
            if (cum + (int)c.z >= target) { b = 4 * lane + 2; a = cum; }
            else { cum += (int)c.z;
                if (cum + (int)c.y >= target) { b = 4 * lane + 1; a = cum; }
                else { cum += (int)c.y; b = 4 * lane; a = cum; } } }
    }
    const unsigned long long m = __ballot(here);
    const int src = m ? (int)__builtin_ctzll(m) : 0;
    B = __shfl(b, src); above = __shfl(a, src);
}

__device__ __forceinline__ int wave_incl_scan(int v, int lane) {
#pragma unroll
    for (int d = 1; d < 64; d <<= 1) { const int o = __shfl_up(v, d); if (lane >= d) v += o; }
    return v;
}

typedef short s16x2v __attribute__((ext_vector_type(2)));
__device__ __forceinline__ unsigned relu_pk_bf16(unsigned x) { return __builtin_bit_cast(unsigned, __builtin_elementwise_max(__builtin_bit_cast(s16x2v, x), (s16x2v){0, 0})); }

struct APre { s16x8 Aop[4][2]; f32x4v w0[2], w1[2]; u32x4v g[2][2]; };
__device__ __forceinline__ void dsa_pre(const Ctx& C, int b, int qt, APre& P) {
    const int lane = C.lane, wave = C.wave, fr = lane & 15, fq = lane >> 4;
    unsigned char* ws = C.ws;
    const u16* QIDX = (const u16*)(ws + WS_QIDX); const u16* KIDX = (const u16*)(ws + WS_KIDX); const float* WIDX = (const float*)(ws + WS_WIDX);
    const size_t tb = (size_t)b * SEQ; const int q0 = qt * 8, nt16 = (q0 + 8 + 15) >> 4;
#pragma unroll
    for (int m = 0; m < 4; ++m) { const u16* p = QIDX + (tb + q0 + 4 * (m >> 1) + (fr >> 2)) * 512 + (4 * (m & 1) + (fr & 3)) * 64 + 8 * fq;
#pragma unroll
        for (int ks = 0; ks < 2; ++ks) P.Aop[m][ks] = *(const s16x8*)(p + 32 * ks); }
#pragma unroll
    for (int qq = 0; qq < 2; ++qq) { const float* wp = WIDX + (tb + q0 + 4 * qq + fq) * 8; P.w0[qq] = *(const f32x4v*)wp; P.w1[qq] = *(const f32x4v*)(wp + 4); }
    const u16* kfb = KIDX + (tb >> 4) * 1024 + lane * 8;
#pragma unroll
    for (int j = 0; j < 2; ++j) { const int t_ = wave + 8 * j < nt16 ? wave + 8 * j : (wave < nt16 ? wave : 0);
        P.g[j][0] = *(const u32x4v*)(kfb + (size_t)t_ * 1024); P.g[j][1] = *(const u32x4v*)(kfb + (size_t)t_ * 1024 + 512); }
}

__device__ __forceinline__ int dsa_item(const Ctx& C, int b, int qt, APre& P, int nxt) {
    const int tid = C.tid, lane = C.lane, wave = C.wave;
    unsigned char* ws = C.ws;
    const u16* QLAT = (const u16*)(ws + WS_QLAT); const u16* QIDX = (const u16*)(ws + WS_QIDX); const u16* CKV = (const u16*)(ws + WS_CKV); const u16* KIDX = (const u16*)(ws + WS_KIDX);
    const float* WIDX = (const float*)(ws + WS_WIDX); const float* SSQ = (const float*)(ws + WS_SSQ); u16* MIX = (u16*)(ws + WS_MIX);
    LAS _Float16* SC = (LAS _Float16*)(C.lds + DSA_SC); LAS u16* SCK = (LAS u16*)(C.lds + DSA_SC);
    LAS unsigned* H1 = (LAS unsigned*)(C.lds + DSA_H1);
    const size_t tb = (size_t)b * SEQ; const int q0 = qt * 8;
    { constexpr int repA = 0;
        const int fr = lane & 15, fq = lane >> 4;
        s16x8 Aop[4][2]; s16x8 Wop[2];
#pragma unroll
        for (int m = 0; m < 4; ++m) { Aop[m][0] = P.Aop[m][0]; Aop[m][1] = P.Aop[m][1]; }
#pragma unroll
        for (int qq = 0; qq < 2; ++qq) { const f32x4v w0 = P.w0[qq], w1 = P.w1[qq];
            const f32x4v zz = {0.f, 0.f, 0.f, 0.f}; const bool own = fr == 4 * fq + qq;
            Wop[qq] = pack8f(own ? w0 : zz, own ? w1 : zz); }
        const int nt16 = (q0 + 8 + 15) >> 4;
        const u16* kfb = KIDX + (tb >> 4) * 1024 + lane * 8;
#define A_GLOADF(b0_, b1_, t_) do { const u16* p_ = kfb + (size_t)(t_) * 1024; b0_ = *(const s16x8*)p_; b1_ = *(const s16x8*)(p_ + 512); } while (0)
#define A_MMA(acc_, B0_, B1_) do { _Pragma("unroll") for (int m = 0; m < 4; ++m) { acc_[m] = mfma16(Aop[m][0], B0_, (f32x4v){0.f, 0.f, 0.f, 0.f}); acc_[m] = mfma16(Aop[m][1], B1_, acc_[m]); } } while (0)
#define A_EPI1(acc_, d0_, d1_) do { if (((MK_REPEAT >> 17) & 1) && repA) { d0_ = acc_[0] + acc_[1] + acc_[2] + acc_[3]; break; } u32x4v pa_, pb_;                      \
            pa_.x = relu_pk_bf16(cvtpk(acc_[0][0], acc_[0][1])); pa_.y = relu_pk_bf16(cvtpk(acc_[0][2], acc_[0][3])); pa_.z = relu_pk_bf16(cvtpk(acc_[1][0], acc_[1][1])); pa_.w = relu_pk_bf16(cvtpk(acc_[1][2], acc_[1][3])); \
            pb_.x = relu_pk_bf16(cvtpk(acc_[2][0], acc_[2][1])); pb_.y = relu_pk_bf16(cvtpk(acc_[2][2], acc_[2][3])); pb_.z = relu_pk_bf16(cvtpk(acc_[3][0], acc_[3][1])); pb_.w = relu_pk_bf16(cvtpk(acc_[3][2], acc_[3][3])); \
            d0_ = mfma16(Wop[0], __builtin_bit_cast(s16x8, pa_), (f32x4v){0.f, 0.f, 0.f, 0.f}); \
            d0_ = mfma16(Wop[1], __builtin_bit_cast(s16x8, pb_), d0_); } while (0)
#define A_EPI2(d0_, d1_, kt_) do { if (((MK_REPEAT >> 16) & 1) && repA) { dummyA += d0_[0] + d0_[1]; break; } const int kpos = (kt_) * 16 + fr;     \
            const unsigned hh_ = __builtin_bit_cast(unsigned, __builtin_amdgcn_cvt_pkrtz(d0_[0], d0_[1])); \
            const unsigned kk_ = hh_ ^ (__builtin_bit_cast(unsigned, __builtin_bit_cast(s16x2v, hh_) >> 15) | 0x80008000u);      \
            SCK[fq * 8192 + kpos] = (u16)kk_; SCK[(4 + fq) * 8192 + kpos] = (u16)(kk_ >> 16); \
            if (repA == 0) { if (kpos <= q0 + fq) atomicAdd((unsigned*)(H1 + fq * 256 + ((kk_ >> 8) & 0xffu)), 1u); if (kpos <= q0 + 4 + fq) atomicAdd((unsigned*)(H1 + (4 + fq) * 256 + (kk_ >> 24)), 1u); } } while (0)
        float dummyA = 0.f;
        if (wave < nt16) {
            s16x8 f0a, f0b, f1a, f1b, f2a, f2b, f3a, f3b; f32x4v accA[4], accB[4], hd;
#define A_TCL(t_) ((t_) < nt16 ? (t_) : wave)
            f0a = __builtin_bit_cast(s16x8, P.g[0][0]); f0b = __builtin_bit_cast(s16x8, P.g[0][1]); f1a = __builtin_bit_cast(s16x8, P.g[1][0]); f1b = __builtin_bit_cast(s16x8, P.g[1][1]);
            A_GLOADF(f2a, f2b, A_TCL(wave + 16)); A_GLOADF(f3a, f3b, A_TCL(wave + 24));
            A_MMA(accA, f0a, f0b);
            A_GLOADF(f0a, f0b, A_TCL(wave + 32));
            int kt = wave;
#define A_STEP(aX, aY, n0, n1) { A_EPI1(aX, hd, hd); A_MMA(aY, n0, n1); A_EPI2(hd, hd, kt); if (kt + 8 >= nt16) break; A_GLOADF(n0, n1, (kt + 40 < nt16 ? kt + 40 : kt)); kt += 8; }
            for (;;) {
                A_STEP(accA, accB, f1a, f1b)
                A_STEP(accB, accA, f2a, f2b)
                A_STEP(accA, accB, f3a, f3b)
                A_STEP(accB, accA, f0a, f0b)
            }
#undef A_STEP
#undef A_TCL
        }
        if (dummyA == 12345.678f) SC[0] = (_Float16)0.f;
#undef A_GLOADF
#undef A_MMA
#undef A_EPI1
#undef A_EPI2
    }
    LAS int* itemw2 = (LAS int*)(C.lds + DSA_ITEM) + 1;
    if (tid == 0) *itemw2 = nxt;
    __syncthreads();
    const int nx = __builtin_amdgcn_readfirstlane(*itemw2);
    const int tq = q0 + wave, nk = tq + 1;
    LAS unsigned* h1 = H1 + wave * 256;
    LAS unsigned* hist = h1;
    LAS u16* idx = (LAS u16*)(C.lds + DSA_IDX) + wave * 256;
    LAS float* rsel = (LAS float*)(C.lds + DSA_KST + wave * 2048);
    const LAS u16* scq = (const LAS u16*)(C.lds + DSA_SC) + wave * 8192;
    s16x8 Bq[4];
    { const int fr = lane & 15, fq = lane >> 4;
#pragma unroll
      for (int ks = 0; ks < 4; ++ks) { Bq[ks] = (s16x8){0, 0, 0, 0, 0, 0, 0, 0}; if (fr < 8) Bq[ks] = *(const s16x8*)(QLAT + (tb + tq) * 1024 + fr * 128 + 32 * ks + 8 * fq); } }
    int cnt;
    const int frC = lane & 15, fqC = lane >> 4;
    const u16* ckb = CKV + tb * 128 + frC * 8;
    u32x4v gbuf[8]; f32x4v q4e = {0.f, 0.f, 0.f, 0.f}; bool early = false;
#define C_ISSUE(ch_) do { int kk_[8]; _Pragma("unroll") for (int i = 0; i < 8; ++i) { const int s_ = (ch_) * 32 + 4 * i + fqC; kk_[i] = (int)idx[s_ < cnt ? s_ : cnt - 1]; }     \
            _Pragma("unroll") for (int i = 0; i < 8; ++i) gbuf[i] = *(const u32x4v*)(ckb + (size_t)kk_[i] * 128); } while (0)
#define C_EARLY() do { LDS_FENCE(); C_ISSUE(0); q4e = *(const f32x4v*)(SSQ + (tb + idx[lane < cnt ? lane : cnt - 1]) * 4); } while (0)
    u32x4v h1save = (u32x4v){0u, 0u, 0u, 0u};
    if ((MK_REPEAT >> 9) & 1) h1save = *(const LAS u32x4v*)(h1 + 4 * lane);
    for (int repB = 0; repB < (((MK_REPEAT >> 9) & 1) ? 2 : 1); ++repB) { LDS_FENCE();
    if (repB) { *(LAS u32x4v*)(h1 + 4 * lane) = h1save; LDS_FENCE(); }
    if (nk <= TOPK) {
        cnt = nk;
#pragma unroll
        for (int i = 0; i < 4; ++i) idx[lane + 64 * i] = (u16)(lane + 64 * i);
    } else {
        cnt = TOPK;
        const int nit = (nk + 511) >> 9;
        int B1, above1; find_bin(h1, lane, TOPK, B1, above1);
        LDS_FENCE();
        const int c1 = __builtin_amdgcn_readfirstlane((int)h1[B1 < 0 ? 0 : B1]);
        LAS u16* cand = (LAS u16*)(C.lds + DSA_KST + wave * 2048);
        if (c1 <= 1024) {
        *(LAS u32x4v*)(hist + 4 * lane) = (u32x4v){0u, 0u, 0u, 0u};
        int pos_gt = 0, pos_c = 0;
#pragma unroll 2
        for (int it = 0; it < nit; ++it) { const int base = it * 512 + lane * 8;
            u32x4v v = (u32x4v){0u, 0u, 0u, 0u};
            if (base < nk) v = *(const LAS u32x4v*)(scq + base);
            unsigned mgt = 0u, mc = 0u;
#pragma unroll
            for (int j = 0; j < 8; ++j) { const int hi = (int)((v[j >> 1] >> ((j & 1) * 16 + 8)) & 0xffu); mgt |= (hi > B1 ? 1u : 0u) << j; mc |= (hi == B1 ? 1u : 0u) << j; }
            if ((it + 1) * 512 > nk) { const int left = nk - base; const unsigned vm = left >= 8 ? 0xffu : (left <= 0 ? 0u : ((1u << left) - 1u)); mgt &= vm; mc &= vm; }
            const int packed = __builtin_popcount(mgt) | (__builtin_popcount(mc) << 16);
            const int incl = wave_incl_scan_dpp(packed), excl = incl - packed, tot = __builtin_amdgcn_readlane(incl, 63);
            int og = pos_gt + (excl & 0xffff), oc = pos_c + (excl >> 16);
            pos_gt += tot & 0xffff; pos_c += tot >> 16;
            while (mgt) { const int j = __builtin_ctz(mgt); mgt &= mgt - 1u; idx[og] = (u16)(base + j); ++og; }
            while (mc) { const int j = __builtin_ctz(mc); mc &= mc - 1u; cand[oc] = (u16)(base + j); ++oc; }
            if (!early && pos_gt >= 64 && it + 1 < nit) { early = true; C_EARLY(); } }
        LDS_FENCE();
        for (int j = lane; j < c1; j += 64) atomicAdd((unsigned*)(hist + (scq[cand[j]] & 255u)), 1u);
        LDS_FENCE();
        int B2, above2; find_bin(hist, lane, TOPK - above1, B2, above2);
        const int need_eq = TOPK - above1 - above2;
        int pg = 0, pe = 0;
        for (int j0 = 0; j0 < c1; j0 += 64) { const int j = j0 + lane; const bool vj = j < c1;
            const int pos = vj ? (int)cand[j] : 0; const int low = (int)(scq[pos] & 255u);
            const bool g = vj && low > B2, q = vj && low == B2;
            const unsigned long long bg = __ballot(g), be = __ballot(q);
            const int og = pg + (int)__builtin_amdgcn_mbcnt_hi((unsigned)(bg >> 32), __builtin_amdgcn_mbcnt_lo((unsigned)bg, 0u));
            const int oe = pe + (int)__builtin_amdgcn_mbcnt_hi((unsigned)(be >> 32), __builtin_amdgcn_mbcnt_lo((unsigned)be, 0u));
            if (g) idx[above1 + og] = (u16)pos;
            if (q && oe < need_eq) idx[above1 + above2 + oe] = (u16)pos;
            pg += __builtin_popcountll(bg); pe += __builtin_popcountll(be); }
        } else {
        *(LAS u32x4v*)(hist + 4 * lane) = (u32x4v){0u, 0u, 0u, 0u};
        LDS_FENCE();
#pragma unroll 2
        for (int it = 0; it < nit; ++it) { const int base = it * 512 + lane * 8;
            if ((it + 1) * 512 <= nk) {
                const u32x4v v = *(const LAS u32x4v*)(scq + base);
#pragma unroll
                for (int j = 0; j < 8; ++j) { const unsigned key = (v[j >> 1] >> ((j & 1) * 16)) & 0xffffu; if ((int)(key >> 8) == B1) atomicAdd((unsigned*)(hist + (key & 255u)), 1u); }
            } else if (base < nk) { const u32x4v v = *(const LAS u32x4v*)(scq + base);
#pragma unroll
                for (int j = 0; j < 8; ++j) { const unsigned key = (v[j >> 1] >> ((j & 1) * 16)) & 0xffffu; if (base + j < nk && (int)(key >> 8) == B1) atomicAdd((unsigned*)(hist + (key & 255u)), 1u); } } }
        LDS_FENCE();
        int B2, above2; find_bin(hist, lane, TOPK - above1, B2, above2);
        const unsigned T = ((unsigned)B1 << 8) | (unsigned)B2;
        const int ngt = above1 + above2, need_eq = TOPK - ngt;
        int pos_gt = 0, pos_eq = 0;
#pragma unroll 2
        for (int it = 0; it < nit; ++it) { const int base = it * 512 + lane * 8;
            u32x4v v = (u32x4v){0u, 0u, 0u, 0u};
            if (base < nk) v = *(const LAS u32x4v*)(scq + base);
            unsigned key[8];
#pragma unroll
            for (int j = 0; j < 8; ++j) key[j] = (v[j >> 1] >> ((j & 1) * 16)) & 0xffffu;
            if ((it + 1) * 512 > nk) {
#pragma unroll
                for (int j = 0; j < 8; ++j) if (base + j >= nk) key[j] = 0u; }
            unsigned mgt = 0u, meq = 0u;
#pragma unroll
            for (int j = 0; j < 8; ++j) { mgt |= (key[j] > T ? 1u : 0u) << j; meq |= (key[j] == T ? 1u : 0u) << j; }
            const int cgt = __builtin_popcount(mgt), ceq = __builtin_popcount(meq);
            const int packed = cgt | (ceq << 16);
            const int incl = wave_incl_scan_dpp(packed), excl = incl - packed, tot = __builtin_amdgcn_readlane(incl, 63);
            int og = pos_gt + (excl & 0xffff), oe = pos_eq + (excl >> 16);
            pos_gt += tot & 0xffff; pos_eq += tot >> 16;
            while (mgt) { const int j = __builtin_ctz(mgt); mgt &= mgt - 1u; idx[og] = (u16)(base + j); ++og; }
            while (meq) { const int j = __builtin_ctz(meq); meq &= meq - 1u; if (oe < need_eq) idx[ngt + oe] = (u16)(base + j); ++oe; }
            if (!early && pos_gt >= 64 && it + 1 < nit) { early = true; C_EARLY(); } }
        }
    }
    }
    *(LAS u32x4v*)(h1 + 4 * lane) = (u32x4v){0u, 0u, 0u, 0u};
    LDS_FENCE();
    for (int repC = 0; repC < (((MK_REPEAT >> 10) & 1) ? 2 : 1); ++repC) {
        const int fr = lane & 15, fq = lane >> 4;
        const size_t tok = tb + tq;
        const int nch = (cnt + 31) >> 5;
        if (!early || repC) C_EARLY();
        { int kr[3]; f32x4v q4[4]; q4[0] = q4e;
#pragma unroll
          for (int i = 1; i < 4; ++i) { const int s = lane + 64 * i; kr[i - 1] = (int)idx[s < cnt ? s : cnt - 1]; }
#pragma unroll
          for (int i = 1; i < 4; ++i) q4[i] = *(const f32x4v*)(SSQ + (tb + kr[i - 1]) * 4);
#pragma unroll
          for (int i = 0; i < 4; ++i) { const int s = lane + 64 * i; rsel[s] = s < cnt ? __builtin_amdgcn_rsqf((q4[i][0] + q4[i][1] + q4[i][2] + q4[i][3]) * (1.f / 128.f) + EPS) : 0.f; } }
        f32x4v O[8];
#pragma unroll
        for (int ct = 0; ct < 8; ++ct) O[ct] = (f32x4v){0.f, 0.f, 0.f, 0.f};
        float mrun = -__builtin_inff(), lsum = 0.f;
        const int rho0 = 8 * (fr >> 2) + (fr & 3);
        const int tq_ = (lane & 15) >> 2, tp = lane & 3;
        LAS unsigned char* const CB = C.lds + DSA_SC + wave * 16384;
        auto c_chunk = [&](const int ch, LAS unsigned char* const CH) __attribute__((always_inline)) {
            f32x4v sacc[2];
#pragma unroll
            for (int T = 0; T < 2; ++T) { sacc[T] = (f32x4v){0.f, 0.f, 0.f, 0.f};
#pragma unroll
                for (int ks = 0; ks < 4; ++ks) { const s16x8 a = *(const LAS s16x8*)(CH + off_b(rho0 + 4 * T, 4 * ks + fq)); sacc[T] = mfma16(a, Bq[ks], sacc[T]); } }
            const f32x4v r0 = *(const LAS f32x4v*)(rsel + ch * 32 + 8 * fq), r1 = *(const LAS f32x4v*)(rsel + ch * 32 + 8 * fq + 4);
            float sv[8];
#pragma unroll
            for (int i = 0; i < 4; ++i) { sv[i] = sacc[0][i] * r0[i]; sv[4 + i] = sacc[1][i] * r1[i]; }
            if (ch * 32 + 32 > cnt) {
#pragma unroll
                for (int i = 0; i < 4; ++i) { const int s0 = ch * 32 + 8 * fq + i; if (s0 >= cnt) sv[i] = -__builtin_inff(); if (s0 + 4 >= cnt) sv[4 + i] = -__builtin_inff(); } }
            float cmax = fmaxf(fmaxf(fmaxf(sv[0], sv[1]), fmaxf(sv[2], sv[3])), fmaxf(fmaxf(sv[4], sv[5]), fmaxf(sv[6], sv[7])));
            cmax = fmaxf(cmax, __shfl_xor(cmax, 16)); cmax = fmaxf(cmax, __shfl_xor(cmax, 32));
            const bool need = cmax > mrun + 8.f;
            if (__any(need)) {
                const float mnew = need ? cmax : mrun;
                const float alpha = fast_exp(mrun - mnew);
                mrun = mnew; lsum *= alpha;
#pragma unroll
                for (int ct = 0; ct < 8; ++ct) O[ct] = O[ct] * alpha;
            }
            float p[8]; float ps = 0.f;
#pragma unroll
            for (int i = 0; i < 8; ++i) { p[i] = fast_exp(sv[i] - mrun); ps += p[i]; }
            lsum += ps;
            f32x4v pa, pb;
#pragma unroll
            for (int i = 0; i < 4; ++i) { pa[i] = p[i] * r0[i]; pb[i] = p[4 + i] * r1[i]; }
            const s16x8 pop = pack8f(pa, pb);
#pragma unroll
            for (int ct = 0; ct < 8; ++ct) {
                const s16x4 t0 = tr4((const LAS u16*)(CH + off_b(8 * fq + tq_, 2 * ct + (tp >> 1)) + 8 * (tp & 1)));
                const s16x4 t1 = tr4((const LAS u16*)(CH + off_b(8 * fq + 4 + tq_, 2 * ct + (tp >> 1)) + 8 * (tp & 1)));
                O[ct] = mfma16(cat4(t0, t1), pop, O[ct]);
            }
        };
#pragma unroll 1
        for (int ch = 0; ch < nch; ch += 2) {
#pragma unroll
            for (int i = 0; i < 8; ++i) *(LAS u32x4v*)(CB + off_b(4 * i + fq, fr)) = gbuf[i];
            if (ch + 1 < nch) C_ISSUE(ch + 1);
            LDS_FENCE();
            c_chunk(ch, CB);
            if (ch + 1 < nch) {
#pragma unroll
                for (int i = 0; i < 8; ++i) *(LAS u32x4v*)(CB + 8192 + off_b(4 * i + fq, fr)) = gbuf[i];
                if (ch + 2 < nch) C_ISSUE(ch + 2);
                LDS_FENCE();
                c_chunk(ch + 1, CB + 8192);
            }
        }
#undef C_ISSUE
#undef C_EARLY
        lsum += __shfl_xor(lsum, 16); lsum += __shfl_xor(lsum, 32);
        const float inv = 1.f / lsum;
        float am = 0.f;
#pragma unroll
        for (int ct = 0; ct < 8; ++ct) { O[ct] = O[ct] * inv; am = fmaxf(am, fmaxf(fmaxf(fabsf(O[ct][0]), fabsf(O[ct][1])), fmaxf(fabsf(O[ct][2]), fabsf(O[ct][3])))); }
        if (fr >= 8) am = 0.f;
        am = wave_max_f(am);
        const float qs = am > 0.f ? 127.f / am : 0.f;
        if (fr < 8) {
            unsigned char* mp = (unsigned char*)MIX + tok * MIXB + fr * 128 + 4 * fq;
#pragma unroll
            for (int ct = 0; ct < 8; ++ct) *(unsigned*)(mp + 16 * ct) = pack_i8(O[ct][0] * qs, O[ct][1] * qs, O[ct][2] * qs, O[ct][3] * qs);
        }
        if (lane == 0) ((float*)(ws + WS_MIXS))[tok] = am * (1.f / 127.f);
    }
    dsa_pre(C, b, (SEQ / 8 - 1) - (nx < SEQ / 8 ? nx : SEQ / 8 - 1), P);
    return nx;
}

__device__ __forceinline__ void p2_mixers(const Ctx& C, int cw = 0) {
    if (C.bid < 64) { hgrn_seq(C, C.bid); if ((MK_REPEAT >> 7) & 1) hgrn_seq(C, C.bid); }
    unsigned* qctr = (unsigned*)(C.ws + WS_CTL);
    for (int i = C.tid; i < 2048; i += NTHREADS) ((LAS unsigned*)(C.lds + DSA_H1))[i] = 0u;
    __syncthreads();
    LAS int* itemw = (LAS int*)(C.lds + DSA_ITEM);
    APre P;
    const int xcc = (int)(__builtin_amdgcn_s_getreg((3 << 11) | 20) & 0x7u);
    for (int k = 0; k < NB; ++k) { const int bq = (xcc + k) & 7;
        if (C.tid == 0) *itemw = (int)atomicAdd(qctr + 8 * cw + bq, 1u);
        __syncthreads();
        int item = *itemw;
        __syncthreads();
        if (item < SEQ / 8) dsa_pre(C, bq, (SEQ / 8 - 1) - item, P);
        while (item < SEQ / 8) {
            int nxt = 0;
            if (C.tid == 0) nxt = (int)atomicAdd(qctr + 8 * cw + bq, 1u);
            item = dsa_item(C, bq, (SEQ / 8 - 1) - item, P, nxt);
            __syncthreads();
        }
    }
}


__device__ __forceinline__ float wave_sum(float v) {
#pragma unroll
    for (int d = 1; d < 64; d <<= 1) v += __shfl_xor(v, d);
    return v;
}
__device__ __forceinline__ void p4_ln1(const Ctx& C) {
    const u16* Y1 = (const u16*)(C.ws + WS_Y1); u16* HB = (u16*)(C.ws + WS_HB); unsigned char* H8 = C.ws + WS_H8; float* HS = (float*)(C.ws + WS_HS);
    const float* g = C.in[I_LN1G]; const float* bb = C.in[I_LN1B];
    const int lane = C.lane, gw = C.bid * 8 + C.wave, nw = C.G * 8;
    f32x4v gv[4], bv[4];
#pragma unroll
    for (int c = 0; c < 4; ++c) { gv[c] = *(const f32x4v*)(g + lane * 16 + 4 * c); bv[c] = *(const f32x4v*)(bb + lane * 16 + 4 * c); }
    u32x4v ya[4], yb[4];
#define LN1_LOAD(k_, r_) do { const int rr_ = (r_) < MTOK ? (r_) : gw; ya[k_] = *(const u32x4v*)(Y1 + (size_t)rr_ * 1024 + lane * 16); yb[k_] = *(const u32x4v*)(Y1 + (size_t)rr_ * 1024 + lane * 16 + 8); } while (0)
    LN1_LOAD(0, gw); LN1_LOAD(1, gw + nw); LN1_LOAD(2, gw + 2 * nw); LN1_LOAD(3, gw + 3 * nw);
    for (int r0 = gw; r0 < MTOK; r0 += 4 * nw) {
#pragma unroll
    for (int kq = 0; kq < 4; ++kq) { const int r = r0 + kq * nw; const bool rv = r < MTOK;
        const u32x4v y0 = ya[kq], y1 = yb[kq];
        LN1_LOAD(kq, r + 4 * nw);
        float v[16]; float s = 0.f;
#pragma unroll
        for (int j = 0; j < 4; ++j) { v[2 * j] = bf_lo(y0[j]); v[2 * j + 1] = bf_hi(y0[j]); v[8 + 2 * j] = bf_lo(y1[j]); v[8 + 2 * j + 1] = bf_hi(y1[j]); }
#pragma unroll
        for (int j = 0; j < 16; ++j) s += v[j];
        const float mu = wave_sum_f(s) * (1.f / 1024.f);
        float q = 0.f;
#pragma unroll
        for (int j = 0; j < 16; ++j) { v[j] -= mu; q += v[j] * v[j]; }
        const float rstd = __builtin_amdgcn_rsqf(wave_sum_f(q) * (1.f / 1024.f) + EPS);
        float am = 0.f;
#pragma unroll
        for (int j = 0; j < 16; ++j) { v[j] = v[j] * rstd * gv[j >> 2][j & 3] + bv[j >> 2][j & 3]; am = fmaxf(am, fabsf(v[j])); }
        am = wave_max_f(am);
        const float qs = am > 0.f ? 127.f / am : 0.f;
        u32x4v w8;
#pragma unroll
        for (int j = 0; j < 4; ++j) w8[j] = pack_i8(v[4 * j] * qs, v[4 * j + 1] * qs, v[4 * j + 2] * qs, v[4 * j + 3] * qs);
        if (rv) { *(u32x4v*)(H8 + (size_t)r * 1024 + lane * 16) = w8; if (lane == 0) HS[r] = am * (1.f / 127.f); }
    }
    }
#undef LN1_LOAD
}

constexpr int SSROW = 136;
constexpr int PE_SS = 0, PE_TV = 0, PE_TI = 32768, PE_EU = 53248, PE_EID = 131072, PE_EG = 147456;

__device__ __forceinline__ void ins16(float (&tv)[16], int (&ti)[16], float v, int id) {
#pragma unroll
    for (int j = 15; j >= 0; --j) {
        const bool c = v > tv[j];
        const bool cp = (j > 0) ? (v > tv[j > 0 ? j - 1 : 0]) : false;
        const float nv = cp ? tv[j > 0 ? j - 1 : 0] : v; const int ni = cp ? ti[j > 0 ? j - 1 : 0] : id;
        tv[j] = c ? nv : tv[j]; ti[j] = c ? ni : ti[j];
    }
}

__device__ __forceinline__ float gelu_tanh(float x) {
    const float u = 0.7978845608028654f * (x + 0.044715f * x * x * x);
    const float e = fast_exp(2.f * u);
    const float th = 1.f - 2.f * __builtin_amdgcn_rcpf(e + 1.f);
    return 0.5f * x * (1.f + th);
}


#ifndef MK_PASSBAR
#define MK_PASSBAR 0
#endif
constexpr int PE_PD = 0, PE_STAT = 131072, PE_WSC = 133120;
constexpr size_t WS_GSID = WS_MIX, WS_GSG = WS_MIX + 32 * MiB, WS_GSU = WS_MIX + 64 * MiB;
constexpr int NSEG = 8, SEGB = 128;

__device__ __forceinline__ void p6_peer(const Ctx& C) {
    unsigned char* ws = C.ws;
    const u16* PQ = (const u16*)(ws + WS_PQ); const u16* HB = (const u16*)(ws + WS_HB); const u16* SKB = (const u16*)(ws + WS_SKB); const unsigned char* H8 = ws + WS_H8; const float* HS = (const float*)(ws + WS_HS);
    const unsigned char* U8 = ws + WS_UB; const unsigned char* V8 = ws + WS_VB; const float* USC = (const float*)(ws + WS_USC); const float* VSC = (const float*)(ws + WS_VSC);
    u16* YB = (u16*)(ws + WS_YB);
    u16* G_SID = (u16*)(ws + WS_GSID);     float* G_SG = (float*)(ws + WS_GSG); float* G_SU = (float*)(ws + WS_GSU);
    const float* g2 = C.in[I_LN2G]; const float* b2 = C.in[I_LN2B];
    const int tid = C.tid, lane = C.lane, wave = C.wave, fr = lane & 15, fq = lane >> 4;
    LAS u16* SSK = (LAS u16*)(C.lds + PE_SS);
    LAS float* TV = (LAS float*)(C.lds + PE_TV); LAS u16* TI = (LAS u16*)(C.lds + PE_TI);
    LAS int* EID = (LAS int*)(C.lds + PE_EID); LAS float* EG = (LAS float*)(C.lds + PE_EG); LAS float* EU = (LAS float*)(C.lds + PE_EU);
    cg::grid_group grid = cg::this_grid();
    const int ntile = MTOK / 32, tiles_per_wg = (ntile + C.G - 1) / C.G, nsr = (tiles_per_wg + 7) / 8;
    for (int sr = 0; sr < nsr; ++sr) {
    for (int jj = 0; jj < 8; ++jj) { const int tile = C.bid + (8 * sr + jj) * C.G; if (tile >= ntile) break;
        const size_t t0 = (size_t)tile * 32;
        int tid_r = C.tid; asm volatile("" : "+v"(tid_r));
        const int lane_r = tid_r & 63, fr_r = lane_r & 15, fq_r = lane_r >> 4;
#define tid tid_r
#define lane lane_r
#define fr fr_r
#define fq fq_r
#define SK_KEYS(x_, y_) ({ const unsigned hh_ = __builtin_bit_cast(unsigned, __builtin_amdgcn_cvt_pkrtz(x_, y_)); hh_ ^ (__builtin_bit_cast(unsigned, __builtin_bit_cast(s16x2v, hh_) >> 15) | 0x80008000u); })
#define SK_LOAD(dst, hp_, k0_) do { _Pragma("unroll") for (int kk = 0; kk < 4; ++kk) _Pragma("unroll") for (int ks = 0; ks < 4; ++ks) \
            dst[kk][ks] = *(const s16x8*)(SKB + ((size_t)((((hp_) * 8 + (k0_) + kk) * 4 + ks) * 64 + fr + 16 * fq)) * 8); } while (0)
#define PQ_LOAD(dst, hp_) do { _Pragma("unroll") for (int tt = 0; tt < 2; ++tt) _Pragma("unroll") for (int ks = 0; ks < 4; ++ks) dst[tt][ks] = *(const s16x8*)(PQ + ((((t0 >> 4) + tt) * 16 + (hp_)) * 4 + ks) * 512 + (fr + 16 * fq) * 8); } while (0)
#define SK_COMP(src, Bq_, hp_, k0_) do { _Pragma("unroll") for (int kk = 0; kk < 4; ++kk) { const int kt = (k0_) + kk; f32x4v a0 = {0.f, 0.f, 0.f, 0.f}, a1 = a0; \
            _Pragma("unroll") for (int ks = 0; ks < 4; ++ks) { a0 = mfma16(src[kk][ks], Bq_[0][ks], a0); a1 = mfma16(src[kk][ks], Bq_[1][ks], a1); } \
              \
            u32x2v kwa_, kwb_; kwa_.x = SK_KEYS(a0[0], a0[1]); kwa_.y = SK_KEYS(a0[2], a0[3]); kwb_.x = SK_KEYS(a1[0], a1[1]); kwb_.y = SK_KEYS(a1[2], a1[3]); \
            *(LAS u32x2v*)(SSK + ((hp_) * 32 + fr) * SSROW + 16 * kt + 4 * fq) = kwa_; *(LAS u32x2v*)(SSK + ((hp_) * 32 + 16 + fr) * SSROW + 16 * kt + 4 * fq) = kwb_; } } while (0)
#pragma unroll 1
        for (int rep1 = 0; rep1 < (((MK_REPEAT >> 11) & 1) ? 2 : 1); ++rep1) {
            const int hp0 = 2 * wave, hp1 = hp0 + 1;
            s16x8 akA[4][4], akB[4][4], Bt0[2][4], Bt1[2][4];
            PQ_LOAD(Bt0, hp0); SK_LOAD(akA, hp0, 0); SK_LOAD(akB, hp0, 4); PQ_LOAD(Bt1, hp1);
            SK_COMP(akA, Bt0, hp0, 0); SK_LOAD(akA, hp1, 0);
            SK_COMP(akB, Bt0, hp0, 4); SK_LOAD(akB, hp1, 4);
            SK_COMP(akA, Bt1, hp1, 0);
            SK_COMP(akB, Bt1, hp1, 4);
        }
#undef SK_LOAD
#undef PQ_LOAD
#undef SK_COMP
#undef SK_KEYS
        __syncthreads();
        for (int repS = 0; repS < (((MK_REPEAT >> 12) & 1) ? 2 : 1); ++repS) {
            if (repS) __syncthreads();
            const int tok = tid & 31, hp = tid >> 5;
            float tk[16];
#pragma unroll
            for (int j = 0; j < 16; ++j) tk[j] = __builtin_bit_cast(float, 0x40000000u);
            const LAS u16* rowp = SSK + (hp * 32 + tok) * SSROW;
#pragma unroll 2
            for (int kb = 0; kb < 16; ++kb) {
                const u32x4v w = *(const LAS u32x4v*)(rowp + 8 * kb);
#pragma unroll
                for (int j = 0; j < 8; ++j) { const int k = 8 * kb + j; const unsigned k16 = (j & 1) ? (w[j >> 1] >> 16) : (w[j >> 1] & 0xffffu);
                    const float x = __builtin_bit_cast(float, (k16 << 7) | (0x40000000u | (unsigned)(127 - k)));
                    float nk[16];
                    nk[0] = __builtin_amdgcn_fmed3f(__builtin_inff(), x, tk[0]);
#pragma unroll
                    for (int jj = 1; jj < 16; ++jj) nk[jj] = __builtin_amdgcn_fmed3f(tk[jj - 1], x, tk[jj]);
#pragma unroll
                    for (int jj = 0; jj < 16; ++jj) tk[jj] = nk[jj]; }
            }
            if (repS + 1 < (((MK_REPEAT >> 12) & 1) ? 2 : 1)) continue;
            __syncthreads();
#pragma unroll
            for (int j = 0; j < 16; ++j) { const unsigned bits = __builtin_bit_cast(unsigned, tk[j]); const unsigned k16 = (bits >> 7) & 0xffffu;
                const unsigned hb = (k16 & 0x8000u) ? (k16 & 0x7fffu) : (~k16 & 0xffffu);
                TV[tid * 16 + j] = (float)__builtin_bit_cast(_Float16, (unsigned short)hb); TI[tid * 16 + j] = (u16)(127u - (bits & 0x7fu)); }
        }
        __syncthreads();
        for (int repK = 0; repK < (((MK_REPEAT >> 13) & 1) ? 2 : 1); ++repK) if (tid < 256) {
            int tid_o = tid; asm volatile("" : "+v"(tid_o));
            const int tok = tid_o & 31, h = tid_o >> 5;
            const int ra = ((2 * h) * 32 + tok) * 16, rb = ((2 * h + 1) * 32 + tok) * 16;
            float va[16], vb[16];
#pragma unroll
            for (int j = 0; j < 16; ++j) { va[j] = TV[ra + j]; vb[j] = TV[rb + j]; }
            float tk[16];
#pragma unroll
            for (int j = 0; j < 16; ++j) tk[j] = -__builtin_inff();
#pragma unroll
            for (int a = 0; a < 16; ++a)
#pragma unroll
                for (int b = 0; b < 16; ++b) if ((a + 1) * (b + 1) <= 16) {
                    const float x = __builtin_bit_cast(float, (__builtin_bit_cast(unsigned, va[a] + vb[b]) & 0xffffff00u) | (unsigned)(a * 16 + b));
                    float nk[16];
                    nk[0] = __builtin_amdgcn_fmed3f(__builtin_inff(), x, tk[0]);
#pragma unroll
                    for (int j = 1; j < 16; ++j) nk[j] = __builtin_amdgcn_fmed3f(tk[j - 1], x, tk[j]);
#pragma unroll
                    for (int j = 0; j < 16; ++j) tk[j] = nk[j];
                }
            float tv[16]; int ti[16];
#pragma unroll
            for (int j = 0; j < 16; ++j) { const unsigned bits = __builtin_bit_cast(unsigned, tk[j]); tv[j] = __builtin_bit_cast(float, bits & 0xffffff00u);
                ti[j] = (int)TI[ra + ((bits >> 4) & 15u)] * 128 + (int)TI[rb + (bits & 15u)]; }
            float mx = tv[0], sum = 0.f, e[16];
#pragma unroll
            for (int j = 0; j < 16; ++j) { e[j] = fast_exp(tv[j] - mx); sum += e[j]; }
            const float inv = __builtin_amdgcn_rcpf(sum);
#pragma unroll
            for (int j = 0; j < 16; ++j) { const f32x2v uv = *(const f32x2v*)(USC + 2 * ti[j]);
                EID[tok * 128 + h * 16 + j] = ti[j]; EG[tok * 128 + h * 16 + j] = e[j] * inv * uv.y; EU[tok * 128 + h * 16 + j] = uv.x; }
        }
        __syncthreads();
        { const u32x4v i0 = *(const LAS u32x4v*)(EID + tid * 8), i1 = *(const LAS u32x4v*)(EID + tid * 8 + 4);
          const f32x4v a0 = *(const LAS f32x4v*)(EG + tid * 8), a1 = *(const LAS f32x4v*)(EG + tid * 8 + 4), u0 = *(const LAS f32x4v*)(EU + tid * 8), u1 = *(const LAS f32x4v*)(EU + tid * 8 + 4);
          *(u32x4v*)(G_SID + t0 * 128 + tid * 8) = (u32x4v){i0[0] | (i0[1] << 16), i0[2] | (i0[3] << 16), i1[0] | (i1[1] << 16), i1[2] | (i1[3] << 16)};
          *(f32x4v*)(G_SG + t0 * 128 + tid * 8) = a0; *(f32x4v*)(G_SG + t0 * 128 + tid * 8 + 4) = a1;
          *(f32x4v*)(G_SU + t0 * 128 + tid * 8) = u0; *(f32x4v*)(G_SU + t0 * 128 + tid * 8 + 4) = u1; }
        __syncthreads();
#undef tid
#undef lane
#undef fr
#undef fq
    }
    __syncthreads();
    int lane_o = C.lane, wave_o = C.wave; asm volatile("" : "+v"(lane_o), "+s"(wave_o));
#define lane lane_o
#define wave wave_o
    LAS float* PD = (LAS float*)(C.lds + PE_PD) + wave * 4096;
    LAS float* STAT = (LAS float*)(C.lds + PE_STAT) + wave * 64;
    LAS float* WSC = (LAS float*)(C.lds + PE_WSC) + wave * 32;
    {
#pragma unroll
        for (int i = 0; i < 16; ++i) *(LAS f32x4v*)(PD + (i * 64 + lane) * 4) = (f32x4v){0.f, 0.f, 0.f, 0.f};
        STAT[lane] = 0.f;
        LDS_FENCE();
    }
#define SID_T const unsigned*
#define ID_LOAD(kb_) (*(SID_T)(sid + 16 * (kb_) + 2 * pc))
#define ROW_ISSUE(buf, idv, hb_, tbl) do { _Pragma("unroll") for (int jj_ = 0; jj_ < 8; ++jj_) { const int j_ = 8 * ((hb_) & 1) + jj_; \
            const unsigned id_ = (unsigned)__shfl((int)((j_ & 1) ? (idv >> 16) : (idv & 0xffffu)), 8 * g + (j_ >> 1)); \
            buf[jj_] = *(const u32x4v*)((tbl) + ((id_ << 7) + (unsigned)(pc * 16))); } } while (0)
#define STREAM(tbl, CONSUME) do { \
        unsigned idA_ = idP0, idB_ = idP1; u32x4v bA_[8], bB_[8];                       \
        idP0 = *(SID_T)(sidn + 2 * pc); idP1 = *(SID_T)(sidn + 16 + 2 * pc); \
        ROW_ISSUE(bA_, idA_, 0, tbl); ROW_ISSUE(bB_, idA_, 1, tbl); \
        _Pragma("unroll 1") for (int hb = 0; hb < 16; hb += 2) { \
            __builtin_amdgcn_sched_barrier(0); CONSUME(bA_, hb); __builtin_amdgcn_sched_barrier(0);        \
            if (hb + 2 < 16) ROW_ISSUE(bA_, idB_, hb + 2, tbl); \
            __builtin_amdgcn_sched_barrier(0); CONSUME(bB_, hb + 1); __builtin_amdgcn_sched_barrier(0); \
            if (hb + 2 < 16) { ROW_ISSUE(bB_, idB_, hb + 3, tbl); idA_ = idB_; if (hb + 4 < 16) idB_ = ID_LOAD((hb >> 1) + 2); } } } while (0)
#define R_TOKEN(r_) ({ const int q_ = 8 * (r_) + g; const int tl_ = C.bid + (8 * sr + (q_ >> 2)) * C.G; (tl_ < ntile ? (size_t)tl_ * 32 + 4 * wave + (q_ & 3) : (size_t)0); })
    asm volatile("" : "+v"(lane_o));
    { const int g = lane >> 3, pc = lane & 7;
    unsigned idP0, idP1; { const u16* s0_ = G_SID + R_TOKEN(0) * 128; idP0 = *(const unsigned*)(s0_ + 2 * pc); idP1 = *(const unsigned*)(s0_ + 16 + 2 * pc); }
    for (int repU = 0; repU < (((MK_REPEAT >> 20) & 5) ? 2 : 1); ++repU)
#pragma unroll 1
    for (int seg = 0; seg < NSEG; ++seg) {
#if MK_PASSBAR == 1
        grid.sync();
#endif
        const unsigned char* tbl = U8 + (size_t)seg * (16384u * SEGB);
#pragma unroll 1
        for (int r = 0; r < 4; ++r) {
            const int q = 8 * r + g; const int tile = C.bid + (8 * sr + (q >> 2)) * C.G; const bool valid = tile < ntile;
            const size_t token = valid ? (size_t)tile * 32 + 4 * wave + (q & 3) : 0;
            const u16* sid = G_SID + token * 128; const u16* sidn = G_SID + R_TOKEN((r + 1) & 3) * 128;
            const u32x4v x8 = *(const u32x4v*)(H8 + token * 1024 + seg * SEGB + pc * 16);
            LAS int* pdq = (LAS int*)PD + q * 128;
#define U_CONSUME(buf, hb_) do { int pv_[8]; \
                _Pragma("unroll") for (int i = 0; i < 8; ++i) { int a_ = __builtin_amdgcn_sdot4((int)buf[i][0], (int)x8[0], 0, false); a_ = __builtin_amdgcn_sdot4((int)buf[i][1], (int)x8[1], a_, false);     \
                    a_ = __builtin_amdgcn_sdot4((int)buf[i][2], (int)x8[2], a_, false); pv_[i] = __builtin_amdgcn_sdot4((int)buf[i][3], (int)x8[3], a_, false); } \
                int r_[4], q_[2];                                               \
                _Pragma("unroll") for (int i = 0; i < 4; ++i) { const int snd_ = (pc & 4) ? pv_[i] : pv_[i + 4], kp_ = (pc & 4) ? pv_[i + 4] : pv_[i]; r_[i] = kp_ + dppi_xor4(snd_); } \
                _Pragma("unroll") for (int i = 0; i < 2; ++i) { const int snd_ = (pc & 2) ? r_[i] : r_[i + 2], kp_ = (pc & 2) ? r_[i + 2] : r_[i]; q_[i] = kp_ + dppi_xor2(snd_); } \
                const int z_ = ((pc & 1) ? q_[1] : q_[0]) + dppi_xor1((pc & 1) ? q_[0] : q_[1]); \
                if (valid && repU == 0) pdq[8 * (hb_) + pc] += z_; } while (0)
#ifndef MK_NOU
            STREAM(tbl, U_CONSUME);
#endif
#undef U_CONSUME
        }
    }
    }
    LDS_FENCE();
    asm volatile("" : "+v"(lane_o));
#define W_TOKEN(q_) ({ const int tl_ = C.bid + (8 * sr + ((q_) >> 2)) * C.G; (size_t)(tl_ < ntile ? tl_ : C.bid) * 32 + 4 * wave + ((q_) & 3); })
    float nsg0, nsg1, nsu0, nsu1, nhs; u16 nid0, nid1;
    { const size_t tk_ = W_TOKEN(0); nsg0 = G_SG[tk_ * 128 + lane]; nsg1 = G_SG[tk_ * 128 + 64 + lane]; nsu0 = G_SU[tk_ * 128 + lane]; nsu1 = G_SU[tk_ * 128 + 64 + lane]; nhs = HS[tk_]; nid0 = G_SID[tk_ * 128 + lane]; nid1 = G_SID[tk_ * 128 + 64 + lane]; }
#pragma unroll 1
    for (int q = 0; q < 32; ++q) { const int tile = C.bid + (8 * sr + (q >> 2)) * C.G;
        const float sg0 = nsg0, sg1 = nsg1, su0 = nsu0, su1 = nsu1, hs = nhs; const u16 id0 = nid0, id1 = nid1;
        { const size_t tk_ = W_TOKEN(q + 1 < 32 ? q + 1 : q); nsg0 = G_SG[tk_ * 128 + lane]; nsg1 = G_SG[tk_ * 128 + 64 + lane]; nsu0 = G_SU[tk_ * 128 + lane]; nsu1 = G_SU[tk_ * 128 + 64 + lane]; nhs = HS[tk_]; nid0 = G_SID[tk_ * 128 + lane]; nid1 = G_SID[tk_ * 128 + 64 + lane]; }
        const int d0_ = ((LAS int*)PD)[q * 128 + lane], d1_ = ((LAS int*)PD)[q * 128 + 64 + lane];
        asm volatile("" ::: "memory");
        { LAS u16* il_ = (LAS u16*)(PD + q * 128) + 64; il_[lane] = id0; il_[64 + lane] = id1; }
        asm volatile("" ::: "memory");
        if (tile >= ntile) continue;
        const float w0 = sg0 * gelu_tanh((float)d0_ * (su0 * hs));
        const float w1 = sg1 * gelu_tanh((float)d1_ * (su1 * hs));
        float am = fmaxf(fabsf(w0), fabsf(w1));
        am = wave_max_f(am);
        const float qs = am > 0.f ? 127.f / am : 0.f;
        LAS signed char* w8 = (LAS signed char*)(PD + q * 128);
        w8[lane] = (signed char)(int)__builtin_rintf(w0 * qs); w8[64 + lane] = (signed char)(int)__builtin_rintf(w1 * qs);
        if (lane == 0) WSC[q] = am * (1.f / 127.f); }
#undef W_TOKEN
    LDS_FENCE();
    asm volatile("" : "+v"(lane_o));
    { const int g = lane >> 3, pc = lane & 7;
    const unsigned shb = 8u * (unsigned)(lane & 3), selb = 0x0c0c0c0cu & ~(0xffu << shb);
    #undef SID_T
#define SID_T const LAS unsigned*
    unsigned idP0, idP1; { const LAS u16* s0_ = (const LAS u16*)(PD + g * 128) + 64; idP0 = *(SID_T)(s0_ + 2 * pc); idP1 = *(SID_T)(s0_ + 16 + 2 * pc); }
#pragma unroll 1
    for (int seg = 0; seg < NSEG; ++seg) {
#if MK_PASSBAR == 1
        grid.sync();
#endif
        const unsigned char* tbl = V8 + (size_t)seg * (16384u * SEGB);
#pragma unroll 1
        for (int r = 0; r < 4; ++r) {
            const int q = 8 * r + g; const int tile = C.bid + (8 * sr + (q >> 2)) * C.G; const bool valid = tile < ntile;
            const size_t token = valid ? (size_t)tile * 32 + 4 * wave + (q & 3) : 0;
            const LAS u16* sid = (const LAS u16*)(PD + q * 128) + 64; const LAS u16* sidn = (const LAS u16*)(PD + (8 * ((r + 1) & 3) + g) * 128) + 64;
            const LAS unsigned char* wq_ = (const LAS unsigned char*)(PD + q * 128);
            const u32x4v h8r = *(const u32x4v*)(H8 + token * 1024 + seg * SEGB + pc * 16); const float hsa = ALPHA * HS[token];
            i32x4v accR[4];
#pragma unroll
            for (int j = 0; j < 4; ++j) accR[j] = (i32x4v){0, 0, 0, 0};
#define V_CONSUME(buf, hb_) do { const u32x2v w8_ = *(const LAS u32x2v*)(wq_ + 8 * (hb_)); \
                _Pragma("unroll") for (int i = 0; i < 8; ++i) { const int bop_ = (int)__builtin_amdgcn_perm(w8_.y, w8_.x, selb | ((unsigned)i << shb)); \
                    _Pragma("unroll") for (int r_ = 0; r_ < 4; ++r_) accR[r_] = __builtin_amdgcn_mfma_i32_4x4x4i8((int)buf[i][r_], bop_, accR[r_], 0, 0, 0); } } while (0)
#ifndef MK_NOV
            STREAM(tbl, V_CONSUME);
#endif
#undef V_CONSUME
#pragma unroll
            for (int r_ = 0; r_ < 4; ++r_) {
#pragma unroll
                for (int a = 0; a < 4; a += 2) { const int snd = (pc & 1) ? accR[r_][a] : accR[r_][a + 1]; const int rcv = dppi_xor1(snd); if (pc & 1) accR[r_][a] = rcv; else accR[r_][a + 1] = rcv; }
#pragma unroll
                for (int a = 0; a < 2; ++a) { const int snd = (pc & 2) ? accR[r_][a] : accR[r_][a + 2]; const int rcv = dppi_xor2(snd); if (pc & 2) accR[r_][a] = rcv; else accR[r_][a + 2] = rcv; }
            }
            const float wsq = WSC[q];
            float y[16]; float s1 = 0.f, s2 = 0.f;
#pragma unroll
            for (int j = 0; j < 16; ++j) y[j] = hsa * (float)((int)(h8r[j >> 2] << (24 - 8 * (j & 3))) >> 24) + (float)accR[j >> 2][j & 3] * wsq;
#pragma unroll
            for (int j = 0; j < 16; ++j) { s1 += y[j]; s2 += y[j] * y[j]; }
            s1 += dpp_xor1(s1); s2 += dpp_xor1(s2); s1 += dpp_xor2(s1); s2 += dpp_xor2(s2); s1 += dpp_xor4(s1); s2 += dpp_xor4(s2);
            if (valid) { u16* op = YB + token * 1024 + seg * SEGB + pc * 16;
                u32x4v w0, w1;
#pragma unroll
                for (int c = 0; c < 4; ++c) { w0[c] = cvtpk(y[2 * c], y[2 * c + 1]); w1[c] = cvtpk(y[8 + 2 * c], y[8 + 2 * c + 1]); }
                *(u32x4v*)op = w0; *(u32x4v*)(op + 8) = w1;
                if (pc == 0) { STAT[2 * q] += s1; STAT[2 * q + 1] += s2; } }
        }
    }
    }
    LDS_FENCE();
    asm volatile("" : "+v"(lane_o));
    __builtin_amdgcn_fence(__ATOMIC_RELEASE, "workgroup");
    asm volatile("s_waitcnt vmcnt(0)" ::: "memory");
#define L_TOKEN(q_) ({ const int tl_ = C.bid + (8 * sr + ((q_) >> 2)) * C.G; (size_t)(tl_ < ntile ? tl_ : C.bid) * 32 + 4 * wave + ((q_) & 3); })
    f32x4v ga4[4], ba4[4];
#pragma unroll
    for (int c = 0; c < 4; ++c) { ga4[c] = *(const f32x4v*)(g2 + lane * 16 + 4 * c); ba4[c] = *(const f32x4v*)(b2 + lane * 16 + 4 * c); }
    u32x4v ya[4], yb[4];
#define L_LOAD(k_, q_) do { const size_t tk_ = L_TOKEN((q_) < 32 ? (q_) : 31); ya[k_] = *(const u32x4v*)(YB + tk_ * 1024 + lane * 16); yb[k_] = *(const u32x4v*)(YB + tk_ * 1024 + lane * 16 + 8); } while (0)
    L_LOAD(0, 0); L_LOAD(1, 1); L_LOAD(2, 2); L_LOAD(3, 3);
#pragma unroll 1
    for (int q0 = 0; q0 < 32; q0 += 4) {
#pragma unroll
    for (int kq = 0; kq < 4; ++kq) { const int q = q0 + kq; const int tile = C.bid + (8 * sr + (q >> 2)) * C.G;
        const u32x4v y0 = ya[kq], y1 = yb[kq];
        L_LOAD(kq, q + 4);
        if (tile < ntile) {
        const size_t token = (size_t)tile * 32 + 4 * wave + (q & 3);
        const float mu = STAT[2 * q] * (1.f / 1024.f), var = STAT[2 * q + 1] * (1.f / 1024.f) - mu * mu;
        const float rstd = __builtin_amdgcn_rsqf(fmaxf(var, 0.f) + EPS);
        float* op = C.out + token * 1024 + lane * 16;
#pragma unroll
        for (int c = 0; c < 4; ++c) { const u32x4v& yy = c < 2 ? y0 : y1; const f32x4v yv = {bf_lo(yy[2 * (c & 1)]), bf_hi(yy[2 * (c & 1)]), bf_lo(yy[2 * (c & 1) + 1]), bf_hi(yy[2 * (c & 1) + 1])};
            *(f32x4v*)(op + 4 * c) = (yv - mu) * rstd * ga4[c] + ba4[c]; } } } }
#undef L_LOAD
#undef L_TOKEN
#undef ID_LOAD
#undef R_TOKEN
#undef ROW_ISSUE
#undef STREAM
#undef lane
#undef wave
    __syncthreads();
    }
}


#ifndef MK_LAUNCHES
#define MK_LAUNCHES 1
#endif
constexpr int NPHASE = 7;
#define REP(k) for (int rep_ = 0; rep_ < (((MK_REPEAT >> (k)) & 1) ? 2 : 1); ++rep_, ((MK_REPEAT >> (k)) & 1) ? grid.sync() : (void)0)


__global__ void __launch_bounds__(NTHREADS, 2) hymba_fwd(Args args) {
    extern __shared__ __attribute__((aligned(16))) unsigned char lds_raw[];
    Ctx C;
    C.lds = (LAS unsigned char*)lds_raw;
    C.tid = threadIdx.x; C.lane = C.tid & 63; C.wave = __builtin_amdgcn_readfirstlane(C.tid >> 6);
    C.G = gridDim.x; C.bid = blockIdx.x;
#pragma unroll
    for (int i = 0; i < 16; ++i) C.in[i] = args.in[i];
    C.out = args.out; C.ws = args.ws;
    const int lo = args.ph_lo, hi = args.ph_hi;
    cg::grid_group grid = cg::this_grid();
#ifdef MK_ONLY
#define IN(k) ((k) == MK_ONLY)
#else
#define IN(k) (lo <= (k) && (k) < hi)
#endif
    unsigned bar_target = 0u;
#define SEAM(k) do { if (IN(k) && IN((k) + 1)) { if ((k) == 0 || MK_REPEAT || !MK_CUSTOM_BAR) grid.sync(); else grid_bar(C, bar_target); } } while (0)
    unsigned char* ws = C.ws;
    if (IN(0)) REP(0) p0_prologue(C);
    SEAM(0);
    if (IN(0)) p0b_quant(C);
    SEAM(0);
    if (IN(1)) REP(1) {
        pg8::Gemm g{(const pg8::bf16_t*)(ws + WS_XB), (const pg8::bf16_t*)(ws + WS_W1Q), MTOK, N1, DM / 2};
        pg8::StaticOrder S; S.init(MTOK, N1, C.G, C.bid);
        pg8::EpiProj E{(pg8::bf16_t*)(ws + WS_QLAT), (pg8::bf16_t*)(ws + WS_QIDX), (pg8::bf16_t*)(ws + WS_CKV), (pg8::bf16_t*)(ws + WS_KIDX), (float*)(ws + WS_WIDX), (float*)(ws + WS_SSQ),
                       (pg8::bf16_t*)(ws + WS_HQ), (float*)(ws + WS_HLF), (pg8::bf16_t*)(ws + WS_HV), (pg8::bf16_t*)(ws + WS_HG), (const float*)(ws + WS_LB), (const float*)(ws + WS_XS), (const float*)(ws + WS_W1S)};
        pg8::gemm_phase<pg8::EpiProj, pg8::StaticOrder, true, true, true>(C.lds, g, S, E);
    }
    SEAM(1);
    if (IN(2)) REP(2) p2_mixers(C, rep_);
    SEAM(2);
    if (IN(3)) REP(3) {
        pg8::Gemm g{(const pg8::bf16_t*)(ws + WS_MIX), (const pg8::bf16_t*)(ws + WS_W3M), MTOK, DM, MIXB / 2};
        pg8::StaticOrder S; S.init(MTOK, DM, C.G, C.bid);
        pg8::EpiY1 E{ws + WS_XB, (const float*)(ws + WS_XS), (pg8::bf16_t*)(ws + WS_Y1), ALPHA, (const float*)(ws + WS_MIXS), (const float*)(ws + WS_W3S)};
        pg8::gemm_phase<pg8::EpiY1, pg8::StaticOrder, true, true, false, 8>(C.lds, g, S, E);
    }
    SEAM(3);
    if (IN(4)) REP(4) p4_ln1(C);
    SEAM(4);
    if (IN(5)) REP(5) {
        pg8::Gemm g{(const pg8::bf16_t*)(ws + WS_H8), (const pg8::bf16_t*)(ws + WS_W5Q), MTOK, NPQ, DM / 2};
        pg8::StaticOrder S; S.init(MTOK, NPQ, C.G, C.bid);
        pg8::EpiPQ E{(pg8::bf16_t*)(ws + WS_PQ), NPQ, (const float*)(ws + WS_HS), (const float*)(ws + WS_W5S)};
        pg8::gemm_phase<pg8::EpiPQ, pg8::StaticOrder, true, true, true>(C.lds, g, S, E);
    }
    SEAM(5);
    if (IN(6)) REP(6) p6_peer(C);
#undef IN
#undef SEAM
}

extern "C" void kernel_launch(void* const* d_in, const int* in_sizes, int n_in, void* d_out, int out_size, void* d_ws, size_t ws_size, hipStream_t stream) {
    static int grid = 0;
    if (grid == 0) {
        if (n_in != 16 || out_size != MTOK * DM || ws_size < WS_END) { fprintf(stderr, "kernel_launch: unexpected shapes (n_in %d, out %d, ws %zu)\n", n_in, out_size, ws_size); grid = -1; return; }
        int dev = 0, cus = 0, per_cu = 0;
        if (hipGetDevice(&dev) != hipSuccess || hipDeviceGetAttribute(&cus, hipDeviceAttributeMultiprocessorCount, dev) != hipSuccess) { grid = -1; return; }
        if (hipFuncSetAttribute((const void*)hymba_fwd, hipFuncAttributeMaxDynamicSharedMemorySize, LDS_BYTES) != hipSuccess) { fprintf(stderr, "kernel_launch: hipFuncSetAttribute failed\n"); grid = -1; return; }
        if (hipOccupancyMaxActiveBlocksPerMultiprocessor(&per_cu, (const void*)hymba_fwd, NTHREADS, LDS_BYTES) != hipSuccess || per_cu < 1) { fprintf(stderr, "kernel_launch: occupancy query says %d blocks per CU\n", per_cu); (void)hipGetLastError(); grid = -1; return; }
        grid = cus;
    }
    if (grid < 0) return;
    Args a{};
    for (int i = 0; i < 16; ++i) a.in[i] = (const float*)d_in[i];
    a.out = (float*)d_out; a.ws = (unsigned char*)d_ws;
#if MK_LAUNCHES == 1
    a.ph_lo = 0; a.ph_hi = NPHASE;
    void* kargs[] = {&a};
    hipError_t e = hipLaunchCooperativeKernel((const void*)hymba_fwd, dim3(grid), dim3(NTHREADS), kargs, LDS_BYTES, stream);
    if (e != hipSuccess) fprintf(stderr, "kernel_launch: cooperative launch failed: %s (grid %d)\n", hipGetErrorString(e), grid);
#else
    for (int p = 0; p < NPHASE; ++p) { a.ph_lo = p; a.ph_hi = p + 1; hipLaunchKernelGGL(hymba_fwd, dim3(grid), dim3(NTHREADS), LDS_BYTES, stream, a); }
#endif
}
```
